# Optimizing an MI355X kernel written in HIP

```python
import math
import jax
import jax.numpy as jnp
from jax import lax
import numpy as np

D_MODEL = 1024
BATCH = 32
SEQ = 256
DEPTH = 2
DEC_BATCH = 4
DEC_SEQ = 4096
PAST_LEN = 256

GRID_W = 64
D_MIX = D_MODEL
SSM_WIDTH = D_MIX // 4
SSM_CH_PER_GROUP = 16
SSM_GROUPS = SSM_WIDTH // SSM_CH_PER_GROUP
SSM_STATE = 64
NA_WIDTH = D_MIX // 2
NA_HEAD_DIM = 64
NA_HEADS = NA_WIDTH // NA_HEAD_DIM
NA_MAX_ROWS = 8
NA_COLS = 16
GM_WIDTH = D_MIX - SSM_WIDTH - NA_WIDTH
GM_GROUPS = 4
GM_CHUNK = 128
D_FF = 2816
N_MOD = 9
IN_COLS = SSM_WIDTH + 3 * NA_WIDTH + 2 * GM_WIDTH
IN_SPLITS = (SSM_WIDTH, SSM_WIDTH + NA_WIDTH, SSM_WIDTH + 2 * NA_WIDTH, SSM_WIDTH + 3 * NA_WIDTH)
ATTN_Q_BLOCK = 128
RMS_EPS = 1e-6
LN_EPS = 1e-5
NEG_INF = -1e30

kernel_name = 'hybrid_diffusion_prefix_step'


def rmsnorm(x, g):
    x32 = x.astype(jnp.float32)
    y = x32 * lax.rsqrt(jnp.mean(x32 * x32, axis=-1, keepdims=True) + RMS_EPS)
    return (y * g.astype(jnp.float32)).astype(x.dtype)


def layernorm(x):
    x32 = x.astype(jnp.float32)
    xc = x32 - jnp.mean(x32, axis=-1, keepdims=True)
    var = jnp.mean(xc * xc, axis=-1, keepdims=True)
    return (xc * lax.rsqrt(var + LN_EPS)).astype(x.dtype)


def modulate(h, shift, scale):
    return h * (1.0 + scale) + shift


def swiglu_ffn(h, w_in, w_out):
    gate, up = jnp.split(h @ w_in, 2, axis=-1)
    return (jax.nn.silu(gate) * up) @ w_out


def adaln(cond, w_ada, b_ada):
    mod = jax.nn.silu(cond) @ w_ada + b_ada
    return mod.reshape(cond.shape[0], N_MOD, D_MODEL)


def _linear_recurrence(e1, e2):
    a1, b1 = e1
    a2, b2 = e2
    return a1 * a2, a2 * b1 + b2


def ssm_mixer(x_ssm, lp, init_state):
    f32 = jnp.float32
    b_, seq_len, _ = x_ssm.shape
    u = x_ssm.astype(f32).reshape(b_, seq_len, SSM_GROUPS, SSM_CH_PER_GROUP)
    uc = u.astype(jnp.complex64)
    y = lp['ssm_d'].astype(f32).reshape(SSM_GROUPS, SSM_CH_PER_GROUP) * u
    finals = []
    for d in range(2):
        reverse = d == 1
        lam = lax.complex(lp['ssm_lambda_re'][d].astype(f32), lp['ssm_lambda_im'][d].astype(f32))
        dt = jnp.exp(lp['ssm_log_dt'][d].astype(f32))[:, None]
        lbar = jnp.exp(lam * dt)
        b_mat = lax.complex(lp['ssm_b_re'][d].astype(f32), lp['ssm_b_im'][d].astype(f32))
        bbar = ((lbar - 1.0) / lam)[..., None] * b_mat
        c_mat = lax.complex(lp['ssm_c_re'][d].astype(f32), lp['ssm_c_im'][d].astype(f32))
        bu = jnp.einsum('gpc,blgc->blgp', bbar, uc)
        if init_state is not None:
            s0 = lax.complex(init_state[:, d, ..., 0].astype(f32), init_state[:, d, ..., 1].astype(f32))
            edge = seq_len - 1 if reverse else 0
            bu = bu.at[:, edge].add(lbar * s0)
        a = jnp.broadcast_to(lbar, bu.shape)
        _, s = lax.associative_scan(_linear_recurrence, (a, bu), axis=1, reverse=reverse)
        y = y + jnp.real(jnp.einsum('gcp,blgp->blgc', c_mat, s))
        if init_state is None:
            fin = s[:, 0] if reverse else s[:, seq_len - 1]
            finals.append(jnp.stack([jnp.real(fin), jnp.imag(fin)], axis=-1))
    y = jax.nn.gelu(y.reshape(b_, seq_len, SSM_WIDTH))
    y = y * jax.nn.sigmoid(y @ lp['ssm_glu_w'].astype(f32) + lp['ssm_glu_b'].astype(f32))
    final_state = jnp.stack(finals, axis=1) if init_state is None else None
    return y.astype(x_ssm.dtype), final_state


def dense_attention(q, k, v):
    b_, s_len, h_, dh = q.shape
    nb = s_len // ATTN_Q_BLOCK
    qb = jnp.moveaxis(q.reshape(b_, nb, ATTN_Q_BLOCK, h_, dh), 1, 0)
    scale = dh ** -0.5

    def block(qi):
        s = jnp.einsum('bqhd,bkhd->bhqk', qi, k).astype(jnp.float32) * scale
        p = jax.nn.softmax(s, axis=-1).astype(v.dtype)
        return jnp.einsum('bhqk,bkhd->bqhd', p, v)

    out = lax.map(block, qb)
    return jnp.moveaxis(out, 0, 1).reshape(b_, s_len, h_ * dh)


def neighbourhood_attention(q, k, v, k_ctx, v_ctx, rpb):
    b_, seq_len, h_, dh = q.shape
    rows = seq_len // GRID_W
    kh = min(NA_MAX_ROWS, rows)
    kw = NA_COLS
    kb = 2 * kw
    nb = GRID_W // kw
    qcol = np.arange(GRID_W).reshape(nb, kw)
    kc0 = np.clip(np.arange(nb) * kw - kw // 2, 0, GRID_W - kb)
    kcol = kc0[:, None] + np.arange(kb)[None, :]
    cs = np.clip(qcol - kw // 2, 0, GRID_W - kw)
    win = (kcol[:, None, :] >= cs[:, :, None]) & (kcol[:, None, :] < cs[:, :, None] + kw)
    dc = np.clip(kcol[:, None, :] - qcol[:, :, None], -(kw - 1), kw - 1) + (kw - 1)
    bias_c = rpb[:, :, dc]
    q_g = q.reshape(b_, rows, GRID_W, h_, dh)
    k_g = k.reshape(b_, rows, GRID_W, h_, dh)
    v_g = v.reshape(b_, rows, GRID_W, h_, dh)
    scale = dh ** -0.5

    def row_block(r):
        rs = jnp.clip(r - kh // 2, 0, rows - kh)
        k_blk = lax.dynamic_slice_in_dim(k_g, rs, kh, axis=1)[:, :, kcol]
        v_blk = lax.dynamic_slice_in_dim(v_g, rs, kh, axis=1)[:, :, kcol]
        q_r = lax.dynamic_index_in_dim(q_g, r, axis=1, keepdims=False).reshape(b_, nb, kw, h_, dh)
        s_win = jnp.einsum('bnqhd,bknchd->bhnqkc', q_r, k_blk).astype(jnp.float32) * scale
        dr = rs + jnp.arange(kh) - r + (NA_MAX_ROWS - 1)
        bias = jnp.transpose(jnp.take(bias_c, dr, axis=1), (0, 2, 3, 1, 4))
        s_win = jnp.where(win[None, None, :, :, None, :], s_win + bias[None].astype(jnp.float32), NEG_INF)
        s_ctx = jnp.einsum('bnqhd,bkhd->bhnqk', q_r, k_ctx).astype(jnp.float32) * scale
        logits = jnp.concatenate([s_win.reshape(b_, h_, nb, kw, kh * kb), s_ctx], axis=-1)
        p = jax.nn.softmax(logits, axis=-1).astype(v.dtype)
        p_win = p[..., :kh * kb].reshape(b_, h_, nb, kw, kh, kb)
        p_ctx = p[..., kh * kb:]
        o = jnp.einsum('bhnqkc,bknchd->bnqhd', p_win, v_blk) + jnp.einsum('bhnqk,bkhd->bnqhd', p_ctx, v_ctx)
        return o.reshape(b_, GRID_W, h_, dh)

    out = lax.map(row_block, jnp.arange(rows))
    return jnp.moveaxis(out, 0, 1).reshape(b_, seq_len, h_ * dh)


def spatial_gating(uv, ws, bs):
    b_, seq_len, _ = uv.shape
    u, v = jnp.split(jax.nn.gelu(uv), 2, axis=-1)
    v = layernorm(v)
    vc = v.reshape(b_, seq_len // GM_CHUNK, GM_CHUNK, GM_GROUPS, GM_WIDTH // GM_GROUPS)
    sp = jnp.einsum('gij,bnjgc->bnigc', ws, vc) + jnp.transpose(bs)[:, :, None]
    return u * sp.reshape(b_, seq_len, GM_WIDTH)


def token_mixing(h, lp, ctx_kv, ssm_init):
    b_, seq_len, _ = h.shape
    x_ssm, q, k, v, uv = jnp.split(h @ lp['w_in'], IN_SPLITS, axis=-1)
    y_ssm, ssm_final = ssm_mixer(x_ssm, lp, ssm_init)
    q = rmsnorm(q.reshape(b_, seq_len, NA_HEADS, NA_HEAD_DIM), lp['na_q_norm'])
    k = rmsnorm(k.reshape(b_, seq_len, NA_HEADS, NA_HEAD_DIM), lp['na_k_norm'])
    v = v.reshape(b_, seq_len, NA_HEADS, NA_HEAD_DIM)
    if ctx_kv is None:
        y_na = dense_attention(q, k, v)
    else:
        y_na = neighbourhood_attention(q, k, v, ctx_kv[0], ctx_kv[1], lp['na_rpb'])
    y_gm = spatial_gating(uv, lp['gm_ws'], lp['gm_bs'])
    out = jnp.concatenate([y_ssm, y_na, y_gm], axis=-1) @ lp['w_out']
    ctx_state = (k, v, ssm_final) if ctx_kv is None else None
    return out, ctx_state


def trunk_layer(x, mod, lp, ctx_kv, ssm_init):
    mod = mod.astype(x.dtype)
    sh1, sc1, g1, sh2, sc2, g2, sh3, sc3, g3 = [mod[:, i][:, None, :] for i in range(N_MOD)]
    h = modulate(rmsnorm(x, lp['norm_ffn1']), sh1, sc1)
    x = x + 0.5 * g1 * swiglu_ffn(h, lp['ffn1_w_in'], lp['ffn1_w_out'])
    h = modulate(rmsnorm(x, lp['norm_mix']), sh2, sc2)
    mix, ctx_state = token_mixing(h, lp, ctx_kv, ssm_init)
    x = x + g2 * mix
    h = modulate(rmsnorm(x, lp['norm_ffn2']), sh3, sc3)
    x = x + 0.5 * g3 * swiglu_ffn(h, lp['ffn2_w_in'], lp['ffn2_w_out'])
    return x, ctx_state


def setup_inputs(seed: int = 0) -> dict:
    key = jax.random.key(seed)
    ks = jax.random.split(key, 40)
    f32 = jnp.float32

    def nrm(k, shape, scale):
        return jax.random.normal(k, shape, f32) * scale

    def gain(k, shape):
        return 1.0 + 0.01 * jax.random.normal(k, shape, f32)

    ssm_shape = (DEPTH, 2, SSM_GROUPS, SSM_STATE)
    n_idx = jnp.arange(SSM_STATE, dtype=f32)
    return {
        'x_prompt': nrm(ks[0], (BATCH, SEQ, D_MODEL), 1.0),
        'x_sample': nrm(ks[1], (DEC_BATCH, DEC_SEQ, D_MODEL), 1.0),
        'c': nrm(ks[2], (DEC_BATCH, D_MODEL), 1.0),
        'cache_k': nrm(ks[3], (DEC_BATCH, DEPTH, PAST_LEN, NA_HEADS, NA_HEAD_DIM), 1.0),
        'cache_v': nrm(ks[4], (DEC_BATCH, DEPTH, PAST_LEN, NA_HEADS, NA_HEAD_DIM), 1.0),
        'state_ssm': nrm(ks[5], (DEC_BATCH, DEPTH, 2, SSM_GROUPS, SSM_STATE, 2), 0.1),
        'c_ctx': nrm(ks[6], (D_MODEL,), 1.0),
        'w_ada': nrm(ks[7], (DEPTH, D_MODEL, N_MOD * D_MODEL), 0.02),
        'b_ada': nrm(ks[8], (DEPTH, N_MOD * D_MODEL), 0.02),
        'norm_ffn1': gain(ks[9], (DEPTH, D_MODEL)),
        'ffn1_w_in': nrm(ks[10], (DEPTH, D_MODEL, 2 * D_FF), D_MODEL ** -0.5),
        'ffn1_w_out': nrm(ks[11], (DEPTH, D_FF, D_MODEL), D_FF ** -0.5),
        'norm_mix': gain(ks[12], (DEPTH, D_MODEL)),
        'w_in': nrm(ks[13], (DEPTH, D_MODEL, IN_COLS), D_MODEL ** -0.5),
        'w_out': nrm(ks[14], (DEPTH, D_MIX, D_MODEL), D_MIX ** -0.5),
        'ssm_lambda_re': -0.5 + nrm(ks[15], ssm_shape, 0.01),
        'ssm_lambda_im': math.pi * n_idx + nrm(ks[16], ssm_shape, 0.01),
        'ssm_log_dt': jax.random.uniform(ks[17], (DEPTH, 2, SSM_GROUPS), f32, math.log(1e-3), math.log(1e-1)),
        'ssm_b_re': nrm(ks[18], (DEPTH, 2, SSM_GROUPS, SSM_STATE, SSM_CH_PER_GROUP), (2 * SSM_CH_PER_GROUP) ** -0.5),
        'ssm_b_im': nrm(ks[19], (DEPTH, 2, SSM_GROUPS, SSM_STATE, SSM_CH_PER_GROUP), (2 * SSM_CH_PER_GROUP) ** -0.5),
        'ssm_c_re': nrm(ks[20], (DEPTH, 2, SSM_GROUPS, SSM_CH_PER_GROUP, SSM_STATE), (2 * SSM_STATE) ** -0.5),
        'ssm_c_im': nrm(ks[21], (DEPTH, 2, SSM_GROUPS, SSM_CH_PER_GROUP, SSM_STATE), (2 * SSM_STATE) ** -0.5),
        'ssm_d': nrm(ks[22], (DEPTH, SSM_WIDTH), 1.0),
        'ssm_glu_w': nrm(ks[23], (DEPTH, SSM_WIDTH, SSM_WIDTH), SSM_WIDTH ** -0.5),
        'ssm_glu_b': nrm(ks[24], (DEPTH, SSM_WIDTH), 0.02),
        'na_q_norm': gain(ks[25], (DEPTH, NA_HEAD_DIM)),
        'na_k_norm': gain(ks[26], (DEPTH, NA_HEAD_DIM)),
        'na_rpb': nrm(ks[27], (DEPTH, NA_HEADS, 2 * NA_MAX_ROWS - 1, 2 * NA_COLS - 1), 0.1),
        'gm_ws': nrm(ks[28], (DEPTH, GM_GROUPS, GM_CHUNK, GM_CHUNK), GM_CHUNK ** -0.5),
        'gm_bs': gain(ks[29], (DEPTH, GM_GROUPS, GM_CHUNK)),
        'norm_ffn2': gain(ks[30], (DEPTH, D_MODEL)),
        'ffn2_w_in': nrm(ks[31], (DEPTH, D_MODEL, 2 * D_FF), D_MODEL ** -0.5),
        'ffn2_w_out': nrm(ks[32], (DEPTH, D_FF, D_MODEL), D_FF ** -0.5),
    }


def reference(x_prompt, x_sample, c, cache_k, cache_v, state_ssm, c_ctx, w_ada, b_ada,
              norm_ffn1, ffn1_w_in, ffn1_w_out, norm_mix, w_in, w_out,
              ssm_lambda_re, ssm_lambda_im, ssm_log_dt, ssm_b_re, ssm_b_im, ssm_c_re, ssm_c_im,
              ssm_d, ssm_glu_w, ssm_glu_b, na_q_norm, na_k_norm, na_rpb, gm_ws, gm_bs,
              norm_ffn2, ffn2_w_in, ffn2_w_out):
    stacked = {
        'norm_ffn1': norm_ffn1, 'ffn1_w_in': ffn1_w_in, 'ffn1_w_out': ffn1_w_out,
        'norm_mix': norm_mix, 'w_in': w_in, 'w_out': w_out,
        'ssm_lambda_re': ssm_lambda_re, 'ssm_lambda_im': ssm_lambda_im, 'ssm_log_dt': ssm_log_dt,
        'ssm_b_re': ssm_b_re, 'ssm_b_im': ssm_b_im, 'ssm_c_re': ssm_c_re, 'ssm_c_im': ssm_c_im,
        'ssm_d': ssm_d, 'ssm_glu_w': ssm_glu_w, 'ssm_glu_b': ssm_glu_b,
        'na_q_norm': na_q_norm, 'na_k_norm': na_k_norm, 'na_rpb': na_rpb,
        'gm_ws': gm_ws, 'gm_bs': gm_bs,
        'norm_ffn2': norm_ffn2, 'ffn2_w_in': ffn2_w_in, 'ffn2_w_out': ffn2_w_out,
    }
    xp = x_prompt
    xs = x_sample
    new_k, new_v, new_s = [], [], []
    for l in range(DEPTH):
        lp = {name: arr[l] for name, arr in stacked.items()}
        mod_ctx = adaln(c_ctx[None, :], w_ada[l], b_ada[l])
        xp, (k_c, v_c, s_c) = trunk_layer(xp, mod_ctx, lp, None, None)
        new_k.append(k_c)
        new_v.append(v_c)
        new_s.append(s_c)
        mod_lat = adaln(c, w_ada[l], b_ada[l])
        xs, _ = trunk_layer(xs, mod_lat, lp, (cache_k[:, l], cache_v[:, l]), state_ssm[:, l])
    new_cache_k = jnp.stack(new_k, axis=1)
    new_cache_v = jnp.stack(new_v, axis=1)
    new_state_ssm = jnp.stack(new_s, axis=1)
    return (xp, xs, new_cache_k, new_cache_v, new_state_ssm)
```

```cpp
#include <hip/hip_runtime.h>
#include <hip/hip_cooperative_groups.h>
#include <cstdio>
#include <cstdint>

typedef unsigned short bf16_t;
namespace {
constexpr int D = 1024, BATCH = 32, SEQ = 256, DEPTH = 2, DB = 4, DSEQ = 4096, PAST = 256;
constexpr int GW = 64, SSMW = 256, NAW = 512, NH = 8, HD = 64, GMW = 256, FF = 2816, NMOD = 9, INC = 2304;
constexpr int SG = 16, SC = 16, SP = 64;
constexpr int MC = BATCH * SEQ, ML = DB * DSEQ, MT = MC + ML;
constexpr size_t MiB = 1u << 20;
constexpr size_t WS_CTL = 0, WS_MOD = 1 * MiB, WS_SSMP = 2 * MiB, WS_CK = 3 * MiB, WS_CVT = 5 * MiB, WS_E = 7 * MiB;
constexpr size_t WS_WSB = 13 * MiB, WS_GLT = 13 * MiB + MiB / 2;
constexpr size_t WS_BMF = 14 * MiB, WS_CFF = 14 * MiB + MiB / 2;
constexpr size_t WS_SHW = MiB + 384 * 1024, WS_ROWSS = 15 * MiB, WS_WN = 15 * MiB + 768 * 1024;
constexpr int SHW_LAYER = 5 * (2 * 2 * FF + INC), SHW_J1 = 5 * 2 * FF, SHW_J2 = 5 * (2 * FF + INC);
constexpr size_t WS_W = 16 * MiB, WS_H = 96 * MiB, WS_ACT = 144 * MiB;
constexpr size_t WS_XSSM = 144 * MiB, WS_Q = 168 * MiB, WS_K = 192 * MiB, WS_VT = 216 * MiB, WS_U = 240 * MiB, WS_VG = 252 * MiB;
constexpr size_t WS_SIN = 264 * MiB, WS_MIX = 276 * MiB, WS_XH2B = 324 * MiB, WS_END = 332 * MiB;
constexpr size_t XH_OUT_OFF = 48 * MiB; constexpr int XH2_SPLIT_PM = 80;
constexpr size_t O_YP = 0, O_YS = (size_t)MC * D, O_CK = (size_t)MT * D, O_CV = O_CK + (size_t)BATCH * DEPTH * SEQ * NAW,
                 O_ST = O_CV + (size_t)BATCH * DEPTH * SEQ * NAW;

__device__ __forceinline__ float bf2f(bf16_t v) { return __uint_as_float(((unsigned)v) << 16); }
__device__ __forceinline__ bf16_t f2bf(float f) { unsigned u = __float_as_uint(f); return (bf16_t)((u + 0x7fffu + ((u >> 16) & 1u)) >> 16); }
__device__ __forceinline__ float silu_f(float x) { return x / (1.f + __expf(-x)); }
__device__ __forceinline__ float gelu_tanh(float x) { const float u = 0.7978845608028654f * (x + 0.044715f * x * x * x); return 0.5f * x * (1.f + tanhf(u)); }
__device__ __forceinline__ int modrow(int m) { return m < MC ? 0 : 1 + (m - MC) / DSEQ; }
__device__ __forceinline__ float wave_sum(float v) {
#pragma unroll
    for (int o = 1; o < 64; o <<= 1) v += __shfl_xor(v, o);
    return v;
}

struct Params {
    const float* in[33];
    float* out;
    unsigned char* ws;
    int ph_lo, ph_hi, rep_mask, pad;
};


template <int OFF> __device__ __forceinline__ unsigned long long karg64() {
    unsigned long long v;
    asm volatile("s_load_dwordx2 %0, %1, %2\n\ts_waitcnt lgkmcnt(0)" : "=s"(v) : "s"(__builtin_amdgcn_kernarg_segment_ptr()), "i"(OFF) : "memory");
    return v;
}
__device__ __forceinline__ int tid_opaque() { int t = threadIdx.x; asm volatile("" : "+v"(t)); return t; }
#define GASP __attribute__((address_space(1)))
#define PIN(i) ((const float*)(const GASP float*)karg64<8 * (i)>())
#define POUT ((float*)(GASP float*)karg64<8 * 33>())
#define PWS ((unsigned char*)(GASP unsigned char*)karg64<8 * 34>())
constexpr int NWAVES = 8, LDS_BYTES = 147456, LDS_CTL_OFF = LDS_BYTES - 64, CW_BAR = 4096;
constexpr size_t WL_STRIDE = 40 * MiB, WO_W1A = 0, WO_W2A = 11 * MiB, WO_WIN = 16 * MiB + MiB / 2, WO_WOUT = 21 * MiB, WO_W1B = 23 * MiB, WO_W2B = 34 * MiB;
enum { PH_PRO = 0, PH_X0 = 1, PH_F1IN = 2, PH_F1OUT, PH_WIN, PH_MIX1, PH_MIXC, PH_MIX2, PH_WOUT, PH_F2IN, PH_F2OUT, PH_PER_LAYER = 9 };
constexpr int NPHASES = 2 + DEPTH * PH_PER_LAYER;
constexpr int PROBE_REP_MASK = 0;


namespace pg8 {
#define PG8_LAS __attribute__((address_space(3)))
typedef unsigned short bf16_t;
typedef short bf16x8 __attribute__((ext_vector_type(8)));
typedef float f32x4 __attribute__((ext_vector_type(4)));
typedef unsigned u32x4 __attribute__((ext_vector_type(4)));
constexpr int BM = 256, BK = 64, HALF = 128, HTB = HALF * BK * 2  , STAGE_BYTES = 8 * HTB, NXCD = 8, WGM = 8;

__host__ __device__ __forceinline__ int lds_byte(int r, int c) { const int st = (r >> 4) * 2 + (c >> 5), rr = r & 15, cc = c & 31, ob = rr * 64 + cc * 2; return st * 1024 + (ob ^ (((ob >> 9) & 1) << 5)); }
__host__ __device__ __forceinline__ void stage_rc(int b, int& R, int& C) { const int st = b / 1024, sb = b % 1024, swz = sb ^ (((sb >> 9) & 1) << 5); R = (st >> 1) * 16 + swz / 64; C = (st & 1) * 32 + (swz % 64) / 2; }
__host__ __device__ __forceinline__ int perm32(int rho) { const int n = rho >> 4, i = rho & 15; return 8 * (i >> 2) + 4 * n + (i & 3); }

struct Unit { int pm, pn, mask; };
struct Gemm { const bf16_t* A; const bf16_t* Bt; int M, N, K; };

struct StaticOrder {
    int nM, nN, nwg, G, c;
    __host__ __device__ void init(int M, int N, int G_, int c_) { nM = M / BM; nN = N / BM; nwg = nM * nN; G = G_; c = c_; }
    __host__ __device__ bool next(int i, Unit& u) const {
        const int rfull = nwg / G, left = nwg - rfull * G;
        long L = (long)i * G + c; u.mask = 3;
        if (i == rfull && left > 0 && 2 * left <= G) { if (c >= 2 * left) return false; L = (long)i * G + (c >> 1); u.mask = 1 << (c & 1); }
        if (L >= nwg) return false;
        int wgid = (int)L; { const int q = nwg / NXCD, r = nwg % NXCD, xcd = wgid % NXCD, off = wgid / NXCD; wgid = (xcd < r ? xcd * (q + 1) : r * (q + 1) + (xcd - r) * q) + off; }
        const int nig = WGM * nN, gid = wgid / nig, fm = gid * WGM, gsz = (nM - fm) < WGM ? (nM - fm) : WGM;
        u.pm = fm + ((wgid % nig) % gsz); u.pn = (wgid % nig) / gsz; return true;
    }
    __device__ __forceinline__ void a_ready(const Unit&) const {}
    __device__ __forceinline__ void done(const Unit&) const {}
};
__device__ __forceinline__ unsigned cvt_pk_bf16(float lo, float hi) { unsigned r; asm volatile("v_cvt_pk_bf16_f32 %0, %1, %2" : "=v"(r) : "v"(lo), "v"(hi)); return r; }

__device__ __forceinline__ float silu_fast(float x) { return x * __builtin_amdgcn_rcpf(1.f + __builtin_amdgcn_exp2f(-1.4426950408889634f * x)); }
__device__ __forceinline__ float gelu_fast(float x) {
    const float u2 = 1.5957691216057308f * (x + 0.044715f * x * x * x);
    return x * __builtin_amdgcn_rcpf(1.f + __builtin_amdgcn_exp2f(-1.4426950408889634f * u2));
}
struct EpiFfnIn {
    static constexpr bool PERM = true, AFTER_DRAIN = false;
    int l, second;
    __device__ __forceinline__ void operator()(const f32x4 (&acc)[2][2][4][2], const Unit& u, int wr, int wc, int fr, int fq) const {
        asm volatile("" : "+v"(fr), "+v"(fq));
        unsigned char* ws = PWS; bf16_t* ACT = (bf16_t*)(ws + WS_ACT);
        const float* rowss = (const float*)(ws + WS_ROWSS) + (size_t)(l * 3 + (second ? 2 : 0)) * MT; const float* shw = (const float*)(ws + WS_SHW) + (size_t)l * SHW_LAYER + (second ? SHW_J2 : 0);
        const int row0 = u.pm * 256 + wr * 64 + fr, col0 = u.pn * 128 + wc * 32 + 8 * fq;
        const float* sp = shw + (size_t)modrow(u.pm * 256) * (2 * FF) + u.pn * 256 + wc * 32 + 8 * fq;
        const f32x4 sg0 = *(const f32x4*)sp, sg1 = *(const f32x4*)(sp + 4), su0 = *(const f32x4*)(sp + 128), su1 = *(const f32x4*)(sp + 132);
#pragma unroll
        for (int ai = 0; ai < 2; ++ai) if ((u.mask >> ai) & 1)
#pragma unroll
            for (int m = 0; m < 4; ++m) {
                const int row = row0 + ai * 128 + m * 16;
                const float ri = rsqrtf(rowss[row] * (1.f / D) + 1e-6f);
                const f32x4 g0 = acc[ai][0][m][0] * ri + sg0, g1 = acc[ai][0][m][1] * ri + sg1, u0 = acc[ai][1][m][0] * ri + su0, u1 = acc[ai][1][m][1] * ri + su1;
                u32x4 w;
                w.x = cvt_pk_bf16(silu_fast(g0[0]) * u0[0], silu_fast(g0[1]) * u0[1]); w.y = cvt_pk_bf16(silu_fast(g0[2]) * u0[2], silu_fast(g0[3]) * u0[3]);
                w.z = cvt_pk_bf16(silu_fast(g1[0]) * u1[0], silu_fast(g1[1]) * u1[1]); w.w = cvt_pk_bf16(silu_fast(g1[2]) * u1[2], silu_fast(g1[3]) * u1[3]);
                *(u32x4*)(ACT + (size_t)row * FF + col0) = w;
            }
    }
};
typedef _Float16 f16x8 __attribute__((ext_vector_type(8)));
typedef _Float16 f16x4 __attribute__((ext_vector_type(4)));
typedef float f32x8 __attribute__((ext_vector_type(8)));
struct EpiRes {
    static constexpr bool PERM = true, AFTER_DRAIN = false;
    int l, kind;
    __device__ __forceinline__ void operator()(const f32x4 (&acc)[2][2][4][2], const Unit& u, int wr, int wc, int fr, int fq) const {
        asm volatile("" : "+v"(fr), "+v"(fq));
        unsigned char* ws = PWS; float* X = POUT;
        const int step = l * 3 + kind;
        const bool out_f32 = step == DEPTH * 3 - 1;
        const GASP unsigned char* rp; GASP unsigned char* wp;
        if (out_f32) rp = (const GASP unsigned char*)(u.pm < XH2_SPLIT_PM ? ws + WS_W : ws + WS_XH2B - (size_t)XH2_SPLIT_PM * 256 * D * 2);
        else rp = (const GASP unsigned char*)X + XH_OUT_OFF;
        if (out_f32) wp = (GASP unsigned char*)X;
        else if (step == DEPTH * 3 - 2) wp = (GASP unsigned char*)(u.pm < XH2_SPLIT_PM ? ws + WS_W : ws + WS_XH2B - (size_t)XH2_SPLIT_PM * 256 * D * 2);
        else wp = (GASP unsigned char*)X + XH_OUT_OFF;
        const int row0 = u.pm * 256 + wr * 64 + fr, mr = modrow(u.pm * 256);
        const float fac = kind == 1 ? 1.f : 0.5f;
        const float* gate = (const float*)(ws + WS_MOD) + ((size_t)l * 5 + mr) * NMOD * D + (kind == 0 ? 2 : kind == 1 ? 5 : 8) * D;
        const int nl = kind == 2 ? l + 1 : l, nn = nl * 3 + (kind == 0 ? 1 : kind == 1 ? 2 : 0);
        const bool wn = nl < DEPTH;
        bf16_t* H = (bf16_t*)(ws + WS_H); const float* wnp = (const float*)(ws + WS_WN) + ((size_t)nn * 5 + mr) * D; float* rowss_next = (float*)(ws + WS_ROWSS) + (size_t)nn * MT;
        f32x4 ga[2], gb[2], wa[2], wb[2];
#pragma unroll
        for (int bj = 0; bj < 2; ++bj) {
            const int col = u.pn * 256 + bj * 128 + wc * 32 + 8 * fq;
            ga[bj] = *(const f32x4*)(gate + col) * fac; gb[bj] = *(const f32x4*)(gate + col + 4) * fac;
            wa[bj] = (f32x4){0.f, 0.f, 0.f, 0.f}; wb[bj] = wa[bj];
            if (wn) { wa[bj] = *(const f32x4*)(wnp + col); wb[bj] = *(const f32x4*)(wnp + col + 4); }
        }
#pragma unroll
        for (int ai = 0; ai < 2; ++ai) if ((u.mask >> ai) & 1)
#pragma unroll
            for (int m = 0; m < 4; ++m) {
                const int row = row0 + ai * 128 + m * 16;
                float ssq = 0.f;
#pragma unroll
                for (int bj = 0; bj < 2; ++bj) {
                    const size_t ro = (size_t)row * D + u.pn * 256 + bj * 128 + wc * 32 + 8 * fq;
                    f32x4 x0, x1;
                    { const f32x8 fv = __builtin_convertvector(*(const GASP f16x8*)((const GASP _Float16*)rp + ro), f32x8); x0 = fv.lo; x1 = fv.hi; }
                    x0 += ga[bj] * acc[ai][bj][m][0]; x1 += gb[bj] * acc[ai][bj][m][1];
                    if (out_f32) { GASP float* x = (GASP float*)wp + ro; *(GASP f32x4*)x = x0; *(GASP f32x4*)(x + 4) = x1; }
                    else { f32x8 fv; fv.lo = x0; fv.hi = x1; *(GASP f16x8*)((GASP _Float16*)wp + ro) = __builtin_convertvector(fv, f16x8); }
                    if (wn) {
                        ssq += ((x0[0] * x0[0] + x0[1] * x0[1]) + (x0[2] * x0[2] + x0[3] * x0[3])) + ((x1[0] * x1[0] + x1[1] * x1[1]) + (x1[2] * x1[2] + x1[3] * x1[3]));
                        const f32x4 h0 = x0 * wa[bj], h1 = x1 * wb[bj];
                        u32x4 w; w.x = cvt_pk_bf16(h0[0], h0[1]); w.y = cvt_pk_bf16(h0[2], h0[3]); w.z = cvt_pk_bf16(h1[0], h1[1]); w.w = cvt_pk_bf16(h1[2], h1[3]);
                        *(u32x4*)(H + ro) = w;
                    }
                }
                if (wn) { ssq += __shfl_xor(ssq, 16); ssq += __shfl_xor(ssq, 32); if (fq == 0) (void)__hip_atomic_fetch_add(rowss_next + row, ssq, __ATOMIC_RELAXED, __HIP_MEMORY_SCOPE_AGENT); }
            }
    }
};
struct EpiWin {
    static constexpr bool PERM = true, AFTER_DRAIN = false;
    int l;
    __device__ __forceinline__ void operator()(f32x4 (&acc)[2][2][4][2], const Unit& u, int wr, int wc, int fr, int fq) const {
        asm volatile("" : "+v"(fr), "+v"(fq));
        unsigned char* ws = PWS; float* out = POUT; const float* qn = PIN(25) + l * HD; const float* kn = PIN(26) + l * HD;
        const float* rowss = (const float*)(ws + WS_ROWSS) + (size_t)(l * 3 + 1) * MT; const float* shw = (const float*)(ws + WS_SHW) + (size_t)l * SHW_LAYER + SHW_J1;
        const int row0 = u.pm * 256 + wr * 64 + fr, pn = u.pn;
        {
            const float* sp = shw + (size_t)modrow(u.pm * 256) * INC + pn * 256 + wc * 32 + 8 * fq;
            f32x4 sv[2][2];
#pragma unroll
            for (int bj = 0; bj < 2; ++bj) { sv[bj][0] = *(const f32x4*)(sp + bj * 128); sv[bj][1] = *(const f32x4*)(sp + bj * 128 + 4); }
#pragma unroll
            for (int ai = 0; ai < 2; ++ai) if ((u.mask >> ai) & 1)
#pragma unroll
                for (int m = 0; m < 4; ++m) {
                    const float ri = rsqrtf(rowss[row0 + ai * 128 + m * 16] * (1.f / D) + 1e-6f);
#pragma unroll
                    for (int bj = 0; bj < 2; ++bj) { acc[ai][bj][m][0] = acc[ai][bj][m][0] * ri + sv[bj][0]; acc[ai][bj][m][1] = acc[ai][bj][m][1] * ri + sv[bj][1]; }
                }
        }
        float* XS = (float*)(ws + WS_XSSM); bf16_t* Q = (bf16_t*)(ws + WS_Q); bf16_t* K = (bf16_t*)(ws + WS_K); bf16_t* VT = (bf16_t*)(ws + WS_VT); bf16_t* U = (bf16_t*)(ws + WS_U); bf16_t* VG = (bf16_t*)(ws + WS_VG);
        float* ock = out + O_CK; float* ocv = out + O_CV;
        if (pn == 0) {
#pragma unroll
            for (int ai = 0; ai < 2; ++ai) if ((u.mask >> ai) & 1)
#pragma unroll
                for (int m = 0; m < 4; ++m)
#pragma unroll
                    for (int bj = 0; bj < 2; ++bj) { float* o = XS + (size_t)(row0 + ai * 128 + m * 16) * SSMW + bj * 128 + wc * 32 + 8 * fq;
                        *(f32x4*)o = acc[ai][bj][m][0]; *(f32x4*)(o + 4) = acc[ai][bj][m][1]; }
        } else if (pn <= 4) {
            const bool isk = pn >= 3; const int h = 4 * ((pn - 1) & 1) + wc;
            const float* gn = isk ? kn : qn; bf16_t* O = isk ? K : Q;
            f32x4 gv[2][2];
#pragma unroll
            for (int bj = 0; bj < 2; ++bj)
#pragma unroll
                for (int n = 0; n < 2; ++n) gv[bj][n] = *(const f32x4*)(gn + 32 * bj + 8 * fq + 4 * n);
#pragma unroll
            for (int ai = 0; ai < 2; ++ai) if ((u.mask >> ai) & 1)
#pragma unroll
                for (int m = 0; m < 4; ++m) {
                    float ss = 0.f;
#pragma unroll
                    for (int bj = 0; bj < 2; ++bj)
#pragma unroll
                        for (int n = 0; n < 2; ++n) { const f32x4 v = acc[ai][bj][m][n]; ss += (v[0] * v[0] + v[1] * v[1]) + (v[2] * v[2] + v[3] * v[3]); }
                    ss += __shfl_xor(ss, 16); ss += __shfl_xor(ss, 32);
                    const float rinv = rsqrtf(ss * (1.f / HD) + 1e-6f);
                    const int row = row0 + ai * 128 + m * 16;
#pragma unroll
                    for (int bj = 0; bj < 2; ++bj) {
                        const f32x4 v0 = acc[ai][bj][m][0] * rinv * gv[bj][0], v1 = acc[ai][bj][m][1] * rinv * gv[bj][1];
                        u32x4 w; w.x = cvt_pk_bf16(v0[0], v0[1]); w.y = cvt_pk_bf16(v0[2], v0[3]); w.z = cvt_pk_bf16(v1[0], v1[1]); w.w = cvt_pk_bf16(v1[2], v1[3]);
                        const int d = 32 * bj + 8 * fq;
                        *(u32x4*)(O + (size_t)row * NAW + h * HD + d) = w;
                        if (isk && u.pm < MC / 256) { const int b = row / SEQ, t = row % SEQ; float* o = ock + ((((size_t)b * DEPTH + l) * SEQ + t) * NH + h) * HD + d;
                            *(f32x4*)o = v0; *(f32x4*)(o + 4) = v1; }
                    }
                }
        } else if (pn <= 6) {
            const bool ctx = u.pm < MC / 256;
#pragma unroll
            for (int ai = 0; ai < 2; ++ai) if ((u.mask >> ai) & 1)
#pragma unroll
                for (int m = 0; m < 4; ++m) {
                    const int row = row0 + ai * 128 + m * 16;
                    size_t vb; int Lq; float* oc = nullptr;
                    if (ctx) { const int b = row / SEQ, t = row % SEQ; vb = (size_t)b * NH * HD * SEQ + t; Lq = SEQ; oc = ocv + (((size_t)b * DEPTH + l) * SEQ + t) * NAW; }
                    else { const int r2 = row - MC, b = r2 / DSEQ, t = r2 % DSEQ; vb = (size_t)MC * NAW + (size_t)b * NH * HD * DSEQ + t; Lq = DSEQ; }
#pragma unroll
                    for (int bj = 0; bj < 2; ++bj) {
                        const int cl = (pn - 5) * 256 + bj * 128 + wc * 32 + 8 * fq;
                        const f32x4 v0 = acc[ai][bj][m][0], v1 = acc[ai][bj][m][1];
                        bf16_t* o = VT + vb + (size_t)cl * Lq;
                        o[0] = f2bf(v0[0]); o[(size_t)Lq] = f2bf(v0[1]); o[(size_t)2 * Lq] = f2bf(v0[2]); o[(size_t)3 * Lq] = f2bf(v0[3]);
                        o[(size_t)4 * Lq] = f2bf(v1[0]); o[(size_t)5 * Lq] = f2bf(v1[1]); o[(size_t)6 * Lq] = f2bf(v1[2]); o[(size_t)7 * Lq] = f2bf(v1[3]);
                        if (ctx) { *(f32x4*)(oc + cl) = v0; *(f32x4*)(oc + cl + 4) = v1; }
                    }
                }
        } else {
            bf16_t* O = pn == 7 ? U : VG;
#pragma unroll
            for (int ai = 0; ai < 2; ++ai) if ((u.mask >> ai) & 1)
#pragma unroll
                for (int m = 0; m < 4; ++m)
#pragma unroll
                    for (int bj = 0; bj < 2; ++bj) {
                        const f32x4 v0 = acc[ai][bj][m][0], v1 = acc[ai][bj][m][1];
                        u32x4 w; w.x = cvt_pk_bf16(gelu_fast(v0[0]), gelu_fast(v0[1])); w.y = cvt_pk_bf16(gelu_fast(v0[2]), gelu_fast(v0[3]));
                        w.z = cvt_pk_bf16(gelu_fast(v1[0]), gelu_fast(v1[1])); w.w = cvt_pk_bf16(gelu_fast(v1[2]), gelu_fast(v1[3]));
                        *(u32x4*)(O + (size_t)(row0 + ai * 128 + m * 16) * GMW + bj * 128 + wc * 32 + 8 * fq) = w;
                    }
        }
    }
};

template <class Epi, class Sched, bool ALIGN_EPI = false, bool SP2 = false>
__device__ __forceinline__ void gemm_phase(PG8_LAS unsigned char* lds, const Gemm g, const Sched& S, const Epi& E) {
    const int tid = tid_opaque(), wid = __builtin_amdgcn_readfirstlane(tid >> 6), lane = tid & 63, wr = wid >> 2, wc = wid & 3, fr = lane & 15, fq = lane >> 4;
    const int K = g.K, nt = K / BK;
    unsigned voffA[2], voffB[2];
#pragma unroll
    for (int i = 0; i < 2; ++i) { int R, C; stage_rc(tid * 16 + i * 8192, R, C); const int Rb = Epi::PERM ? ((R & ~31) + perm32(R & 31)) : R;
        voffA[i] = (unsigned)(R * K + C) * 2u; voffB[i] = (unsigned)(Rb * K + C) * 2u; }
    const size_t kstep = (size_t)(BK * 2);
    const size_t hstep = (size_t)HALF * K * 2;
    const size_t tstep = 2 * hstep;
    const unsigned ldsw = (unsigned)wid * 1024u;
    const int aoff = lds_byte(wr * 64 + fr, fq * 8), boff = lds_byte(wc * 32 + fr, fq * 8);
#define PG8_SA(b, h) (((b) * 2 + (h)) * HTB)
#define PG8_SB(b, h) ((4 + (b) * 2 + (h)) * HTB)
#define PG8_STAGE(bufoff, gbase, voff) do { _Pragma("unroll") for (int _i = 0; _i < 2; ++_i) \
        __builtin_amdgcn_global_load_lds((const unsigned*)((const char*)(gbase) + (voff)[_i]), (PG8_LAS unsigned*)(lds + (bufoff) + ldsw + _i * 8192), 16, 0, 0); } while (0)
#define PG8_LDA(dst, b, h) do { _Pragma("unroll") for (int m = 0; m < 4; ++m) _Pragma("unroll") for (int k = 0; k < 2; ++k) dst[m][k] = *(const PG8_LAS bf16x8*)(lds + PG8_SA(b, h) + aoff + m * 2048 + k * 1024); } while (0)
#define PG8_LDB(dst, b, h) do { _Pragma("unroll") for (int n = 0; n < 2; ++n) _Pragma("unroll") for (int k = 0; k < 2; ++k) dst[n][k] = *(const PG8_LAS bf16x8*)(lds + PG8_SB(b, h) + boff + n * 2048 + k * 1024); } while (0)
#define PG8_MMA(ai, bj, At, Bt) do { __builtin_amdgcn_s_setprio(1); _Pragma("unroll") for (int m = 0; m < 4; ++m) _Pragma("unroll") for (int n = 0; n < 2; ++n) _Pragma("unroll") for (int k = 0; k < 2; ++k) \
        acc[ai][bj][m][n] = __builtin_amdgcn_mfma_f32_16x16x32_bf16(Bt[n][k], At[m][k], acc[ai][bj][m][n], 0, 0, 0); __builtin_amdgcn_s_setprio(0); } while (0)
#define PG8_WAIT_V(n) asm volatile("s_waitcnt vmcnt(" #n ")" ::: "memory")
#define PG8_WAIT_L(n) asm volatile("s_waitcnt lgkmcnt(" #n ")" ::: "memory")
#define PG8_BAR __builtin_amdgcn_s_barrier()
#define PG8_SCHED __builtin_amdgcn_sched_barrier(0)
    Unit cur, nxt; int ui = 0;
    if (!S.next(0, cur)) return;
    f32x4 acc[2][2][4][2];
#pragma unroll
    for (int a = 0; a < 2; ++a)
#pragma unroll
        for (int b = 0; b < 2; ++b)
#pragma unroll
            for (int m = 0; m < 4; ++m)
#pragma unroll
                for (int n = 0; n < 2; ++n) acc[a][b][m][n] = (f32x4){0.f, 0.f, 0.f, 0.f};
    bf16x8 At[4][2], B0[2][2], B1[2][2];
    const char* cA = (const char*)g.A + (size_t)cur.pm * tstep; const char* cB = (const char*)g.Bt + (size_t)cur.pn * tstep;
    S.a_ready(cur);
    if constexpr (SP2) {
        PG8_STAGE(PG8_SB(0, 0), cB, voffB); PG8_STAGE(PG8_SB(0, 1), cB + hstep, voffB); PG8_STAGE(PG8_SA(0, 0), cA, voffA); PG8_STAGE(PG8_SA(0, 1), cA + hstep, voffA);
        if (wr == 1) PG8_BAR;
        PG8_WAIT_V(2); PG8_BAR;
        PG8_STAGE(PG8_SB(1, 0), cB + kstep, voffB); PG8_STAGE(PG8_SA(1, 0), cA + kstep, voffA); PG8_STAGE(PG8_SB(1, 1), cB + hstep + kstep, voffB);
        PG8_WAIT_V(6); PG8_BAR;
    } else {
        PG8_STAGE(PG8_SB(0, 0), cB, voffB); PG8_STAGE(PG8_SA(0, 0), cA, voffA); PG8_STAGE(PG8_SB(0, 1), cB + hstep, voffB); PG8_STAGE(PG8_SA(0, 1), cA + hstep, voffA);
        if (wr == 1) PG8_BAR;
        PG8_WAIT_V(4); PG8_BAR;
        PG8_STAGE(PG8_SB(1, 0), cB + kstep, voffB); PG8_STAGE(PG8_SA(1, 0), cA + kstep, voffA); PG8_STAGE(PG8_SB(1, 1), cB + hstep + kstep, voffB);
        PG8_WAIT_V(6); PG8_BAR;
    }
    for (;;) {
        const bool has_next = S.next(ui + 1, nxt);
        const char* nA = has_next ? (const char*)g.A + (size_t)nxt.pm * tstep : cA; const char* nB = has_next ? (const char*)g.Bt + (size_t)nxt.pn * tstep : cB;
        for (int t = 0; t < nt; t += 2) {
            const bool last = (t == nt - 2);
            const char* a1 = cA + (size_t)(t + 1) * kstep;
            const char* a2 = last ? nA : cA + (size_t)(t + 2) * kstep; const char* b2 = last ? nB : cB + (size_t)(t + 2) * kstep;
            const char* a3 = a2 + kstep; const char* b3 = b2 + kstep;
            if (last && has_next) S.a_ready(nxt);
            if constexpr (SP2) {
            PG8_LDB(B0, 0, 0); PG8_LDB(B1, 0, 1); PG8_SCHED; if (cur.mask & 1) PG8_LDA(At, 0, 0); PG8_STAGE(PG8_SA(1, 1), a1 + hstep, voffA);
            PG8_WAIT_V(8); PG8_WAIT_L(0); PG8_BAR; if (cur.mask & 1) { PG8_MMA(0, 0, At, B0); PG8_MMA(0, 1, At, B1); } PG8_BAR; PG8_SCHED;
            if (cur.mask & 2) PG8_LDA(At, 0, 1); PG8_STAGE(PG8_SB(0, 0), b2, voffB); PG8_STAGE(PG8_SB(0, 1), b2 + hstep, voffB); PG8_STAGE(PG8_SA(0, 0), a2, voffA);
            PG8_WAIT_V(8); PG8_WAIT_L(0); PG8_BAR; if (cur.mask & 2) { PG8_MMA(1, 0, At, B0); PG8_MMA(1, 1, At, B1); } PG8_BAR; PG8_SCHED;
            PG8_LDB(B0, 1, 0); PG8_LDB(B1, 1, 1); PG8_SCHED; if (cur.mask & 1) PG8_LDA(At, 1, 0); PG8_STAGE(PG8_SA(0, 1), a2 + hstep, voffA);
            PG8_WAIT_V(8); PG8_WAIT_L(0); PG8_BAR; if (cur.mask & 1) { PG8_MMA(0, 0, At, B0); PG8_MMA(0, 1, At, B1); } PG8_BAR; PG8_SCHED;
            if (cur.mask & 2) PG8_LDA(At, 1, 1); PG8_STAGE(PG8_SB(1, 0), b3, voffB); PG8_STAGE(PG8_SB(1, 1), b3 + hstep, voffB); PG8_STAGE(PG8_SA(1, 0), a3, voffA);
            PG8_WAIT_V(8); PG8_WAIT_L(0); PG8_BAR; if (cur.mask & 2) { PG8_MMA(1, 0, At, B0); PG8_MMA(1, 1, At, B1); } PG8_BAR; PG8_SCHED;
            } else {
            PG8_LDB(B0, 0, 0); PG8_SCHED; PG8_LDA(At, 0, 0); PG8_STAGE(PG8_SA(1, 1), a1 + hstep, voffA);
            PG8_WAIT_L(8); PG8_BAR; PG8_WAIT_L(0); PG8_MMA(0, 0, At, B0); PG8_BAR; PG8_SCHED;
            PG8_LDB(B1, 0, 1); PG8_STAGE(PG8_SB(0, 0), b2, voffB);
            PG8_BAR; PG8_WAIT_L(0); PG8_MMA(0, 1, At, B1); PG8_BAR;
            PG8_LDA(At, 0, 1); PG8_STAGE(PG8_SA(0, 0), a2, voffA);
            PG8_BAR; PG8_WAIT_L(0); PG8_MMA(1, 0, At, B0); PG8_BAR; PG8_SCHED;
            PG8_STAGE(PG8_SB(0, 1), b2 + hstep, voffB);
            PG8_WAIT_V(6); PG8_BAR; PG8_MMA(1, 1, At, B1); PG8_BAR;
            PG8_LDB(B0, 1, 0); PG8_SCHED; PG8_LDA(At, 1, 0); PG8_STAGE(PG8_SA(0, 1), a2 + hstep, voffA);
            PG8_WAIT_L(8); PG8_BAR; PG8_WAIT_L(0); PG8_MMA(0, 0, At, B0); PG8_BAR; PG8_SCHED;
            PG8_LDB(B1, 1, 1); PG8_STAGE(PG8_SB(1, 0), b3, voffB);
            PG8_BAR; PG8_WAIT_L(0); PG8_MMA(0, 1, At, B1); PG8_BAR;
            PG8_LDA(At, 1, 1); PG8_STAGE(PG8_SA(1, 0), a3, voffA);
            PG8_BAR; PG8_WAIT_L(0); PG8_MMA(1, 0, At, B0); PG8_BAR; PG8_SCHED;
            PG8_STAGE(PG8_SB(1, 1), b3 + hstep, voffB);
            PG8_WAIT_V(6); PG8_BAR; PG8_MMA(1, 1, At, B1); PG8_BAR;
            }
        }
        if constexpr (ALIGN_EPI) { if (wr == 0) PG8_BAR; }
        if constexpr (!Epi::AFTER_DRAIN) { E(acc, cur, wr, wc, fr, fq); S.done(cur); }
        if (!has_next) break;
#pragma unroll
        for (int a = 0; a < 2; ++a)
#pragma unroll
            for (int b = 0; b < 2; ++b)
#pragma unroll
                for (int m = 0; m < 4; ++m)
#pragma unroll
                    for (int n = 0; n < 2; ++n) acc[a][b][m][n] = (f32x4){0.f, 0.f, 0.f, 0.f};
        cur = nxt; cA = nA; cB = nB; ++ui;
        if constexpr (ALIGN_EPI) { if (wr == 1) PG8_BAR; }
    }
    PG8_WAIT_V(0);
    if constexpr (!ALIGN_EPI) { if (wr == 0) PG8_BAR; }
    PG8_BAR;
    if constexpr (Epi::AFTER_DRAIN) { E.fused(acc, cur, wr, wc, fr, fq, lds, wid, lane); S.done(cur); }
#undef PG8_SA
#undef PG8_SB
#undef PG8_STAGE
#undef PG8_LDA
#undef PG8_LDB
#undef PG8_MMA
#undef PG8_WAIT_V
#undef PG8_WAIT_L
#undef PG8_BAR
#undef PG8_SCHED
}

}

#define LAS __attribute__((address_space(3)))

__device__ __forceinline__ void transpose_item(const float* W, int K, int N, bf16_t* WT, int k0, int ns0, int nd0, LAS float* scr, int lane) {
    float v[32];
    const float* wp = W + (size_t)(k0 + (lane >> 5)) * N + ns0 + (lane & 31);
#pragma unroll
    for (int i = 0; i < 32; ++i) v[i] = wp[(size_t)(2 * i) * N];
#pragma unroll
    for (int i = 0; i < 32; ++i) scr[(2 * i + (lane >> 5)) * 33 + (lane & 31)] = v[i];
    asm volatile("s_waitcnt lgkmcnt(0)" ::: "memory");
    const int c = lane & 7;
#pragma unroll
    for (int j = 0; j < 4; ++j) { const int n = (lane >> 3) + 8 * j; const LAS float* s = scr + (8 * c) * 33 + n;
        pg8::u32x4 o; o.x = pg8::cvt_pk_bf16(s[0 * 33], s[1 * 33]); o.y = pg8::cvt_pk_bf16(s[2 * 33], s[3 * 33]); o.z = pg8::cvt_pk_bf16(s[4 * 33], s[5 * 33]); o.w = pg8::cvt_pk_bf16(s[6 * 33], s[7 * 33]);
        *(pg8::u32x4*)(WT + (size_t)(nd0 + n) * K + k0 + 8 * c) = o; }
    asm volatile("s_waitcnt lgkmcnt(0)" ::: "memory");
}
__device__ __forceinline__ void prologue_phase(LAS unsigned char* lds, int vcu, int G) {
    const int tid = tid_opaque(), lane = tid & 63, wave = __builtin_amdgcn_readfirstlane(tid >> 6);
    {
        LAS float* sc = (LAS float*)lds;
        LAS float* red = (LAS float*)(lds + 20480);
        const float* cctx = PIN(6); const float* cc = PIN(2);
        for (int i = tid; i < 5 * D; i += NWAVES * 64) { const int r = i / D, k = i % D; const float v = r == 0 ? cctx[k] : cc[(r - 1) * D + k]; sc[i] = v / (1.f + __expf(-v)); }
        __syncthreads();
        constexpr int KQ = 16, NBLK = NMOD * D / 128, NIT = DEPTH * NBLK * KQ;
        int it0 = (int)((long)vcu * NIT / G); const int it1 = (int)((long)(vcu + 1) * NIT / G);
        while (it0 < it1) {
            const int blk = it0 / KQ, ke = it1 < (blk + 1) * KQ ? it1 : (blk + 1) * KQ, nk = ke - it0;
            const int l = blk / NBLK, n0 = (blk % NBLK) * 128, kbeg = (it0 % KQ) * (D / KQ);
            const float* w = PIN(7) + (size_t)l * D * NMOD * D + n0 + (lane & 31) * 4;
            const int kb = kbeg + wave * (nk * 8) + (lane >> 5), nl = nk * 4;
            pg8::f32x4 a[5];
#pragma unroll
            for (int r = 0; r < 5; ++r) a[r] = (pg8::f32x4){0.f, 0.f, 0.f, 0.f};
#pragma unroll 1
            for (int i0 = 0; i0 < nl; i0 += 12) {
                pg8::f32x4 wv[12];
#pragma unroll
                for (int i = 0; i < 12; ++i) { const int ii = i0 + i < nl ? i0 + i : nl - 1; wv[i] = *(const pg8::f32x4*)(w + (size_t)(kb + 2 * ii) * NMOD * D); }
#pragma unroll
                for (int i = 0; i < 12; ++i) { const bool ok = i0 + i < nl; const int k = kb + 2 * (ok ? i0 + i : nl - 1);
#pragma unroll
                    for (int r = 0; r < 5; ++r) a[r] += wv[i] * (ok ? sc[r * D + k] : 0.f); }
            }
#pragma unroll
            for (int r = 0; r < 5; ++r) {
#pragma unroll
                for (int e = 0; e < 4; ++e) a[r][e] += __shfl_xor(a[r][e], 32);
                if (lane < 32) *(LAS pg8::f32x4*)(red + (wave * 5 + r) * 128 + lane * 4) = a[r]; }
            __syncthreads();
            const float* bada = PIN(8); float* modo = (float*)(PWS + WS_MOD);
            for (int o = tid; o < 5 * 128; o += NWAVES * 64) { const int r = o / 128, c = o % 128; float s = kbeg == 0 ? bada[l * NMOD * D + n0 + c] : 0.f;
#pragma unroll
                for (int w8 = 0; w8 < 8; ++w8) s += red[(w8 * 5 + r) * 128 + c];
                (void)__hip_atomic_fetch_add(modo + ((size_t)l * 5 + r) * NMOD * D + n0 + c, s, __ATOMIC_RELAXED, __HIP_MEMORY_SCOPE_AGENT); }
            __syncthreads();
            it0 = ke;
        }
        __syncthreads();
    }
    {
        LAS float* scr = (LAS float*)(lds + wave * 16384);
        const int gw = vcu * NWAVES + wave, NGW = G * NWAVES;
        constexpr int I_FIN = (D / 64) * (2 * FF / 32), I_FOUT = (FF / 64) * (D / 32), I_WIN = (D / 64) * (INC / 32), I_WOUT = (D / 64) * (D / 32);
        constexpr int I_LAYER = 2 * I_FIN + 2 * I_FOUT + I_WIN + I_WOUT;
        for (int it = gw; it < DEPTH * I_LAYER; it += NGW) {
            const int l = it / I_LAYER; int r = it % I_LAYER;
            unsigned char* wl = PWS + WS_W + (size_t)l * WL_STRIDE;
            int which = 0;
            if (r >= I_FIN) { r -= I_FIN; which = 1; if (r >= I_FOUT) { r -= I_FOUT; which = 2; if (r >= I_WIN) { r -= I_WIN; which = 3; if (r >= I_WOUT) { r -= I_WOUT; which = 4; if (r >= I_FIN) { r -= I_FIN; which = 5; } } } } }
            if (which == 0 || which == 4) {
                const float* W = (which == 0 ? PIN(10) : PIN(31)) + (size_t)l * D * 2 * FF; bf16_t* WT = (bf16_t*)(wl + (which == 0 ? WO_W1A : WO_W1B));
                const int nblk = 2 * FF / 32, kb = r / nblk, nd0 = (r % nblk) * 32; const int pn = nd0 / 256, c = nd0 % 256, bj = c / 128, x = c % 128;
                transpose_item(W, D, 2 * FF, WT, kb * 64, bj * FF + 128 * pn + x, nd0, scr, lane);
            } else if (which == 1 || which == 5) {
                const float* W = (which == 1 ? PIN(11) : PIN(32)) + (size_t)l * FF * D; bf16_t* WT = (bf16_t*)(wl + (which == 1 ? WO_W2A : WO_W2B));
                const int nblk = D / 32, kb = r / nblk, nd0 = (r % nblk) * 32;
                transpose_item(W, FF, D, WT, kb * 64, nd0, nd0, scr, lane);
            } else if (which == 2) {
                const float* W = PIN(13) + (size_t)l * D * INC; bf16_t* WT = (bf16_t*)(wl + WO_WIN);
                const int nblk = INC / 32, kb = r / nblk, nd0 = (r % nblk) * 32; const int pn = nd0 / 256, c = nd0 % 256;
                int ns0 = nd0; if (pn >= 1 && pn <= 4) { const int bj = c / 128, wc = (c % 128) / 32; ns0 = 256 * pn + 64 * wc + 32 * bj; }
                transpose_item(W, D, INC, WT, kb * 64, ns0, nd0, scr, lane);
            } else {
                const float* W = PIN(14) + (size_t)l * D * D; bf16_t* WT = (bf16_t*)(wl + WO_WOUT);
                const int nblk = D / 32, kb = r / nblk, nd0 = (r % nblk) * 32;
                transpose_item(W, D, D, WT, kb * 64, nd0, nd0, scr, lane);
            }
        }
    }
    const int gt = vcu * (NWAVES * 64) + tid, NGT = G * NWAVES * 64;
    const int gtr = (G - 1 - vcu) * (NWAVES * 64) + tid;
    {
        constexpr int NSLOT = DEPTH * 4 * 128 * 128, CTOT = DB * DEPTH * PAST * NH * HD;
        static_assert(DEPTH * SSMW * SSMW == NSLOT && CTOT == 8 * NSLOT && DEPTH * 3 * MT <= 2 * NSLOT, "slot loop layout");
        const float* gws = PIN(28); bf16_t* wsb = (bf16_t*)(PWS + WS_WSB); const float* glw = PIN(23); bf16_t* glt = (bf16_t*)(PWS + WS_GLT); float* rs = (float*)(PWS + WS_ROWSS);
        const float* cki = PIN(3); const float* cvi = PIN(4); bf16_t* cko = (bf16_t*)(PWS + WS_CK); bf16_t* cvo = (bf16_t*)(PWS + WS_CVT);
        for (int sl = gt; sl < NSLOT; sl += NGT) {
            const float w0 = gws[sl];
            const int gk = sl % SSMW, gn = (sl / SSMW) % SSMW, gl = sl / (SSMW * SSMW);
            const float g0 = glw[((size_t)gl * SSMW + gk) * SSMW + gn];
            float kv[8], vv[8];
#pragma unroll
            for (int j = 0; j < 8; ++j) { kv[j] = cki[sl + j * NSLOT]; vv[j] = cvi[sl + j * NSLOT]; }
            wsb[sl] = f2bf(w0); glt[sl] = f2bf(g0);
            rs[sl] = 0.f; if (sl + NSLOT < DEPTH * 3 * MT) rs[sl + NSLOT] = 0.f;
#pragma unroll
            for (int j = 0; j < 8; ++j) { const int idx = sl + j * NSLOT;
                const int d = idx % HD, h = (idx / HD) % NH, t = (idx / (HD * NH)) % PAST, l = (idx / (HD * NH * PAST)) % DEPTH, b = idx / (HD * NH * PAST * DEPTH);
                cko[((((size_t)l * DB + b) * NH + h) * PAST + t) * HD + d] = f2bf(kv[j]);
                cvo[((((size_t)l * DB + b) * NH + h) * HD + d) * PAST + t] = f2bf(vv[j]); }
        }
    }
    for (int idx = gtr; idx < DEPTH * 2 * SG * SP; idx += NGT) {
        const int g = (idx / SP) % SG, ld = idx / (SP * SG);
        const float lre = PIN(15)[idx], lim = PIN(16)[idx];
        const float dt = expf(PIN(17)[ld * SG + g]);
        const float er = expf(lre * dt); float sn, cs; sincosf(lim * dt, &sn, &cs);
        const float br = er * cs, bi = er * sn;
        const float nr = br - 1.f, ni = bi, den = lre * lre + lim * lim;
        const float cr = (nr * lre + ni * lim) / den, ci = (ni * lre - nr * lim) / den;
        float2* lb = (float2*)(PWS + WS_SSMP); float2* bb = (float2*)(PWS + WS_SSMP + 64 * 1024);
        lb[idx] = make_float2(br, bi);
        const float* bre = PIN(18); const float* bim = PIN(19);
        float bxr[SC], bxi[SC];
#pragma unroll
        for (int c = 0; c < SC; ++c) { const float xr = bre[(size_t)idx * SC + c], xi = bim[(size_t)idx * SC + c];
            bxr[c] = cr * xr - ci * xi; bxi[c] = cr * xi + ci * xr; bb[(size_t)idx * SC + c] = make_float2(bxr[c], bxi[c]); }
        const int pp = idx % SP; pg8::u32x4* bmf = (pg8::u32x4*)(PWS + WS_BMF) + ((size_t)(idx / SP) * 8 + pp / 8) * 64;
#pragma unroll
        for (int part = 0; part < 2; ++part)
#pragma unroll
            for (int q4 = 0; q4 < 4; ++q4) { const int c0 = 8 * (q4 & 1); pg8::u32x4 w;
                w.x = pg8::cvt_pk_bf16(part ? bxi[c0 + 0] : bxr[c0 + 0], part ? bxi[c0 + 1] : bxr[c0 + 1]); w.y = pg8::cvt_pk_bf16(part ? bxi[c0 + 2] : bxr[c0 + 2], part ? bxi[c0 + 3] : bxr[c0 + 3]);
                w.z = pg8::cvt_pk_bf16(part ? bxi[c0 + 4] : bxr[c0 + 4], part ? bxi[c0 + 5] : bxr[c0 + 5]); w.w = pg8::cvt_pk_bf16(part ? bxi[c0 + 6] : bxr[c0 + 6], part ? bxi[c0 + 7] : bxr[c0 + 7]);
                bmf[16 * q4 + 2 * (pp % 8) + part] = w; }
    }
    {
        const float* cre0 = PIN(20); const float* cim0 = PIN(21); pg8::u32x4* cff = (pg8::u32x4*)(PWS + WS_CFF);
        for (int idx = gtr; idx < DEPTH * 2 * SG * 4 * 64; idx += NGT) {
            const int ln = idx & 63, ks = (idx >> 6) & 3, ldg = idx >> 8, rr = ln & 15, qq = ln >> 4;
            const float* a = cre0 + ((size_t)ldg * SC + rr) * SP + 16 * ks + 4 * qq; const float* b = cim0 + ((size_t)ldg * SC + rr) * SP + 16 * ks + 4 * qq;
            pg8::u32x4 w; w.x = pg8::cvt_pk_bf16(a[0], -b[0]); w.y = pg8::cvt_pk_bf16(a[1], -b[1]); w.z = pg8::cvt_pk_bf16(a[2], -b[2]); w.w = pg8::cvt_pk_bf16(a[3], -b[3]);
            cff[idx] = w;
        }
    }
}
__device__ __forceinline__ void x0_phase(int vcu, int G) {
    const int tid = tid_opaque(), lane = tid & 63, wave = __builtin_amdgcn_readfirstlane(tid >> 6);
    const int gw = vcu * NWAVES + wave, NGW = G * NWAVES;
    const float* modb = (const float*)(PWS + WS_MOD);
    {
        const float* gain = PIN(9); const float* xp = PIN(0); const float* xs = PIN(1); bf16_t* Hb = (bf16_t*)(PWS + WS_H); float* rs = (float*)(PWS + WS_ROWSS);
        for (int row = gw; row < MT; row += NGW) {
            const float* src = row < MC ? xp + (size_t)row * D : xs + (size_t)(row - MC) * D;
            const float* sc = modb + (size_t)modrow(row) * NMOD * D + 1 * D;
            float4 v[4]; float ss = 0.f;
#pragma unroll
            for (int j = 0; j < 4; ++j) { v[j] = ((const float4*)src)[lane + 64 * j]; ss += v[j].x * v[j].x + v[j].y * v[j].y + v[j].z * v[j].z + v[j].w * v[j].w; }
            ss = wave_sum(ss);
            if (lane == 0) rs[row] = ss;
            bf16_t* Hr = Hb + (size_t)row * D; _Float16* Xr = (_Float16*)((unsigned char*)POUT + XH_OUT_OFF) + (size_t)row * D;
#pragma unroll
            for (int j = 0; j < 4; ++j) {
                const int c0 = (lane + 64 * j) * 4;
                { pg8::f32x4 xv; xv[0] = v[j].x; xv[1] = v[j].y; xv[2] = v[j].z; xv[3] = v[j].w; *(pg8::f16x4*)(Xr + c0) = __builtin_convertvector(xv, pg8::f16x4); }
                const float4 g4 = *(const float4*)(gain + c0), s4 = *(const float4*)(sc + c0);
                uint2 o;
                o.x = pg8::cvt_pk_bf16(v[j].x * g4.x * (1.f + s4.x), v[j].y * g4.y * (1.f + s4.y));
                o.y = pg8::cvt_pk_bf16(v[j].z * g4.z * (1.f + s4.z), v[j].w * g4.w * (1.f + s4.w));
                *(uint2*)(Hr + c0) = o;
            }
        }
    }
    {
        float* wn = (float*)(PWS + WS_WN);
        const int gt = vcu * (NWAVES * 64) + tid, NGT = G * NWAVES * 64;
        for (int idx = gt; idx < DEPTH * 3 * 5 * D; idx += NGT) {
            const int c = idx % D, mr = (idx / D) % 5, j = (idx / (5 * D)) % 3, l = idx / (15 * D);
            const float g = (j == 0 ? PIN(9) : j == 1 ? PIN(12) : PIN(30))[l * D + c];
            wn[idx] = g * (1.f + modb[((size_t)l * 5 + mr) * NMOD * D + (3 * j + 1) * D + c]);
        }
    }
    {
        float* shw = (float*)(PWS + WS_SHW);
        constexpr int TPL = (2 * 2 * FF + INC) / 16;
        const int r = lane & 15, q4 = lane >> 4;
        for (int it = gw; it < DEPTH * TPL; it += NGW) {
            const int l = it / TPL, t = it % TPL;
            int j, n0, N; size_t wo;
            if (t < 2 * FF / 16) { j = 0; n0 = t * 16; wo = WO_W1A; N = 2 * FF; } else if (t < (2 * FF + INC) / 16) { j = 1; n0 = (t - 2 * FF / 16) * 16; wo = WO_WIN; N = INC; } else { j = 2; n0 = (t - (2 * FF + INC) / 16) * 16; wo = WO_W1B; N = 2 * FF; }
            const bf16_t* wt = (const bf16_t*)(PWS + WS_W + (size_t)l * WL_STRIDE + wo) + (size_t)(n0 + r) * D + 8 * q4;
            const float* sh = modb + ((size_t)l * 5 + (r < 5 ? r : 4)) * NMOD * D + (3 * j) * D + 8 * q4;
            const bool valid = r < 5;
            pg8::f32x4 ah = (pg8::f32x4){0.f, 0.f, 0.f, 0.f}, al = ah;
#pragma unroll 4
            for (int ks = 0; ks < 32; ++ks) {
                const pg8::bf16x8 b = *(const pg8::bf16x8*)(wt + 32 * ks);
                const pg8::f32x4 s0 = *(const pg8::f32x4*)(sh + 32 * ks), s1 = *(const pg8::f32x4*)(sh + 32 * ks + 4);
                const float sv[8] = {s0[0], s0[1], s0[2], s0[3], s1[0], s1[1], s1[2], s1[3]};
                unsigned hw[4], lw[4];
#pragma unroll
                for (int i = 0; i < 4; ++i) { const unsigned hp = pg8::cvt_pk_bf16(sv[2 * i], sv[2 * i + 1]);
                    const unsigned lp = pg8::cvt_pk_bf16(sv[2 * i] - __uint_as_float(hp << 16), sv[2 * i + 1] - __uint_as_float(hp & 0xffff0000u));
                    hw[i] = valid ? hp : 0u; lw[i] = valid ? lp : 0u; }
                pg8::u32x4 hv, lv; hv.x = hw[0]; hv.y = hw[1]; hv.z = hw[2]; hv.w = hw[3]; lv.x = lw[0]; lv.y = lw[1]; lv.z = lw[2]; lv.w = lw[3];
                ah = __builtin_amdgcn_mfma_f32_16x16x32_bf16(__builtin_bit_cast(pg8::bf16x8, hv), b, ah, 0, 0, 0);
                al = __builtin_amdgcn_mfma_f32_16x16x32_bf16(__builtin_bit_cast(pg8::bf16x8, lv), b, al, 0, 0, 0);
            }
            const pg8::f32x4 sum = ah + al;
            float* o = shw + (size_t)l * SHW_LAYER + (j == 0 ? 0 : j == 1 ? SHW_J1 : SHW_J2) + n0 + r;
            if (q4 == 0) { o[0] = sum[0]; o[(size_t)N] = sum[1]; o[(size_t)2 * N] = sum[2]; o[(size_t)3 * N] = sum[3]; }
            else if (q4 == 1) o[(size_t)4 * N] = sum[0];
        }
    }
}
typedef short bf16x8 __attribute__((ext_vector_type(8)));
typedef float f32x4 __attribute__((ext_vector_type(4)));
typedef unsigned u32x4 __attribute__((ext_vector_type(4)));
typedef float f32x2 __attribute__((ext_vector_type(2)));
typedef unsigned u32x2 __attribute__((ext_vector_type(2)));
constexpr float QK_SCALE_LOG2E = 0.125f * 1.4426950408889634f;
constexpr int AK_STRIDE = 72, AV_STRIDE = 264, ATT_V_OFF = 256 * AK_STRIDE * 2, ATT_B_OFF = ATT_V_OFF + 64 * AV_STRIDE * 2;
__device__ __forceinline__ bf16x8 ldg8(const bf16_t* p) { return *(const bf16x8*)p; }
__device__ __forceinline__ void softmax_pv_step(const f32x4 sa, const f32x4 sb, float& m, float& lsum, f32x4 (&o)[4], const bf16x8 (&vf)[4]) {
    const float mx8 = fmaxf(fmaxf(fmaxf(sa[0], sa[1]), fmaxf(sa[2], sa[3])), fmaxf(fmaxf(sb[0], sb[1]), fmaxf(sb[2], sb[3])));
    if (__builtin_amdgcn_ballot_w64(mx8 > m + 8.f) != 0ull) {
        float mx = fmaxf(mx8, __shfl_xor(mx8, 16)); mx = fmaxf(mx, __shfl_xor(mx, 32));
        const float mn = fmaxf(m, mx), alpha = __builtin_amdgcn_exp2f(m - mn); m = mn; lsum *= alpha;
#pragma unroll
        for (int dt = 0; dt < 4; ++dt) o[dt] = o[dt] * alpha;
    }
    float p[8];
#pragma unroll
    for (int i = 0; i < 4; ++i) { p[i] = __builtin_amdgcn_exp2f(sa[i] - m); p[4 + i] = __builtin_amdgcn_exp2f(sb[i] - m); }
    lsum += ((p[0] + p[1]) + (p[2] + p[3])) + ((p[4] + p[5]) + (p[6] + p[7]));
    u32x4 pw; pw.x = pg8::cvt_pk_bf16(p[0], p[1]); pw.y = pg8::cvt_pk_bf16(p[2], p[3]); pw.z = pg8::cvt_pk_bf16(p[4], p[5]); pw.w = pg8::cvt_pk_bf16(p[6], p[7]);
    const bf16x8 pf = __builtin_bit_cast(bf16x8, pw);
#pragma unroll
    for (int dt = 0; dt < 4; ++dt) o[dt] = __builtin_amdgcn_mfma_f32_16x16x32_bf16(vf[dt], pf, o[dt], 0, 0, 0);
}
__device__ __forceinline__ void softmax_pv_step2(const f32x4 sa, const f32x4 sb, float& m, float& lsum, f32x4 (&o)[4], const bf16x8 (&vf)[4],
                                                 const f32x4 ta, const f32x4 tb, float& m2, float& l2, f32x4 (&o2)[4], const bf16x8 (&vf2)[4]) {
    const float mx8 = fmaxf(fmaxf(fmaxf(sa[0], sa[1]), fmaxf(sa[2], sa[3])), fmaxf(fmaxf(sb[0], sb[1]), fmaxf(sb[2], sb[3])));
    const float nx8 = fmaxf(fmaxf(fmaxf(ta[0], ta[1]), fmaxf(ta[2], ta[3])), fmaxf(fmaxf(tb[0], tb[1]), fmaxf(tb[2], tb[3])));
    if (__builtin_amdgcn_ballot_w64(mx8 > m + 8.f || nx8 > m2 + 8.f) != 0ull) {
        float mx = fmaxf(mx8, __shfl_xor(mx8, 16)); mx = fmaxf(mx, __shfl_xor(mx, 32));
        float nx = fmaxf(nx8, __shfl_xor(nx8, 16)); nx = fmaxf(nx, __shfl_xor(nx, 32));
        const float mn = fmaxf(m, mx), alpha = __builtin_amdgcn_exp2f(m - mn); m = mn; lsum *= alpha;
        const float nn = fmaxf(m2, nx), beta = __builtin_amdgcn_exp2f(m2 - nn); m2 = nn; l2 *= beta;
#pragma unroll
        for (int dt = 0; dt < 4; ++dt) { o[dt] = o[dt] * alpha; o2[dt] = o2[dt] * beta; }
    }
    float p[8], q[8];
#pragma unroll
    for (int i = 0; i < 4; ++i) { p[i] = __builtin_amdgcn_exp2f(sa[i] - m); p[4 + i] = __builtin_amdgcn_exp2f(sb[i] - m); q[i] = __builtin_amdgcn_exp2f(ta[i] - m2); q[4 + i] = __builtin_amdgcn_exp2f(tb[i] - m2); }
    lsum += ((p[0] + p[1]) + (p[2] + p[3])) + ((p[4] + p[5]) + (p[6] + p[7]));
    l2 += ((q[0] + q[1]) + (q[2] + q[3])) + ((q[4] + q[5]) + (q[6] + q[7]));
    u32x4 pw; pw.x = pg8::cvt_pk_bf16(p[0], p[1]); pw.y = pg8::cvt_pk_bf16(p[2], p[3]); pw.z = pg8::cvt_pk_bf16(p[4], p[5]); pw.w = pg8::cvt_pk_bf16(p[6], p[7]);
    u32x4 qw; qw.x = pg8::cvt_pk_bf16(q[0], q[1]); qw.y = pg8::cvt_pk_bf16(q[2], q[3]); qw.z = pg8::cvt_pk_bf16(q[4], q[5]); qw.w = pg8::cvt_pk_bf16(q[6], q[7]);
    const bf16x8 pf = __builtin_bit_cast(bf16x8, pw), qf = __builtin_bit_cast(bf16x8, qw);
#pragma unroll
    for (int dt = 0; dt < 4; ++dt) { o[dt] = __builtin_amdgcn_mfma_f32_16x16x32_bf16(vf[dt], pf, o[dt], 0, 0, 0); o2[dt] = __builtin_amdgcn_mfma_f32_16x16x32_bf16(vf2[dt], qf, o2[dt], 0, 0, 0); }
}
__device__ __forceinline__ void qk_tiles(const bf16x8 a0, const bf16x8 a1, const bf16x8 b0, const bf16x8 b1, const bf16x8 (&qf)[2], f32x4& sa, f32x4& sb) {
    sa = (f32x4){0.f, 0.f, 0.f, 0.f}; sb = (f32x4){0.f, 0.f, 0.f, 0.f};
    sa = __builtin_amdgcn_mfma_f32_16x16x32_bf16(a0, qf[0], sa, 0, 0, 0); sa = __builtin_amdgcn_mfma_f32_16x16x32_bf16(a1, qf[1], sa, 0, 0, 0);
    sb = __builtin_amdgcn_mfma_f32_16x16x32_bf16(b0, qf[0], sb, 0, 0, 0); sb = __builtin_amdgcn_mfma_f32_16x16x32_bf16(b1, qf[1], sb, 0, 0, 0);
}
__device__ __forceinline__ void attn_stage_kv(LAS unsigned char* lds, const bf16_t* ksrc, int krs, const bf16_t* vsrc, int tid) {
    LAS bf16_t* kl = (LAS bf16_t*)lds; LAS bf16_t* vl = (LAS bf16_t*)(lds + ATT_V_OFF);
#pragma unroll
    for (int i = 0; i < 4; ++i) { const int c = tid + NWAVES * 64 * i, row = c >> 3, part = c & 7;
        *(LAS bf16x8*)(kl + row * AK_STRIDE + part * 8) = ldg8(ksrc + (size_t)row * krs + part * 8); }
#pragma unroll
    for (int i = 0; i < 4; ++i) { const int c = tid + NWAVES * 64 * i, d = c >> 5, part = c & 31;
        *(LAS bf16x8*)(vl + d * AV_STRIDE + part * 8) = ldg8(vsrc + (size_t)d * 256 + part * 8); }
}
__device__ __forceinline__ void attn_lds_logits(const LAS unsigned char* lds, int k0, const bf16x8 (&qf)[2], f32x4& sa, f32x4& sb, bf16x8 (&vf)[4], int r, int q4) {
    const LAS bf16_t* ka = (const LAS bf16_t*)lds + (k0 + 8 * (r >> 2) + (r & 3)) * AK_STRIDE + 8 * q4;
    const LAS bf16_t* vl = (const LAS bf16_t*)(lds + ATT_V_OFF) + r * AV_STRIDE + 8 * q4 + k0;
    const bf16x8 a0 = *(const LAS bf16x8*)ka, a1 = *(const LAS bf16x8*)(ka + 32), b0 = *(const LAS bf16x8*)(ka + 4 * AK_STRIDE), b1 = *(const LAS bf16x8*)(ka + 4 * AK_STRIDE + 32);
#pragma unroll
    for (int dt = 0; dt < 4; ++dt) vf[dt] = *(const LAS bf16x8*)(vl + dt * 16 * AV_STRIDE);
    qk_tiles(a0, a1, b0, b1, qf, sa, sb);
    sa = sa * QK_SCALE_LOG2E; sb = sb * QK_SCALE_LOG2E;
}
__device__ __forceinline__ void attn_lds_block(const LAS unsigned char* lds, int k0, const bf16x8 (&qf)[2], float& m, float& lsum, f32x4 (&o)[4], int r, int q4) {
    const LAS bf16_t* ka = (const LAS bf16_t*)lds + (k0 + 8 * (r >> 2) + (r & 3)) * AK_STRIDE + 8 * q4;
    const LAS bf16_t* vl = (const LAS bf16_t*)(lds + ATT_V_OFF) + r * AV_STRIDE + 8 * q4 + k0;
    const bf16x8 a0 = *(const LAS bf16x8*)ka, a1 = *(const LAS bf16x8*)(ka + 32), b0 = *(const LAS bf16x8*)(ka + 4 * AK_STRIDE), b1 = *(const LAS bf16x8*)(ka + 4 * AK_STRIDE + 32);
    bf16x8 vf[4];
#pragma unroll
    for (int dt = 0; dt < 4; ++dt) vf[dt] = *(const LAS bf16x8*)(vl + dt * 16 * AV_STRIDE);
    f32x4 sa, sb; qk_tiles(a0, a1, b0, b1, qf, sa, sb);
    sa = sa * QK_SCALE_LOG2E; sb = sb * QK_SCALE_LOG2E;
    softmax_pv_step(sa, sb, m, lsum, o, vf);
}
__device__ __forceinline__ void attn_merge(float& m, float& lsum, f32x4 (&o)[4], const float m2, const float l2, const f32x4 (&o2)[4]) {
    const float mn = fmaxf(m, m2), fa = __builtin_amdgcn_exp2f(m - mn), fb = __builtin_amdgcn_exp2f(m2 - mn);
    m = mn; lsum = lsum * fa + l2 * fb;
#pragma unroll
    for (int dt = 0; dt < 4; ++dt) o[dt] = o[dt] * fa + o2[dt] * fb;
}
__device__ __forceinline__ void attn_store(bf16_t* orow, float lsum, const f32x4 (&o)[4]) {
    lsum += __shfl_xor(lsum, 16); lsum += __shfl_xor(lsum, 32);
    const float inv = 1.f / lsum;
#pragma unroll
    for (int dt = 0; dt < 4; ++dt) { uint2 w; w.x = pg8::cvt_pk_bf16(o[dt][0] * inv, o[dt][1] * inv); w.y = pg8::cvt_pk_bf16(o[dt][2] * inv, o[dt][3] * inv); *(uint2*)(orow + 16 * dt) = w; }
}
__device__ __forceinline__ void attn_ctx_phase(LAS unsigned char* lds, int vcu, int G) {
    const int tid = tid_opaque(), lane = tid & 63, wave = __builtin_amdgcn_readfirstlane(tid >> 6), r = lane & 15, q4 = lane >> 4;
    const bf16_t* Q = (const bf16_t*)(PWS + WS_Q); const bf16_t* K = (const bf16_t*)(PWS + WS_K); const bf16_t* VT = (const bf16_t*)(PWS + WS_VT);
    bf16_t* MIX = (bf16_t*)(PWS + WS_MIX);
    for (int it = vcu; it < BATCH * NH; it += G) {
        const int h = it % NH, b = it / NH;
        __syncthreads();
        attn_stage_kv(lds, K + (size_t)b * SEQ * NAW + h * HD, NAW, VT + (size_t)(b * NH + h) * HD * SEQ, tid);
        __syncthreads();
#pragma unroll 1
        for (int task = wave; task < SEQ / 16; task += NWAVES) {
            const size_t rowq = (size_t)b * SEQ + task * 16 + r;
            bf16x8 qf[2];
            qf[0] = ldg8(Q + rowq * NAW + h * HD + 8 * q4); qf[1] = ldg8(Q + rowq * NAW + h * HD + 32 + 8 * q4);
            f32x4 o[4]; float m = -1e30f, lsum = 0.f;
#pragma unroll
            for (int dt = 0; dt < 4; ++dt) o[dt] = (f32x4){0.f, 0.f, 0.f, 0.f};
            f32x4 o2[4]; float m2 = -1e30f, l2 = 0.f;
#pragma unroll
            for (int dt = 0; dt < 4; ++dt) o2[dt] = (f32x4){0.f, 0.f, 0.f, 0.f};
#pragma unroll
            for (int i = 0; i < 4; ++i) { f32x4 sa, sb, ta, tb; bf16x8 v1[4], v2[4];
                attn_lds_logits(lds, 32 * i, qf, sa, sb, v1, r, q4); attn_lds_logits(lds, 128 + 32 * i, qf, ta, tb, v2, r, q4);
                softmax_pv_step2(sa, sb, m, lsum, o, v1, ta, tb, m2, l2, o2, v2); }
            attn_merge(m, lsum, o, m2, l2, o2);
            attn_store(MIX + rowq * D + SSMW + h * HD + 4 * q4, lsum, o);
        }
    }
    __syncthreads();
}
constexpr int NAV_STRIDE = 520, NA_WV_OFF = 512 * AK_STRIDE * 2, NA_WB_OFF = NA_WV_OFF + 64 * NAV_STRIDE * 2;
static_assert(NA_WB_OFF + 15 * 32 * 4 <= LDS_CTL_OFF && ATT_V_OFF + 64 * AV_STRIDE * 2 <= NA_WB_OFF, "NA lds map");
__device__ __forceinline__ void na_stage_window(LAS unsigned char* lds, const bf16_t* kg, const bf16_t* vg, int row0, int nrows, int tid) {
    LAS bf16_t* kl = (LAS bf16_t*)lds; LAS bf16_t* vl = (LAS bf16_t*)(lds + NA_WV_OFF);
    const int ntok = nrows * 64;
#pragma unroll 1
    for (int i0 = 0; i0 < 8; i0 += 4) {
#pragma unroll
        for (int i = i0; i < i0 + 4; ++i) { const int c = tid + NWAVES * 64 * i, tok = c >> 3, part = c & 7;
            if (tok < ntok) *(LAS bf16x8*)(kl + tok * AK_STRIDE + part * 8) = ldg8(kg + (size_t)(row0 * GW + tok) * NAW + part * 8); }
    }
#pragma unroll 1
    for (int i0 = 0; i0 < 8; i0 += 4) {
#pragma unroll
        for (int i = i0; i < i0 + 4; ++i) { const int c = tid + NWAVES * 64 * i, d = c >> 6, part = c & 63;
            if (part * 8 < ntok) *(LAS bf16x8*)(vl + d * NAV_STRIDE + part * 8) = ldg8(vg + (size_t)d * DSEQ + row0 * GW + part * 8); }
    }
}
__device__ __forceinline__ void attn_na_phase(LAS unsigned char* lds, int l, int vcu, int G) {
    const int tid = tid_opaque(), lane = tid & 63, wave = __builtin_amdgcn_readfirstlane(tid >> 6), r = lane & 15, q4 = lane >> 4;
    const bf16_t* Q = (const bf16_t*)(PWS + WS_Q); const bf16_t* K = (const bf16_t*)(PWS + WS_K); const bf16_t* VT = (const bf16_t*)(PWS + WS_VT);
    bf16_t* MIX = (bf16_t*)(PWS + WS_MIX);
    const float* rpb_l = PIN(27) + (size_t)l * NH * 15 * 31;
    const int koff = 8 * (r >> 2) + (r & 3);
    constexpr int NT = 2, IR = 2 * NT;
    const int nb = wave & 3, rl0 = wave >> 2;
    const int qcol = nb * 16 + r;
    int kc0 = nb * 16 - 8; kc0 = kc0 < 0 ? 0 : (kc0 > GW - 32 ? GW - 32 : kc0);
    int cs = qcol - 8; cs = cs < 0 ? 0 : (cs > GW - 16 ? GW - 16 : cs);
    int bidx[8];
#pragma unroll
    for (int i = 0; i < 8; ++i) { const int kcol = kc0 + 8 * q4 + i; const bool valid = kcol >= cs && kcol < cs + 16;
        int dc = kcol - qcol + 15; dc = dc < 0 ? 0 : (dc > 30 ? 30 : dc); bidx[i] = valid ? dc : 31; }
    for (int it = vcu; it < DB * NH * (GW / IR); it += G) {
        const int rg = it % (GW / IR), h = (it / (GW / IR)) % NH, b = it / ((GW / IR) * NH);
        const int R0 = rg * IR;
        int lo = R0 - 4; lo = lo < 0 ? 0 : (lo > GW - 8 ? GW - 8 : lo);
        int hi = R0 + IR - 1 - 4; hi = (hi < 0 ? 0 : (hi > GW - 8 ? GW - 8 : hi)) + 7;
        const bf16_t* kg = K + ((size_t)MC + (size_t)b * DSEQ) * NAW + h * HD;
        const bf16_t* vg = VT + (size_t)MC * NAW + (size_t)(b * NH + h) * HD * DSEQ;
        __syncthreads();
        attn_stage_kv(lds, (const bf16_t*)(PWS + WS_CK) + (((size_t)l * DB + b) * NH + h) * PAST * HD, HD, (const bf16_t*)(PWS + WS_CVT) + (((size_t)l * DB + b) * NH + h) * HD * PAST, tid);
        if (tid < 15 * 32) { const int dr = tid >> 5, dc = tid & 31; ((LAS float*)(lds + NA_WB_OFF))[tid] = dc < 31 ? rpb_l[(size_t)h * 15 * 31 + dr * 31 + dc] * 1.4426950408889634f : -1e30f; }
        __syncthreads();
        f32x4 o[NT][4]; float m[NT], ls[NT];
        const bf16_t* qbase = Q + ((size_t)MC + (size_t)b * DSEQ + (R0 + rl0) * GW + qcol) * NAW + h * HD + 8 * q4;
#pragma unroll
        for (int t = 0; t < NT; ++t) {
            bf16x8 qf[2]; qf[0] = ldg8(qbase + (size_t)t * 2 * GW * NAW); qf[1] = ldg8(qbase + (size_t)t * 2 * GW * NAW + 32);
            m[t] = -1e30f; ls[t] = 0.f;
#pragma unroll
            for (int dt = 0; dt < 4; ++dt) o[t][dt] = (f32x4){0.f, 0.f, 0.f, 0.f};
#pragma unroll 2
            for (int k0 = 0; k0 < PAST; k0 += 32) { f32x4 sa, sb; bf16x8 v1[4];
                attn_lds_logits(lds, k0, qf, sa, sb, v1, r, q4);
                softmax_pv_step(sa, sb, m[t], ls[t], o[t], v1); }
            __builtin_amdgcn_sched_barrier(0);
        }
        const LAS float* btab = (const LAS float*)(lds + NA_WB_OFF);
#pragma unroll 1
        for (int pass = 0; pass < 2; ++pass) {
            const int base = lo + 8 * pass, nrows = pass == 0 ? 8 : hi - (lo + 8) + 1;
            __syncthreads();
            na_stage_window(lds, kg, vg, base, nrows, tid);
            __syncthreads();
#pragma unroll
            for (int t = 0; t < NT; ++t) {
                const int row = R0 + rl0 + 2 * t;
                bf16x8 qf[2]; qf[0] = ldg8(qbase + (size_t)t * 2 * GW * NAW); qf[1] = ldg8(qbase + (size_t)t * 2 * GW * NAW + 32);
                int rs = row - 4; rs = rs < 0 ? 0 : (rs > GW - 8 ? GW - 8 : rs);
#pragma unroll 1
                for (int sl = 0; sl < nrows; ++sl) {
                    const int wr = base + sl;
                    if (wr < rs || wr >= rs + 8) continue;
                    const LAS bf16_t* ka = (const LAS bf16_t*)lds + (sl * GW + kc0 + koff) * AK_STRIDE + 8 * q4;
                    const LAS bf16_t* vl = (const LAS bf16_t*)(lds + NA_WV_OFF) + r * NAV_STRIDE + sl * GW + kc0 + 8 * q4;
                    const bf16x8 a0 = *(const LAS bf16x8*)ka, a1 = *(const LAS bf16x8*)(ka + 32), b0 = *(const LAS bf16x8*)(ka + 4 * AK_STRIDE), b1 = *(const LAS bf16x8*)(ka + 4 * AK_STRIDE + 32);
                    bf16x8 vf[4];
#pragma unroll
                    for (int dt = 0; dt < 4; ++dt) vf[dt] = *(const LAS bf16x8*)(vl + dt * 16 * NAV_STRIDE);
                    f32x4 sa, sb; qk_tiles(a0, a1, b0, b1, qf, sa, sb);
                    const LAS float* brow = btab + (wr - row + 7) * 32;
#pragma unroll
                    for (int i = 0; i < 4; ++i) { sa[i] = fmaf(sa[i], QK_SCALE_LOG2E, brow[bidx[i]]); sb[i] = fmaf(sb[i], QK_SCALE_LOG2E, brow[bidx[4 + i]]); }
                    softmax_pv_step(sa, sb, m[t], ls[t], o[t], vf);
                }
                __builtin_amdgcn_sched_barrier(0);
            }
        }
#pragma unroll
        for (int t = 0; t < NT; ++t) {
            const size_t rowq = (size_t)MC + (size_t)b * DSEQ + (R0 + rl0 + 2 * t) * GW + qcol;
            attn_store(MIX + rowq * D + SSMW + h * HD + 4 * q4, ls[t], o[t]);
        }
    }
    __syncthreads();
}
constexpr int GT_STRIDE = 136;
__device__ __forceinline__ void gate_phase(LAS unsigned char* lds, int l, int first, int stride) {
    const int tid = tid_opaque(), lane = tid & 63, wave = __builtin_amdgcn_readfirstlane(tid >> 6), r = lane & 15, q4 = lane >> 4;
    LAS bf16_t* vt = (LAS bf16_t*)lds;
    const bf16_t* VG = (const bf16_t*)(PWS + WS_VG); const bf16_t* U = (const bf16_t*)(PWS + WS_U);
    const bf16_t* wsb = (const bf16_t*)(PWS + WS_WSB) + (size_t)l * 4 * 128 * 128;
    const float* bs = PIN(29) + (size_t)l * 4 * 128;
    bf16_t* MIX = (bf16_t*)(PWS + WS_MIX);
    for (int it = first; it < MT / 128; it += stride) {
        const size_t base = (size_t)it * 128;
        const int i = wave * 16 + r;
        bf16x8 bfrag[4][4];
#pragma unroll
        for (int g = 0; g < 4; ++g)
#pragma unroll
            for (int ks = 0; ks < 4; ++ks) bfrag[g][ks] = ldg8(wsb + ((size_t)g * 128 + i) * 128 + 8 * q4 + 32 * ks);
        __syncthreads();
        {
            const int t = tid >> 2, qc = tid & 3;
            const u32x4* vr = (const u32x4*)(VG + (base + t) * GMW + 64 * qc);
            u32x4 raw[8];
#pragma unroll
            for (int j = 0; j < 8; ++j) raw[j] = vr[j];
            float x[64]; float sm = 0.f;
#pragma unroll
            for (int j = 0; j < 8; ++j)
#pragma unroll
                for (int e = 0; e < 4; ++e) { x[8 * j + 2 * e] = __uint_as_float(raw[j][e] << 16); x[8 * j + 2 * e + 1] = __uint_as_float(raw[j][e] & 0xffff0000u); sm += x[8 * j + 2 * e] + x[8 * j + 2 * e + 1]; }
            sm += __shfl_xor(sm, 1); sm += __shfl_xor(sm, 2);
            const float mean = sm * (1.f / GMW);
            float sq = 0.f;
#pragma unroll
            for (int c = 0; c < 64; ++c) { x[c] -= mean; sq += x[c] * x[c]; }
            sq += __shfl_xor(sq, 1); sq += __shfl_xor(sq, 2);
            const float rstd = rsqrtf(sq * (1.f / GMW) + 1e-5f);
#pragma unroll
            for (int c = 0; c < 64; ++c) vt[(64 * qc + c) * GT_STRIDE + t] = f2bf(x[c] * rstd);
        }
        __syncthreads();
#pragma unroll
        for (int g = 0; g < 4; ++g) {
            f32x4 acc[4];
            uint2 uu[4];
#pragma unroll
            for (int ct = 0; ct < 4; ++ct) { acc[ct] = (f32x4){0.f, 0.f, 0.f, 0.f}; uu[ct] = *(const uint2*)(U + (base + i) * GMW + g * 64 + ct * 16 + 4 * q4); }
            const float bsv = bs[g * 128 + i];
#pragma unroll
            for (int ks = 0; ks < 4; ++ks)
#pragma unroll
                for (int ct = 0; ct < 4; ++ct) {
                    const bf16x8 afrag = *(const LAS bf16x8*)(vt + (g * 64 + ct * 16 + r) * GT_STRIDE + 32 * ks + 8 * q4);
                    acc[ct] = __builtin_amdgcn_mfma_f32_16x16x32_bf16(afrag, bfrag[g][ks], acc[ct], 0, 0, 0);
                }
#pragma unroll
            for (int ct = 0; ct < 4; ++ct) {
                const int ch = g * 64 + ct * 16 + 4 * q4;
                const float u0 = __uint_as_float(uu[ct].x << 16), u1 = __uint_as_float(uu[ct].x & 0xffff0000u), u2 = __uint_as_float(uu[ct].y << 16), u3 = __uint_as_float(uu[ct].y & 0xffff0000u);
                uint2 w; w.x = pg8::cvt_pk_bf16(u0 * (acc[ct][0] + bsv), u1 * (acc[ct][1] + bsv)); w.y = pg8::cvt_pk_bf16(u2 * (acc[ct][2] + bsv), u3 * (acc[ct][3] + bsv));
                *(uint2*)(MIX + (base + i) * D + SSMW + NAW + ch) = w;
            }
        }
    }
    __syncthreads();
}
constexpr int CH = 64, NCHUNK = MT / CH;
constexpr int BU_STRIDE = 132, SB_STRIDE = 136, YB_STRIDE = 264;
constexpr int SSM_WAVE_BYTES = 16 * BU_STRIDE * 4 + 16 * SB_STRIDE * 2, SSM_YB_OFF = NWAVES * SSM_WAVE_BYTES;
static_assert(SSM_WAVE_BYTES % 16 == 0 && SSM_YB_OFF + CH * YB_STRIDE * 2 <= LDS_CTL_OFF, "ssm lds map");
__device__ __forceinline__ float2 cmul(float2 a, float2 b) { return make_float2(a.x * b.x - a.y * b.y, a.x * b.y + a.y * b.x); }
__device__ __forceinline__ float2 cfma(float2 a, float2 b, float2 c) { return make_float2(fmaf(a.x, b.x, fmaf(-a.y, b.y, c.x)), fmaf(a.x, b.y, fmaf(a.y, b.x, c.y))); }
__device__ __forceinline__ void ssm_load_bm(bf16x8 (&bm)[8], const bf16x8* BMFg, int lane) {
#pragma unroll
    for (int tau = 0; tau < 8; ++tau) bm[tau] = BMFg[tau * 64 + lane];
}
__device__ __forceinline__ bf16x8 ssm_load_u(const float* XS, size_t trow0, int g, int r, int q4) {
    const f32x4* src = (const f32x4*)(XS + (trow0 + r) * SSMW + g * SC + 8 * (q4 & 1));
    const f32x4 a = src[0], b = src[1];
    const float u[8] = {a[0], a[1], a[2], a[3], b[0], b[1], b[2], b[3]};
    u32x4 w; unsigned ww[4];
#pragma unroll
    for (int i = 0; i < 4; ++i) {
        const unsigned hp = pg8::cvt_pk_bf16(u[2 * i], u[2 * i + 1]);
        const unsigned lp = pg8::cvt_pk_bf16(u[2 * i] - __uint_as_float(hp << 16), u[2 * i + 1] - __uint_as_float(hp & 0xffff0000u));
        ww[i] = (q4 & 2) ? lp : hp;
    }
    w.x = ww[0]; w.y = ww[1]; w.z = ww[2]; w.w = ww[3];
    return __builtin_bit_cast(bf16x8, w);
}
__device__ __forceinline__ void ssm_bu_to_lds(LAS float* bul, const bf16x8 (&bm)[8], const bf16x8 uf, int r, int q4) {
#pragma unroll
    for (int tau = 0; tau < 8; ++tau) {
        const f32x4 d = __builtin_amdgcn_mfma_f32_16x16x32_bf16(bm[tau], uf, (f32x4){0.f, 0.f, 0.f, 0.f}, 0, 0, 0);
        *(LAS f32x4*)(bul + r * BU_STRIDE + 16 * tau + 4 * q4) = d;
    }
}
template <int DIR> __device__ __forceinline__ void ssm_dir_a(const bf16x8 (&uf)[4], LAS float* bul, const float2* LB, float2* E, int l, int g, int ci, int lane, int r, int q4) {
    constexpr int d = DIR;
    const int pbase = ((l * 2 + d) * SG + g) * SP;
    const float2 lb = LB[pbase + lane];
    bf16x8 bm[8]; ssm_load_bm(bm, (const bf16x8*)(PWS + WS_BMF) + (size_t)((l * 2 + d) * SG + g) * 8 * 64, lane);
    float2 s = make_float2(0.f, 0.f);
    const LAS float* brd = bul + 2 * lane;
#pragma unroll
    for (int si = 0; si < 4; ++si) {
        ssm_bu_to_lds(bul, bm, uf[d ? 3 - si : si], r, q4);
#pragma unroll
        for (int step = 0; step < 16; ++step) { const f32x2 bv2 = *(const LAS f32x2*)(brd + (d ? 15 - step : step) * BU_STRIDE); s = cfma(lb, s, make_float2(bv2[0], bv2[1])); }
    }
    E[((size_t)ci * 2 + d) * SG * SP + g * SP + lane] = s;
}
__device__ __forceinline__ void ssm_pass_a(LAS unsigned char* lds, int l, int vcu, int G) {
    const int tid = tid_opaque(), lane = tid & 63, wave = __builtin_amdgcn_readfirstlane(tid >> 6), r = lane & 15, q4 = lane >> 4;
    LAS float* bul = (LAS float*)(lds + wave * SSM_WAVE_BYTES);
    const float* XS = (const float*)(PWS + WS_XSSM);
    const float2* LB = (const float2*)(PWS + WS_SSMP); const float2* BB = (const float2*)(PWS + WS_SSMP + 64 * 1024);
    float2* E = (float2*)(PWS + WS_E);
    for (int ci = vcu; ci < NCHUNK; ci += G) {
#pragma unroll 1
        for (int gi = 0; gi < 2; ++gi) {
            const int g = wave * 2 + gi;
            bf16x8 uf[4];
#pragma unroll
            for (int sub = 0; sub < 4; ++sub) uf[sub] = ssm_load_u(XS, (size_t)ci * CH + sub * 16, g, r, q4);
            ssm_dir_a<0>(uf, bul, LB, E, l, g, ci, lane, r, q4);
            ssm_dir_a<1>(uf, bul, LB, E, l, g, ci, lane, r, q4);
        }
    }
}
__device__ __forceinline__ void ssm_carry(int l, int vcu, int G) {
    const int tid = tid_opaque(), lane = tid & 63, wave = __builtin_amdgcn_readfirstlane(tid >> 6);
    const float2* LB = (const float2*)(PWS + WS_SSMP);
    const float2* E = (const float2*)(PWS + WS_E); float2* SIN = (float2*)(PWS + WS_SIN);
    const float* st0 = PIN(5);
    for (int wi = wave * G + vcu; wi < (BATCH + DB) * 2 * SG; wi += G * NWAVES) {
        const bool lat = wi < DB * 2 * SG;
        const int w2 = lat ? wi : wi - DB * 2 * SG, g = w2 % SG, d = (w2 / SG) & 1, sq = w2 / (2 * SG);
        const int nC = lat ? DSEQ / CH : SEQ / CH, cbase = lat ? MC / CH + sq * (DSEQ / CH) : sq * (SEQ / CH);
        float2 lt = LB[((l * 2 + d) * SG + g) * SP + lane];
#pragma unroll
        for (int i = 0; i < 6; ++i) lt = cmul(lt, lt);
        float2 s = make_float2(0.f, 0.f);
        if (lat) { const float* st = st0 + (((((size_t)sq * DEPTH + l) * 2 + d) * SG + g) * SP + lane) * 2; s = make_float2(st[0], st[1]); }
        const size_t off = (size_t)d * SG * SP + g * SP + lane, cs = (size_t)2 * SG * SP;
        if (d == 0) {
#pragma unroll 16
            for (int k = 0; k < nC; ++k) { const float2 e = E[(size_t)(cbase + k) * cs + off]; SIN[(size_t)(cbase + k) * cs + off] = s; s = cfma(lt, s, e); }
        } else {
#pragma unroll 16
            for (int k = nC - 1; k >= 0; --k) { const float2 e = E[(size_t)(cbase + k) * cs + off]; SIN[(size_t)(cbase + k) * cs + off] = s; s = cfma(lt, s, e); }
        }
    }
}
template <int DIR> __device__ __forceinline__ void ssm_dir_b(f32x4 (&yg)[4], const bf16x8 (&uf)[4], LAS float* bul, LAS bf16_t* sbw, const float2* LB, const float2* SIN,
                                                          int l, int g, int ci, bool lat, int sq, bool edge_chunk, int lane, int r, int q4) {
    constexpr int d = DIR;
    const int pbase = ((l * 2 + d) * SG + g) * SP;
    const float2 lb = LB[pbase + lane];
    float2 s = SIN[((size_t)ci * 2 + d) * SG * SP + g * SP + lane];
    bf16x8 bm[8]; ssm_load_bm(bm, (const bf16x8*)(PWS + WS_BMF) + (size_t)((l * 2 + d) * SG + g) * 8 * 64, lane);
    bf16x8 cf[4];
    { const bf16x8* cff = (const bf16x8*)(PWS + WS_CFF) + (size_t)((l * 2 + d) * SG + g) * 4 * 64 + lane;
#pragma unroll
      for (int ks = 0; ks < 4; ++ks) cf[ks] = cff[ks * 64]; }
    const LAS float* brd = bul + 2 * lane; LAS bf16_t* swr = sbw + 2 * lane; const LAS bf16_t* srd = sbw + r * SB_STRIDE + 8 * q4;
#pragma unroll
    for (int si = 0; si < 4; ++si) {
        constexpr int dummy = 0; (void)dummy;
        const int sub = d ? 3 - si : si;
        ssm_bu_to_lds(bul, bm, uf[sub], r, q4);
        f32x2 buv[16];
#pragma unroll
        for (int step = 0; step < 16; ++step) buv[step] = *(const LAS f32x2*)(brd + (d ? 15 - step : step) * BU_STRIDE);
#pragma unroll
        for (int step = 0; step < 16; ++step) { s = cfma(lb, s, make_float2(buv[step][0], buv[step][1]));
            *(LAS unsigned*)(swr + (d ? 15 - step : step) * SB_STRIDE) = pg8::cvt_pk_bf16(s.x, s.y); }
#pragma unroll
        for (int ks = 0; ks < 4; ++ks) {
            const bf16x8 sf = *(const LAS bf16x8*)(srd + 32 * ks);
            yg[sub] = __builtin_amdgcn_mfma_f32_16x16x32_bf16(cf[ks], sf, yg[sub], 0, 0, 0);
        }
    }
    if (!lat && edge_chunk) { float* o = POUT + O_ST + (((((size_t)sq * DEPTH + l) * 2 + d) * SG + g) * SP + lane) * 2; o[0] = s.x; o[1] = s.y; }
}
__device__ __forceinline__ void ssm_group_b(f32x4 (&yg)[4], LAS float* bul, LAS bf16_t* sbw, LAS bf16_t* yb, const float* XS, const float2* LB, const float2* BB, const float2* SIN,
                                            int l, int g, int ci, bool lat, int sq, bool first_chunk, bool last_chunk, int lane, int r, int q4) {
#pragma unroll
    for (int s = 0; s < 4; ++s) yg[s] = (f32x4){0.f, 0.f, 0.f, 0.f};
    bf16x8 uf[4];
#pragma unroll
    for (int sub = 0; sub < 4; ++sub) uf[sub] = ssm_load_u(XS, (size_t)ci * CH + sub * 16, g, r, q4);
    ssm_dir_b<0>(yg, uf, bul, sbw, LB, SIN, l, g, ci, lat, sq, last_chunk, lane, r, q4);
    ssm_dir_b<1>(yg, uf, bul, sbw, LB, SIN, l, g, ci, lat, sq, first_chunk, lane, r, q4);
    const f32x4 dv = *(const f32x4*)(PIN(22) + l * SSMW + g * SC + 4 * q4);
#pragma unroll
    for (int sub = 0; sub < 4; ++sub) {
        const int t = sub * 16 + r;
        const f32x4 u = *(const f32x4*)(XS + ((size_t)ci * CH + t) * SSMW + g * SC + 4 * q4);
#pragma unroll
        for (int i = 0; i < 4; ++i) yg[sub][i] = pg8::gelu_fast(fmaf(dv[i], u[i], yg[sub][i]));
        u32x2 w; w[0] = pg8::cvt_pk_bf16(yg[sub][0], yg[sub][1]); w[1] = pg8::cvt_pk_bf16(yg[sub][2], yg[sub][3]);
        *(LAS u32x2*)(yb + t * YB_STRIDE + g * SC + 4 * q4) = w;
    }
}
__device__ __forceinline__ void ssm_pass_b(LAS unsigned char* lds, int l, int vcu, int G) {
    const int tid = tid_opaque(), lane = tid & 63, wave = __builtin_amdgcn_readfirstlane(tid >> 6), r = lane & 15, q4 = lane >> 4;
    LAS float* bul = (LAS float*)(lds + wave * SSM_WAVE_BYTES);
    LAS bf16_t* sbw = (LAS bf16_t*)(lds + wave * SSM_WAVE_BYTES + 16 * BU_STRIDE * 4);
    LAS bf16_t* yb = (LAS bf16_t*)(lds + SSM_YB_OFF);
    const float* XS = (const float*)(PWS + WS_XSSM);
    const float2* LB = (const float2*)(PWS + WS_SSMP); const float2* BB = (const float2*)(PWS + WS_SSMP + 64 * 1024);
    const float2* SIN = (const float2*)(PWS + WS_SIN);
    const bf16_t* glt = (const bf16_t*)(PWS + WS_GLT) + (size_t)l * SSMW * SSMW;
    bf16_t* MIX = (bf16_t*)(PWS + WS_MIX);
    for (int ci = vcu; ci < NCHUNK; ci += G) {
        const bool lat = ci >= MC / CH;
        const int sq = lat ? (ci - MC / CH) / (DSEQ / CH) : ci / (SEQ / CH);
        const int nC = lat ? DSEQ / CH : SEQ / CH, cbase = lat ? MC / CH + sq * (DSEQ / CH) : sq * (SEQ / CH), k = ci - cbase;
        __syncthreads();
        f32x4 yg0[4], yg1[4];
        ssm_group_b(yg0, bul, sbw, yb, XS, LB, BB, SIN, l, wave * 2 + 0, ci, lat, sq, k == 0, k == nC - 1, lane, r, q4);
        ssm_group_b(yg1, bul, sbw, yb, XS, LB, BB, SIN, l, wave * 2 + 1, ci, lat, sq, k == 0, k == nC - 1, lane, r, q4);
        __syncthreads();
        f32x4 z[2][4];
#pragma unroll
        for (int a = 0; a < 2; ++a)
#pragma unroll
            for (int b = 0; b < 4; ++b) z[a][b] = (f32x4){0.f, 0.f, 0.f, 0.f};
#pragma unroll 2
        for (int ks = 0; ks < 8; ++ks) {
            bf16x8 af[2], bfv[4];
#pragma unroll
            for (int a = 0; a < 2; ++a) af[a] = ldg8(glt + (size_t)(wave * 32 + a * 16 + r) * SSMW + 32 * ks + 8 * q4);
#pragma unroll
            for (int b = 0; b < 4; ++b) bfv[b] = *(const LAS bf16x8*)(yb + (b * 16 + r) * YB_STRIDE + 32 * ks + 8 * q4);
#pragma unroll
            for (int a = 0; a < 2; ++a)
#pragma unroll
                for (int b = 0; b < 4; ++b) z[a][b] = __builtin_amdgcn_mfma_f32_16x16x32_bf16(af[a], bfv[b], z[a][b], 0, 0, 0);
        }
        const float* gb = PIN(24) + l * SSMW;
#pragma unroll
        for (int a = 0; a < 2; ++a) {
            const int n = wave * 32 + a * 16 + 4 * q4;
            const f32x4 bv = *(const f32x4*)(gb + n);
#pragma unroll
            for (int b = 0; b < 4; ++b) {
                const f32x4 yv = a ? yg1[b] : yg0[b];
                float o[4];
#pragma unroll
                for (int i = 0; i < 4; ++i) o[i] = yv[i] * __builtin_amdgcn_rcpf(1.f + __builtin_amdgcn_exp2f(-1.4426950408889634f * (z[a][b][i] + bv[i])));
                uint2 w; w.x = pg8::cvt_pk_bf16(o[0], o[1]); w.y = pg8::cvt_pk_bf16(o[2], o[3]);
                *(uint2*)(MIX + ((size_t)ci * CH + b * 16 + r) * D + n) = w;
            }
        }
    }
    __syncthreads();
}

#define XB_TMO      128
#define XB_XCNT(j)  (256  + 64 * (j))
#define XB_XSUB(j)  (1280 + 64 * (j))
#define XB_XGEN(j)  (2304 + 64 * (j))
#define XB_TOP      3328
#define XB_TOPGEN   3392
#define XCD_BAR_WORDS 3456
#define XB_SPIN_CAP (1u << 18)

__device__ __forceinline__ unsigned xb_ld(unsigned* p)              { return __hip_atomic_load(p, __ATOMIC_RELAXED, __HIP_MEMORY_SCOPE_AGENT); }
__device__ __forceinline__ unsigned xb_add(unsigned* p, unsigned v) { return __hip_atomic_fetch_add(p, v, __ATOMIC_RELAXED, __HIP_MEMORY_SCOPE_AGENT); }
__device__ __forceinline__ unsigned xb_xcc_id() { return (unsigned)__builtin_amdgcn_s_getreg((3 << 11) | 20) & 0xFu; }
#define XB_SPIN(cond, bar) do { unsigned _sp = 0; while (cond) { __builtin_amdgcn_s_sleep(1); \
    if ((++_sp & 255u) == 0u) { if (xb_ld(&(bar)[XB_TMO])) break; if (_sp > XB_SPIN_CAP) { atomicAdd(&(bar)[XB_TMO], 1u); break; } } } } while (0)

struct XcdBarrier {
    unsigned* bar; unsigned x;
    volatile LAS unsigned* st;
};

__device__ __forceinline__ XcdBarrier xcd_barrier_post(unsigned* bar, volatile LAS unsigned* st) {
    XcdBarrier b; b.bar = bar; b.x = xb_xcc_id(); b.st = st;
    if (threadIdx.x == 0) (void)xb_add(&bar[XB_XCNT(b.x)], 1u);
    return b;
}
__device__ __forceinline__ void xcd_barrier_complete(unsigned* bar, unsigned x, unsigned& nloc, unsigned& nx) {
    const unsigned G = gridDim.x * gridDim.y * gridDim.z;
    unsigned sum, cnt, mine, sp = 0u;
    for (;;) {
        sum = 0u; cnt = 0u; mine = 0u;
#pragma unroll
        for (unsigned j = 0; j < 16; ++j) { const unsigned c = xb_ld(&bar[XB_XCNT(j)]); sum += c; cnt += (c > 0u) ? 1u : 0u; mine = (j == x) ? c : mine; }
        if (sum == G) break;
        __builtin_amdgcn_s_sleep(1);
        if ((++sp & 255u) == 0u) { if (xb_ld(&bar[XB_TMO])) break; if (sp > XB_SPIN_CAP) { atomicAdd(&bar[XB_TMO], 1u); break; } }
    }
    nloc = mine > 0u ? mine : 1u; nx = cnt > 0u ? cnt : 1u;
}

__device__ __forceinline__ void xcd_barrier(const XcdBarrier& b) {
    asm volatile("s_waitcnt vmcnt(0)" ::: "memory");
    __syncthreads();
    if (threadIdx.x == 0) {
        unsigned* bar = b.bar;
        __builtin_amdgcn_s_waitcnt(0);
        unsigned nloc = b.st[0], nx = b.st[1];
        if (nloc == 0u) { xcd_barrier_complete(bar, b.x, nloc, nx); b.st[0] = nloc; b.st[1] = nx; }
        const unsigned old = xb_add(&bar[XB_XSUB(b.x)], 1u);
        const unsigned gen = old / nloc;
        if (old + 1u == (gen + 1u) * nloc) {
            __builtin_amdgcn_fence(__ATOMIC_RELEASE, "agent");
            asm volatile("s_waitcnt vmcnt(0)" ::: "memory");
            const unsigned og = xb_add(&bar[XB_TOP], 1u);
            const unsigned tg = og / nx;
            if (og + 1u == (tg + 1u) * nx) xb_add(&bar[XB_TOPGEN], 1u);
            else XB_SPIN(xb_ld(&bar[XB_TOPGEN]) == tg, bar);
            __builtin_amdgcn_fence(__ATOMIC_ACQUIRE, "agent");
            xb_add(&bar[XB_XGEN(b.x)], 1u);
            asm volatile("s_waitcnt vmcnt(0)" ::: "memory");
        } else {
            XB_SPIN(xb_ld(&bar[XB_XGEN(b.x)]) == gen, bar);
            __builtin_amdgcn_fence(__ATOMIC_ACQUIRE, "agent");
            asm volatile("s_waitcnt vmcnt(0)" ::: "memory");
        }
    }
    __syncthreads();
}

#define PHASE_FN __device__ __forceinline__
PHASE_FN void ph_prologue(LAS unsigned char* lds, int vcu, int G) { prologue_phase(lds, vcu, G); }
PHASE_FN void ph_x0(int vcu, int G) { x0_phase(vcu, G); }
PHASE_FN void ph_ffn_in(LAS unsigned char* lds, int l, int second, int G, int bx) {
    unsigned char* wl = PWS + WS_W + (size_t)l * WL_STRIDE;
    pg8::Gemm g{(const bf16_t*)(PWS + WS_H), (const bf16_t*)(wl + (second ? WO_W1B : WO_W1A)), MT, 2 * FF, D};
    pg8::StaticOrder S; S.init(MT, 2 * FF, G, bx);
    pg8::EpiFfnIn E{l, second};
    pg8::gemm_phase<pg8::EpiFfnIn, pg8::StaticOrder, true, true>(lds, g, S, E);
}
PHASE_FN void ph_res(LAS unsigned char* lds, int l, int kind, int G, int bx) {
    unsigned char* wl = PWS + WS_W + (size_t)l * WL_STRIDE;
    const bool wo = kind == 1;
    pg8::Gemm g{(const bf16_t*)(PWS + (wo ? WS_MIX : WS_ACT)), (const bf16_t*)(wl + (kind == 0 ? WO_W2A : wo ? WO_WOUT : WO_W2B)), MT, D, wo ? D : FF};
    pg8::StaticOrder S; S.init(MT, D, G, bx);
    pg8::EpiRes E{l, kind};
    pg8::gemm_phase<pg8::EpiRes, pg8::StaticOrder, true, true>(lds, g, S, E);
}
PHASE_FN void ph_win(LAS unsigned char* lds, int l, int G, int bx) {
    unsigned char* wl = PWS + WS_W + (size_t)l * WL_STRIDE;
    pg8::Gemm g{(const bf16_t*)(PWS + WS_H), (const bf16_t*)(wl + WO_WIN), MT, INC, D};
    pg8::StaticOrder S; S.init(MT, INC, G, bx);
    pg8::EpiWin E{l};
    pg8::gemm_phase<pg8::EpiWin, pg8::StaticOrder, true, true>(lds, g, S, E);
}
PHASE_FN void ph_mix1(LAS unsigned char* lds, int l, int vcu, int G, int sub) {
    for (int i = 0; i <= ((sub >> 0) & 1); ++i) ssm_pass_a(lds, l, vcu, G);
    for (int i = 0; i <= ((sub >> 1) & 1); ++i) attn_ctx_phase(lds, vcu, G);
    for (int i = 0; i <= ((sub >> 2) & 1); ++i) attn_na_phase(lds, l, vcu, G);
    (void)sub;
}
PHASE_FN void ph_mixc(int l, int vcu, int G) { ssm_carry(l, vcu, G); }
PHASE_FN void ph_mix2(LAS unsigned char* lds, int l, int vcu, int G) {
    if (G >= 2 && NCHUNK > G && NCHUNK <= 2 * G) { const int h0 = NCHUNK - G; gate_phase(lds, l, vcu >= h0 ? vcu - h0 : MT, G - h0); }
    else gate_phase(lds, l, vcu, G);
    ssm_pass_b(lds, l, vcu, G);
}

__global__ void __launch_bounds__(NWAVES * 64, 2) mega(Params p) {
    extern __shared__ __attribute__((aligned(16))) unsigned char lds_raw[];
    LAS unsigned char* lds = (LAS unsigned char*)lds_raw;
    const int G = gridDim.x, bx = blockIdx.x;
    const int vcu = (G % 8 == 0) ? (bx % 8) * (G / 8) + bx / 8 : bx;
    {
        volatile LAS unsigned* st0 = (volatile LAS unsigned*)(lds + LDS_CTL_OFF);
        if (threadIdx.x < 16) st0[threadIdx.x] = 0u;
        __syncthreads();
        (void)xcd_barrier_post((unsigned*)(PWS + WS_CTL) + CW_BAR, st0);
    }
    for (int ph = p.ph_lo, rep = 0; ph < p.ph_hi;) {
        int Gp = G, vp = vcu, bp = bx; asm volatile("" : "+s"(Gp), "+s"(vp), "+s"(bp));
        if (ph == PH_PRO) { ph_prologue(lds, vp, Gp); }
        else if (ph == PH_X0) { ph_x0(vp, Gp); }
        else {
            const int l = (ph - 2) / PH_PER_LAYER, q = (ph - 2) % PH_PER_LAYER + 2;
            if (q == PH_F1IN) ph_ffn_in(lds, l, 0, Gp, bp);
            else if (q == PH_F2IN) ph_ffn_in(lds, l, 1, Gp, bp);
            else if (q == PH_F1OUT) ph_res(lds, l, 0, Gp, bp);
            else if (q == PH_WOUT) ph_res(lds, l, 1, Gp, bp);
            else if (q == PH_F2OUT) ph_res(lds, l, 2, Gp, bp);
            else if (q == PH_WIN) ph_win(lds, l, Gp, bp);
            else if (q == PH_MIX1) ph_mix1(lds, l, vp, Gp, p.rep_mask >> 16);
            else if (q == PH_MIXC) ph_mixc(l, vp, Gp);
            else if (q == PH_MIX2) ph_mix2(lds, l, vp, Gp);
        }
        const int kind = ph < 2 ? ph : (ph - 2) % PH_PER_LAYER + 2;
        const bool again = rep == 0 && ((p.rep_mask >> kind) & 1);
        if (again || ph + 1 < p.ph_hi) {
            if (ph == PH_PRO) cooperative_groups::this_grid().sync();
            else { XcdBarrier bar; bar.bar = (unsigned*)(PWS + WS_CTL) + CW_BAR; bar.x = xb_xcc_id(); bar.st = (volatile LAS unsigned*)(lds + LDS_CTL_OFF); xcd_barrier(bar); }
        }
        if (again) rep = 1; else { rep = 0; ++ph; }
    }
}
}

extern "C" void kernel_launch(void* const* d_in, const int* in_sizes, int n_in, void* d_out, int out_size, void* d_ws, size_t ws_size, hipStream_t stream) {
    static int grid = 0;
    if (grid == 0) {
        if (n_in != 33 || ws_size < WS_END) { fprintf(stderr, "kernel_launch: unexpected n_in %d / ws_size %zu\n", n_in, ws_size); grid = -1; return; }
        int dev = 0, cus = 0;
        if (hipGetDevice(&dev) != hipSuccess || hipDeviceGetAttribute(&cus, hipDeviceAttributeMultiprocessorCount, dev) != hipSuccess) { grid = -1; return; }
        if (hipFuncSetAttribute((const void*)mega, hipFuncAttributeMaxDynamicSharedMemorySize, LDS_BYTES) != hipSuccess) { fprintf(stderr, "hipFuncSetAttribute failed\n"); grid = -1; return; }
        grid = cus;
    }
    if (grid < 0) return;
    Params p{};
    for (int i = 0; i < 33; ++i) p.in[i] = (const float*)d_in[i];
    p.out = (float*)d_out; p.ws = (unsigned char*)d_ws;
    p.ph_lo = 0; p.ph_hi = NPHASES; p.rep_mask = PROBE_REP_MASK;
    if (hipMemsetAsync((char*)d_ws + WS_CTL, 0, WS_MOD + (size_t)DEPTH * 5 * NMOD * D * 4, stream) != hipSuccess) { fprintf(stderr, "memset of control words failed\n"); return; }
    void* args[] = {&p};
    const hipError_t e = hipLaunchCooperativeKernel((const void*)mega, dim3(grid), dim3(NWAVES * 64), args, LDS_BYTES, stream);
    if (e != hipSuccess) fprintf(stderr, "cooperative launch failed: %s (grid %d)\n", hipGetErrorString(e), grid);
}
```

```cpp
#include <hip/hip_runtime.h>
#include <hip/hip_cooperative_groups.h>
#include <cstdio>
#include <cstdint>

typedef unsigned short bf16_t;
namespace {
constexpr int D = 1024, BATCH = 32, SEQ = 256, DEPTH = 2, DB = 4, DSEQ = 4096, PAST = 256;
constexpr int GW = 64, SSMW = 256, NAW = 512, NH = 8, HD = 64, GMW = 256, FF = 2816, NMOD = 9, INC = 2304;
constexpr int SG = 16, SC = 16, SP = 64;
constexpr int MC = BATCH * SEQ, ML = DB * DSEQ, MT = MC + ML;
constexpr size_t MiB = 1u << 20;
constexpr size_t WS_CTL = 0, WS_MOD = 1 * MiB, WS_SSMP = 2 * MiB, WS_CK = 3 * MiB, WS_CVT = 5 * MiB, WS_E = 7 * MiB;
constexpr size_t WS_WSB = 13 * MiB, WS_GLT = 13 * MiB + MiB / 2;
constexpr size_t WS_BMF = 14 * MiB, WS_CFF = 14 * MiB + MiB / 2;
constexpr size_t WS_SHW = MiB + 384 * 1024, WS_ROWSS = 15 * MiB, WS_WN = 15 * MiB + 768 * 1024;
constexpr int SHW_LAYER = 5 * (2 * 2 * FF + INC), SHW_J1 = 5 * 2 * FF, SHW_J2 = 5 * (2 * FF + INC);
constexpr size_t WS_W = 16 * MiB, WS_H = 96 * MiB, WS_ACT = 144 * MiB;
constexpr size_t WS_XSSM = 144 * MiB, WS_Q = 168 * MiB, WS_K = 192 * MiB, WS_VT = 216 * MiB, WS_U = 240 * MiB, WS_VG = 252 * MiB;
constexpr size_t WS_SIN = 264 * MiB, WS_MIX = 276 * MiB, WS_XH2B = 324 * MiB, WS_END = 332 * MiB;
constexpr size_t XH_OUT_OFF = 48 * MiB; constexpr int XH2_SPLIT_PM = 80;
constexpr size_t O_YP = 0, O_YS = (size_t)MC * D, O_CK = (size_t)MT * D, O_CV = O_CK + (size_t)BATCH * DEPTH * SEQ * NAW,
                 O_ST = O_CV + (size_t)BATCH * DEPTH * SEQ * NAW;

__device__ __forceinline__ float bf2f(bf16_t v) { return __uint_as_float(((unsigned)v) << 16); }
__device__ __forceinline__ bf16_t f2bf(float f) { unsigned u = __float_as_uint(f); return (bf16_t)((u + 0x7fffu + ((u >> 16) & 1u)) >> 16); }
__device__ __forceinline__ float silu_f(float x) { return x / (1.f + __expf(-x)); }
__device__ __forceinline__ float gelu_tanh(float x) { const float u = 0.7978845608028654f * (x + 0.044715f * x * x * x); return 0.5f * x * (1.f + tanhf(u)); }
__device__ __forceinline__ int modrow(int m) { return m < MC ? 0 : 1 + (m - MC) / DSEQ; }
__device__ __forceinline__ float wave_sum(float v) {
#pragma unroll
    for (int o = 1; o < 64; o <<= 1) v += __shfl_xor(v, o);
    return v;
}

struct Params {
    const float* in[33];
    float* out;
    unsigned char* ws;
    int ph_lo, ph_hi, rep_mask, pad;
};


template <int OFF> __device__ __forceinline__ unsigned long long karg64() {
    unsigned long long v;
    asm volatile("s_load_dwordx2 %0, %1, %2\n\ts_waitcnt lgkmcnt(0)" : "=s"(v) : "s"(__builtin_amdgcn_kernarg_segment_ptr()), "i"(OFF) : "memory");
    return v;
}
__device__ __forceinline__ int tid_opaque() { int t = threadIdx.x; asm volatile("" : "+v"(t)); return t; }
#define GASP __attribute__((address_space(1)))
#define PIN(i) ((const float*)(const GASP float*)karg64<8 * (i)>())
#define POUT ((float*)(GASP float*)karg64<8 * 33>())
#define PWS ((unsigned char*)(GASP unsigned char*)karg64<8 * 34>())
constexpr int NWAVES = 8, LDS_BYTES = 147456, LDS_CTL_OFF = LDS_BYTES - 64, CW_BAR = 4096, CW_PASSA = 1024, CW_PASSA_TOP = 3200;
constexpr size_t WL_STRIDE = 40 * MiB, WO_W1A = 0, WO_W2A = 11 * MiB, WO_WIN = 16 * MiB + MiB / 2, WO_WOUT = 21 * MiB, WO_W1B = 23 * MiB, WO_W2B = 34 * MiB;
enum { PH_PRO = 0, PH_X0 = 1, PH_F1IN = 2, PH_F1OUT, PH_WIN, PH_MIX1, PH_MIX2, PH_WOUT, PH_F2IN, PH_F2OUT, PH_PER_LAYER = 8 };
constexpr int NPHASES = 2 + DEPTH * PH_PER_LAYER;
constexpr int PROBE_REP_MASK = 0;


namespace pg8 {
#define PG8_LAS __attribute__((address_space(3)))
typedef unsigned short bf16_t;
typedef short bf16x8 __attribute__((ext_vector_type(8)));
typedef float f32x4 __attribute__((ext_vector_type(4)));
typedef unsigned u32x4 __attribute__((ext_vector_type(4)));
constexpr int BM = 256, BK = 64, HALF = 128, HTB = HALF * BK * 2  , STAGE_BYTES = 8 * HTB, NXCD = 8, WGM = 8;

__host__ __device__ __forceinline__ int lds_byte(int r, int c) { const int st = (r >> 4) * 2 + (c >> 5), rr = r & 15, cc = c & 31, ob = rr * 64 + cc * 2; return st * 1024 + (ob ^ (((ob >> 9) & 1) << 5)); }
__host__ __device__ __forceinline__ void stage_rc(int b, int& R, int& C) { const int st = b / 1024, sb = b % 1024, swz = sb ^ (((sb >> 9) & 1) << 5); R = (st >> 1) * 16 + swz / 64; C = (st & 1) * 32 + (swz % 64) / 2; }
__host__ __device__ __forceinline__ int perm32(int rho) { const int n = rho >> 4, i = rho & 15; return 8 * (i >> 2) + 4 * n + (i & 3); }

struct Unit { int pm, pn, mask; };
struct Gemm { const bf16_t* A; const bf16_t* Bt; int M, N, K; };

struct StaticOrder {
    int nM, nN, nwg, G, c;
    __host__ __device__ void init(int M, int N, int G_, int c_) { nM = M / BM; nN = N / BM; nwg = nM * nN; G = G_; c = c_; }
    __host__ __device__ bool next(int i, Unit& u) const {
        const int rfull = nwg / G, left = nwg - rfull * G;
        long L = (long)i * G + c; u.mask = 3;
        if (i == rfull && left > 0 && 2 * left <= G) { if (c >= 2 * left) return false; L = (long)i * G + (c >> 1); u.mask = 1 << (c & 1); }
        if (L >= nwg) return false;
        int wgid = (int)L; { const int q = nwg / NXCD, r = nwg % NXCD, xcd = wgid % NXCD, off = wgid / NXCD; wgid = (xcd < r ? xcd * (q + 1) : r * (q + 1) + (xcd - r) * q) + off; }
        const int nig = WGM * nN, gid = wgid / nig, fm = gid * WGM, gsz = (nM - fm) < WGM ? (nM - fm) : WGM;
        u.pm = fm + ((wgid % nig) % gsz); u.pn = (wgid % nig) / gsz; return true;
    }
    __device__ __forceinline__ void a_ready(const Unit&) const {}
    __device__ __forceinline__ void done(const Unit&) const {}
};
__device__ __forceinline__ unsigned cvt_pk_bf16(float lo, float hi) { unsigned r; asm volatile("v_cvt_pk_bf16_f32 %0, %1, %2" : "=v"(r) : "v"(lo), "v"(hi)); return r; }

__device__ __forceinline__ float silu_fast(float x) { return x * __builtin_amdgcn_rcpf(1.f + __builtin_amdgcn_exp2f(-1.4426950408889634f * x)); }
__device__ __forceinline__ float gelu_fast(float x) {
    const float u2 = 1.5957691216057308f * (x + 0.044715f * x * x * x);
    return x * __builtin_amdgcn_rcpf(1.f + __builtin_amdgcn_exp2f(-1.4426950408889634f * u2));
}
struct EpiFfnIn {
    static constexpr bool PERM = true, AFTER_DRAIN = false;
    int l, second;
    __device__ __forceinline__ void operator()(const f32x4 (&acc)[2][2][4][2], const Unit& u, int wr, int wc, int fr, int fq) const {
        asm volatile("" : "+v"(fr), "+v"(fq));
        unsigned char* ws = PWS; bf16_t* ACT = (bf16_t*)(ws + WS_ACT);
        const float* rowss = (const float*)(ws + WS_ROWSS) + (size_t)(l * 3 + (second ? 2 : 0)) * MT; const float* shw = (const float*)(ws + WS_SHW) + (size_t)l * SHW_LAYER + (second ? SHW_J2 : 0);
        const int row0 = u.pm * 256 + wr * 64 + fr, col0 = u.pn * 128 + wc * 32 + 8 * fq;
        const float* sp = shw + (size_t)modrow(u.pm * 256) * (2 * FF) + u.pn * 256 + wc * 32 + 8 * fq;
        const f32x4 sg0 = *(const f32x4*)sp, sg1 = *(const f32x4*)(sp + 4), su0 = *(const f32x4*)(sp + 128), su1 = *(const f32x4*)(sp + 132);
#pragma unroll
        for (int ai = 0; ai < 2; ++ai) if ((u.mask >> ai) & 1)
#pragma unroll
            for (int m = 0; m < 4; ++m) {
                const int row = row0 + ai * 128 + m * 16;
                const float ri = rsqrtf(rowss[row] * (1.f / D) + 1e-6f);
                const f32x4 g0 = acc[ai][0][m][0] * ri + sg0, g1 = acc[ai][0][m][1] * ri + sg1, u0 = acc[ai][1][m][0] * ri + su0, u1 = acc[ai][1][m][1] * ri + su1;
                u32x4 w;
                w.x = cvt_pk_bf16(silu_fast(g0[0]) * u0[0], silu_fast(g0[1]) * u0[1]); w.y = cvt_pk_bf16(silu_fast(g0[2]) * u0[2], silu_fast(g0[3]) * u0[3]);
                w.z = cvt_pk_bf16(silu_fast(g1[0]) * u1[0], silu_fast(g1[1]) * u1[1]); w.w = cvt_pk_bf16(silu_fast(g1[2]) * u1[2], silu_fast(g1[3]) * u1[3]);
                *(u32x4*)(ACT + (size_t)row * FF + col0) = w;
            }
    }
};
typedef _Float16 f16x8 __attribute__((ext_vector_type(8)));
typedef _Float16 f16x4 __attribute__((ext_vector_type(4)));
typedef float f32x8 __attribute__((ext_vector_type(8)));
struct EpiRes {
    static constexpr bool PERM = true, AFTER_DRAIN = false;
    int l, kind;
    __device__ __forceinline__ void operator()(const f32x4 (&acc)[2][2][4][2], const Unit& u, int wr, int wc, int fr, int fq) const {
        asm volatile("" : "+v"(fr), "+v"(fq));
        unsigned char* ws = PWS; float* X = POUT;
        const int step = l * 3 + kind;
        const bool out_f32 = step == DEPTH * 3 - 1;
        const GASP unsigned char* rp; GASP unsigned char* wp;
        if (out_f32) rp = (const GASP unsigned char*)(u.pm < XH2_SPLIT_PM ? ws + WS_W : ws + WS_XH2B - (size_t)XH2_SPLIT_PM * 256 * D * 2);
        else rp = (const GASP unsigned char*)X + XH_OUT_OFF;
        if (out_f32) wp = (GASP unsigned char*)X;
        else if (step == DEPTH * 3 - 2) wp = (GASP unsigned char*)(u.pm < XH2_SPLIT_PM ? ws + WS_W : ws + WS_XH2B - (size_t)XH2_SPLIT_PM * 256 * D * 2);
        else wp = (GASP unsigned char*)X + XH_OUT_OFF;
        const int row0 = u.pm * 256 + wr * 64 + fr, mr = modrow(u.pm * 256);
        const float fac = kind == 1 ? 1.f : 0.5f;
        const float* gate = (const float*)(ws + WS_MOD) + ((size_t)l * 5 + mr) * NMOD * D + (kind == 0 ? 2 : kind == 1 ? 5 : 8) * D;
        const int nl = kind == 2 ? l + 1 : l, nn = nl * 3 + (kind == 0 ? 1 : kind == 1 ? 2 : 0);
        const bool wn = nl < DEPTH;
        bf16_t* H = (bf16_t*)(ws + WS_H); const float* wnp = (const float*)(ws + WS_WN) + ((size_t)nn * 5 + mr) * D; float* rowss_next = (float*)(ws + WS_ROWSS) + (size_t)nn * MT;
        f32x4 ga[2], gb[2], wa[2], wb[2];
#pragma unroll
        for (int bj = 0; bj < 2; ++bj) {
            const int col = u.pn * 256 + bj * 128 + wc * 32 + 8 * fq;
            ga[bj] = *(const f32x4*)(gate + col) * fac; gb[bj] = *(const f32x4*)(gate + col + 4) * fac;
            wa[bj] = (f32x4){0.f, 0.f, 0.f, 0.f}; wb[bj] = wa[bj];
            if (wn) { wa[bj] = *(const f32x4*)(wnp + col); wb[bj] = *(const f32x4*)(wnp + col + 4); }
        }
#pragma unroll
        for (int ai = 0; ai < 2; ++ai) if ((u.mask >> ai) & 1)
#pragma unroll
            for (int m = 0; m < 4; ++m) {
                const int row = row0 + ai * 128 + m * 16;
                float ssq = 0.f;
#pragma unroll
                for (int bj = 0; bj < 2; ++bj) {
                    const size_t ro = (size_t)row * D + u.pn * 256 + bj * 128 + wc * 32 + 8 * fq;
                    f32x4 x0, x1;
                    { const f32x8 fv = __builtin_convertvector(*(const GASP f16x8*)((const GASP _Float16*)rp + ro), f32x8); x0 = fv.lo; x1 = fv.hi; }
                    x0 += ga[bj] * acc[ai][bj][m][0]; x1 += gb[bj] * acc[ai][bj][m][1];
                    if (out_f32) { GASP float* x = (GASP float*)wp + ro; *(GASP f32x4*)x = x0; *(GASP f32x4*)(x + 4) = x1; }
                    else { f32x8 fv; fv.lo = x0; fv.hi = x1; *(GASP f16x8*)((GASP _Float16*)wp + ro) = __builtin_convertvector(fv, f16x8); }
                    if (wn) {
                        ssq += ((x0[0] * x0[0] + x0[1] * x0[1]) + (x0[2] * x0[2] + x0[3] * x0[3])) + ((x1[0] * x1[0] + x1[1] * x1[1]) + (x1[2] * x1[2] + x1[3] * x1[3]));
                        const f32x4 h0 = x0 * wa[bj], h1 = x1 * wb[bj];
                        u32x4 w; w.x = cvt_pk_bf16(h0[0], h0[1]); w.y = cvt_pk_bf16(h0[2], h0[3]); w.z = cvt_pk_bf16(h1[0], h1[1]); w.w = cvt_pk_bf16(h1[2], h1[3]);
                        *(u32x4*)(H + ro) = w;
                    }
                }
                if (wn) { ssq += __shfl_xor(ssq, 16); ssq += __shfl_xor(ssq, 32); if (fq == 0) (void)__hip_atomic_fetch_add(rowss_next + row, ssq, __ATOMIC_RELAXED, __HIP_MEMORY_SCOPE_AGENT); }
            }
    }
};
struct EpiWin {
    static constexpr bool PERM = true, AFTER_DRAIN = false;
    int l;
    __device__ __forceinline__ void operator()(f32x4 (&acc)[2][2][4][2], const Unit& u, int wr, int wc, int fr, int fq) const {
        asm volatile("" : "+v"(fr), "+v"(fq));
        unsigned char* ws = PWS; float* out = POUT; const float* qn = PIN(25) + l * HD; const float* kn = PIN(26) + l * HD;
        const float* rowss = (const float*)(ws + WS_ROWSS) + (size_t)(l * 3 + 1) * MT; const float* shw = (const float*)(ws + WS_SHW) + (size_t)l * SHW_LAYER + SHW_J1;
        const int row0 = u.pm * 256 + wr * 64 + fr, pn = u.pn;
        {
            const float* sp = shw + (size_t)modrow(u.pm * 256) * INC + pn * 256 + wc * 32 + 8 * fq;
            f32x4 sv[2][2];
#pragma unroll
            for (int bj = 0; bj < 2; ++bj) { sv[bj][0] = *(const f32x4*)(sp + bj * 128); sv[bj][1] = *(const f32x4*)(sp + bj * 128 + 4); }
#pragma unroll
            for (int ai = 0; ai < 2; ++ai) if ((u.mask >> ai) & 1)
#pragma unroll
                for (int m = 0; m < 4; ++m) {
                    const float ri = rsqrtf(rowss[row0 + ai * 128 + m * 16] * (1.f / D) + 1e-6f);
#pragma unroll
                    for (int bj = 0; bj < 2; ++bj) { acc[ai][bj][m][0] = acc[ai][bj][m][0] * ri + sv[bj][0]; acc[ai][bj][m][1] = acc[ai][bj][m][1] * ri + sv[bj][1]; }
                }
        }
        float* XS = (float*)(ws + WS_XSSM); bf16_t* Q = (bf16_t*)(ws + WS_Q); bf16_t* K = (bf16_t*)(ws + WS_K); bf16_t* VT = (bf16_t*)(ws + WS_VT); bf16_t* U = (bf16_t*)(ws + WS_U); bf16_t* VG = (bf16_t*)(ws + WS_VG);
        float* ock = out + O_CK; float* ocv = out + O_CV;
        if (pn == 0) {
#pragma unroll
            for (int ai = 0; ai < 2; ++ai) if ((u.mask >> ai) & 1)
#pragma unroll
                for (int m = 0; m < 4; ++m)
#pragma unroll
                    for (int bj = 0; bj < 2; ++bj) { float* o = XS + (size_t)(row0 + ai * 128 + m * 16) * SSMW + bj * 128 + wc * 32 + 8 * fq;
                        *(f32x4*)o = acc[ai][bj][m][0]; *(f32x4*)(o + 4) = acc[ai][bj][m][1]; }
        } else if (pn <= 4) {
            const bool isk = pn >= 3; const int h = 4 * ((pn - 1) & 1) + wc;
            const float* gn = isk ? kn : qn; bf16_t* O = isk ? K : Q;
            f32x4 gv[2][2];
#pragma unroll
            for (int bj = 0; bj < 2; ++bj)
#pragma unroll
                for (int n = 0; n < 2; ++n) gv[bj][n] = *(const f32x4*)(gn + 32 * bj + 8 * fq + 4 * n);
#pragma unroll
            for (int ai = 0; ai < 2; ++ai) if ((u.mask >> ai) & 1)
#pragma unroll
                for (int m = 0; m < 4; ++m) {
                    float ss = 0.f;
#pragma unroll
                    for (int bj = 0; bj < 2; ++bj)
#pragma unroll
                        for (int n = 0; n < 2; ++n) { const f32x4 v = acc[ai][bj][m][n]; ss += (v[0] * v[0] + v[1] * v[1]) + (v[2] * v[2] + v[3] * v[3]); }
                    ss += __shfl_xor(ss, 16); ss += __shfl_xor(ss, 32);
                    const float rinv = rsqrtf(ss * (1.f / HD) + 1e-6f);
                    const int row = row0 + ai * 128 + m * 16;
#pragma unroll
                    for (int bj = 0; bj < 2; ++bj) {
                        const f32x4 v0 = acc[ai][bj][m][0] * rinv * gv[bj][0], v1 = acc[ai][bj][m][1] * rinv * gv[bj][1];
                        u32x4 w; w.x = cvt_pk_bf16(v0[0], v0[1]); w.y = cvt_pk_bf16(v0[2], v0[3]); w.z = cvt_pk_bf16(v1[0], v1[1]); w.w = cvt_pk_bf16(v1[2], v1[3]);
                        const int d = 32 * bj + 8 * fq;
                        *(u32x4*)(O + (size_t)row * NAW + h * HD + d) = w;
                        if (isk && u.pm < MC / 256) { const int b = row / SEQ, t = row % SEQ; float* o = ock + ((((size_t)b * DEPTH + l) * SEQ + t) * NH + h) * HD + d;
                            *(f32x4*)o = v0; *(f32x4*)(o + 4) = v1; }
                    }
                }
        } else if (pn <= 6) {
            const bool ctx = u.pm < MC / 256;
#pragma unroll
            for (int ai = 0; ai < 2; ++ai) if ((u.mask >> ai) & 1)
#pragma unroll
                for (int m = 0; m < 4; ++m) {
                    const int row = row0 + ai * 128 + m * 16;
                    size_t vb; int Lq; float* oc = nullptr;
                    if (ctx) { const int b = row / SEQ, t = row % SEQ; vb = (size_t)b * NH * HD * SEQ + t; Lq = SEQ; oc = ocv + (((size_t)b * DEPTH + l) * SEQ + t) * NAW; }
                    else { const int r2 = row - MC, b = r2 / DSEQ, t = r2 % DSEQ; vb = (size_t)MC * NAW + (size_t)b * NH * HD * DSEQ + t; Lq = DSEQ; }
#pragma unroll
                    for (int bj = 0; bj < 2; ++bj) {
                        const int cl = (pn - 5) * 256 + bj * 128 + wc * 32 + 8 * fq;
                        const f32x4 v0 = acc[ai][bj][m][0], v1 = acc[ai][bj][m][1];
                        bf16_t* o = VT + vb + (size_t)cl * Lq;
                        o[0] = f2bf(v0[0]); o[(size_t)Lq] = f2bf(v0[1]); o[(size_t)2 * Lq] = f2bf(v0[2]); o[(size_t)3 * Lq] = f2bf(v0[3]);
                        o[(size_t)4 * Lq] = f2bf(v1[0]); o[(size_t)5 * Lq] = f2bf(v1[1]); o[(size_t)6 * Lq] = f2bf(v1[2]); o[(size_t)7 * Lq] = f2bf(v1[3]);
                        if (ctx) { *(f32x4*)(oc + cl) = v0; *(f32x4*)(oc + cl + 4) = v1; }
                    }
                }
        } else {
            bf16_t* O = pn == 7 ? U : VG;
#pragma unroll
            for (int ai = 0; ai < 2; ++ai) if ((u.mask >> ai) & 1)
#pragma unroll
                for (int m = 0; m < 4; ++m)
#pragma unroll
                    for (int bj = 0; bj < 2; ++bj) {
                        const f32x4 v0 = acc[ai][bj][m][0], v1 = acc[ai][bj][m][1];
                        u32x4 w; w.x = cvt_pk_bf16(gelu_fast(v0[0]), gelu_fast(v0[1])); w.y = cvt_pk_bf16(gelu_fast(v0[2]), gelu_fast(v0[3]));
                        w.z = cvt_pk_bf16(gelu_fast(v1[0]), gelu_fast(v1[1])); w.w = cvt_pk_bf16(gelu_fast(v1[2]), gelu_fast(v1[3]));
                        *(u32x4*)(O + (size_t)(row0 + ai * 128 + m * 16) * GMW + bj * 128 + wc * 32 + 8 * fq) = w;
                    }
        }
    }
};

template <class Epi, class Sched, bool ALIGN_EPI = false, bool SP2 = false>
__device__ __forceinline__ void gemm_phase(PG8_LAS unsigned char* lds, const Gemm g, const Sched& S, const Epi& E) {
    const int tid = tid_opaque(), wid = __builtin_amdgcn_readfirstlane(tid >> 6), lane = tid & 63, wr = wid >> 2, wc = wid & 3, fr = lane & 15, fq = lane >> 4;
    const int K = g.K, nt = K / BK;
    unsigned voffA[2], voffB[2];
#pragma unroll
    for (int i = 0; i < 2; ++i) { int R, C; stage_rc(tid * 16 + i * 8192, R, C); const int Rb = Epi::PERM ? ((R & ~31) + perm32(R & 31)) : R;
        voffA[i] = (unsigned)(R * K + C) * 2u; voffB[i] = (unsigned)(Rb * K + C) * 2u; }
    const size_t kstep = (size_t)(BK * 2);
    const size_t hstep = (size_t)HALF * K * 2;
    const size_t tstep = 2 * hstep;
    const unsigned ldsw = (unsigned)wid * 1024u;
    const int aoff = lds_byte(wr * 64 + fr, fq * 8), boff = lds_byte(wc * 32 + fr, fq * 8);
#define PG8_SA(b, h) (((b) * 2 + (h)) * HTB)
#define PG8_SB(b, h) ((4 + (b) * 2 + (h)) * HTB)
#define PG8_STAGE(bufoff, gbase, voff) do { _Pragma("unroll") for (int _i = 0; _i < 2; ++_i) \
        __builtin_amdgcn_global_load_lds((const unsigned*)((const char*)(gbase) + (voff)[_i]), (PG8_LAS unsigned*)(lds + (bufoff) + ldsw + _i * 8192), 16, 0, 0); } while (0)
#define PG8_LDA(dst, b, h) do { _Pragma("unroll") for (int m = 0; m < 4; ++m) _Pragma("unroll") for (int k = 0; k < 2; ++k) dst[m][k] = *(const PG8_LAS bf16x8*)(lds + PG8_SA(b, h) + aoff + m * 2048 + k * 1024); } while (0)
#define PG8_LDB(dst, b, h) do { _Pragma("unroll") for (int n = 0; n < 2; ++n) _Pragma("unroll") for (int k = 0; k < 2; ++k) dst[n][k] = *(const PG8_LAS bf16x8*)(lds + PG8_SB(b, h) + boff + n * 2048 + k * 1024); } while (0)
#define PG8_MMA(ai, bj, At, Bt) do { __builtin_amdgcn_s_setprio(1); _Pragma("unroll") for (int m = 0; m < 4; ++m) _Pragma("unroll") for (int n = 0; n < 2; ++n) _Pragma("unroll") for (int k = 0; k < 2; ++k) \
        acc[ai][bj][m][n] = __builtin_amdgcn_mfma_f32_16x16x32_bf16(Bt[n][k], At[m][k], acc[ai][bj][m][n], 0, 0, 0); __builtin_amdgcn_s_setprio(0); } while (0)
#define PG8_WAIT_V(n) asm volatile("s_waitcnt vmcnt(" #n ")" ::: "memory")
#define PG8_WAIT_L(n) asm volatile("s_waitcnt lgkmcnt(" #n ")" ::: "memory")
#define PG8_BAR __builtin_amdgcn_s_barrier()
#define PG8_SCHED __builtin_amdgcn_sched_barrier(0)
    Unit cur, nxt; int ui = 0;
    if (!S.next(0, cur)) return;
    f32x4 acc[2][2][4][2];
#pragma unroll
    for (int a = 0; a < 2; ++a)
#pragma unroll
        for (int b = 0; b < 2; ++b)
#pragma unroll
            for (int m = 0; m < 4; ++m)
#pragma unroll
                for (int n = 0; n < 2; ++n) acc[a][b][m][n] = (f32x4){0.f, 0.f, 0.f, 0.f};
    bf16x8 At[4][2], B0[2][2], B1[2][2];
    const char* cA = (const char*)g.A + (size_t)cur.pm * tstep; const char* cB = (const char*)g.Bt + (size_t)cur.pn * tstep;
    S.a_ready(cur);
    if constexpr (SP2) {
        PG8_STAGE(PG8_SB(0, 0), cB, voffB); PG8_STAGE(PG8_SB(0, 1), cB + hstep, voffB); PG8_STAGE(PG8_SA(0, 0), cA, voffA); PG8_STAGE(PG8_SA(0, 1), cA + hstep, voffA);
        if (wr == 1) PG8_BAR;
        PG8_WAIT_V(2); PG8_BAR;
        PG8_STAGE(PG8_SB(1, 0), cB + kstep, voffB); PG8_STAGE(PG8_SA(1, 0), cA + kstep, voffA); PG8_STAGE(PG8_SB(1, 1), cB + hstep + kstep, voffB);
        PG8_WAIT_V(6); PG8_BAR;
    } else {
        PG8_STAGE(PG8_SB(0, 0), cB, voffB); PG8_STAGE(PG8_SA(0, 0), cA, voffA); PG8_STAGE(PG8_SB(0, 1), cB + hstep, voffB); PG8_STAGE(PG8_SA(0, 1), cA + hstep, voffA);
        if (wr == 1) PG8_BAR;
        PG8_WAIT_V(4); PG8_BAR;
        PG8_STAGE(PG8_SB(1, 0), cB + kstep, voffB); PG8_STAGE(PG8_SA(1, 0), cA + kstep, voffA); PG8_STAGE(PG8_SB(1, 1), cB + hstep + kstep, voffB);
        PG8_WAIT_V(6); PG8_BAR;
    }
    for (;;) {
        const bool has_next = S.next(ui + 1, nxt);
        const char* nA = has_next ? (const char*)g.A + (size_t)nxt.pm * tstep : cA; const char* nB = has_next ? (const char*)g.Bt + (size_t)nxt.pn * tstep : cB;
        for (int t = 0; t < nt; t += 2) {
            const bool last = (t == nt - 2);
            const char* a1 = cA + (size_t)(t + 1) * kstep;
            const char* a2 = last ? nA : cA + (size_t)(t + 2) * kstep; const char* b2 = last ? nB : cB + (size_t)(t + 2) * kstep;
            const char* a3 = a2 + kstep; const char* b3 = b2 + kstep;
            if (last && has_next) S.a_ready(nxt);
            if constexpr (SP2) {
            PG8_LDB(B0, 0, 0); PG8_LDB(B1, 0, 1); PG8_SCHED; if (cur.mask & 1) PG8_LDA(At, 0, 0); PG8_STAGE(PG8_SA(1, 1), a1 + hstep, voffA);
            PG8_WAIT_V(8); PG8_WAIT_L(0); PG8_BAR; if (cur.mask & 1) { PG8_MMA(0, 0, At, B0); PG8_MMA(0, 1, At, B1); } PG8_BAR; PG8_SCHED;
            if (cur.mask & 2) PG8_LDA(At, 0, 1); PG8_STAGE(PG8_SB(0, 0), b2, voffB); PG8_STAGE(PG8_SB(0, 1), b2 + hstep, voffB); PG8_STAGE(PG8_SA(0, 0), a2, voffA);
            PG8_WAIT_V(8); PG8_WAIT_L(0); PG8_BAR; if (cur.mask & 2) { PG8_MMA(1, 0, At, B0); PG8_MMA(1, 1, At, B1); } PG8_BAR; PG8_SCHED;
            PG8_LDB(B0, 1, 0); PG8_LDB(B1, 1, 1); PG8_SCHED; if (cur.mask & 1) PG8_LDA(At, 1, 0); PG8_STAGE(PG8_SA(0, 1), a2 + hstep, voffA);
            PG8_WAIT_V(8); PG8_WAIT_L(0); PG8_BAR; if (cur.mask & 1) { PG8_MMA(0, 0, At, B0); PG8_MMA(0, 1, At, B1); } PG8_BAR; PG8_SCHED;
            if (cur.mask & 2) PG8_LDA(At, 1, 1); PG8_STAGE(PG8_SB(1, 0), b3, voffB); PG8_STAGE(PG8_SB(1, 1), b3 + hstep, voffB); PG8_STAGE(PG8_SA(1, 0), a3, voffA);
            PG8_WAIT_V(8); PG8_WAIT_L(0); PG8_BAR; if (cur.mask & 2) { PG8_MMA(1, 0, At, B0); PG8_MMA(1, 1, At, B1); } PG8_BAR; PG8_SCHED;
            } else {
            PG8_LDB(B0, 0, 0); PG8_SCHED; PG8_LDA(At, 0, 0); PG8_STAGE(PG8_SA(1, 1), a1 + hstep, voffA);
            PG8_WAIT_L(8); PG8_BAR; PG8_WAIT_L(0); PG8_MMA(0, 0, At, B0); PG8_BAR; PG8_SCHED;
            PG8_LDB(B1, 0, 1); PG8_STAGE(PG8_SB(0, 0), b2, voffB);
            PG8_BAR; PG8_WAIT_L(0); PG8_MMA(0, 1, At, B1); PG8_BAR;
            PG8_LDA(At, 0, 1); PG8_STAGE(PG8_SA(0, 0), a2, voffA);
            PG8_BAR; PG8_WAIT_L(0); PG8_MMA(1, 0, At, B0); PG8_BAR; PG8_SCHED;
            PG8_STAGE(PG8_SB(0, 1), b2 + hstep, voffB);
            PG8_WAIT_V(6); PG8_BAR; PG8_MMA(1, 1, At, B1); PG8_BAR;
            PG8_LDB(B0, 1, 0); PG8_SCHED; PG8_LDA(At, 1, 0); PG8_STAGE(PG8_SA(0, 1), a2 + hstep, voffA);
            PG8_WAIT_L(8); PG8_BAR; PG8_WAIT_L(0); PG8_MMA(0, 0, At, B0); PG8_BAR; PG8_SCHED;
            PG8_LDB(B1, 1, 1); PG8_STAGE(PG8_SB(1, 0), b3, voffB);
            PG8_BAR; PG8_WAIT_L(0); PG8_MMA(0, 1, At, B1); PG8_BAR;
            PG8_LDA(At, 1, 1); PG8_STAGE(PG8_SA(1, 0), a3, voffA);
            PG8_BAR; PG8_WAIT_L(0); PG8_MMA(1, 0, At, B0); PG8_BAR; PG8_SCHED;
            PG8_STAGE(PG8_SB(1, 1), b3 + hstep, voffB);
            PG8_WAIT_V(6); PG8_BAR; PG8_MMA(1, 1, At, B1); PG8_BAR;
            }
        }
        if constexpr (ALIGN_EPI) { if (wr == 0) PG8_BAR; }
        if constexpr (!Epi::AFTER_DRAIN) { E(acc, cur, wr, wc, fr, fq); S.done(cur); }
        if (!has_next) break;
#pragma unroll
        for (int a = 0; a < 2; ++a)
#pragma unroll
            for (int b = 0; b < 2; ++b)
#pragma unroll
                for (int m = 0; m < 4; ++m)
#pragma unroll
                    for (int n = 0; n < 2; ++n) acc[a][b][m][n] = (f32x4){0.f, 0.f, 0.f, 0.f};
        cur = nxt; cA = nA; cB = nB; ++ui;
        if constexpr (ALIGN_EPI) { if (wr == 1) PG8_BAR; }
    }
    PG8_WAIT_V(0);
    if constexpr (!ALIGN_EPI) { if (wr == 0) PG8_BAR; }
    PG8_BAR;
    if constexpr (Epi::AFTER_DRAIN) { E.fused(acc, cur, wr, wc, fr, fq, lds, wid, lane); S.done(cur); }
#undef PG8_SA
#undef PG8_SB
#undef PG8_STAGE
#undef PG8_LDA
#undef PG8_LDB
#undef PG8_MMA
#undef PG8_WAIT_V
#undef PG8_WAIT_L
#undef PG8_BAR
#undef PG8_SCHED
}

}

#define LAS __attribute__((address_space(3)))

__device__ __forceinline__ void transpose_item(const float* W, int K, int N, bf16_t* WT, int k0, int ns0, int nd0, LAS float* scr, int lane) {
    float v[32];
    const float* wp = W + (size_t)(k0 + (lane >> 5)) * N + ns0 + (lane & 31);
#pragma unroll
    for (int i = 0; i < 32; ++i) v[i] = wp[(size_t)(2 * i) * N];
#pragma unroll
    for (int i = 0; i < 32; ++i) scr[(2 * i + (lane >> 5)) * 33 + (lane & 31)] = v[i];
    asm volatile("s_waitcnt lgkmcnt(0)" ::: "memory");
    const int c = lane & 7;
#pragma unroll
    for (int j = 0; j < 4; ++j) { const int n = (lane >> 3) + 8 * j; const LAS float* s = scr + (8 * c) * 33 + n;
        pg8::u32x4 o; o.x = pg8::cvt_pk_bf16(s[0 * 33], s[1 * 33]); o.y = pg8::cvt_pk_bf16(s[2 * 33], s[3 * 33]); o.z = pg8::cvt_pk_bf16(s[4 * 33], s[5 * 33]); o.w = pg8::cvt_pk_bf16(s[6 * 33], s[7 * 33]);
        *(pg8::u32x4*)(WT + (size_t)(nd0 + n) * K + k0 + 8 * c) = o; }
    asm volatile("s_waitcnt lgkmcnt(0)" ::: "memory");
}
__device__ __forceinline__ void prologue_phase(LAS unsigned char* lds, int vcu, int G) {
    const int tid = tid_opaque(), lane = tid & 63, wave = __builtin_amdgcn_readfirstlane(tid >> 6);
    {
        LAS float* sc = (LAS float*)lds;
        LAS float* red = (LAS float*)(lds + 20480);
        const float* cctx = PIN(6); const float* cc = PIN(2);
        for (int i = tid; i < 5 * D; i += NWAVES * 64) { const int r = i / D, k = i % D; const float v = r == 0 ? cctx[k] : cc[(r - 1) * D + k]; sc[i] = v / (1.f + __expf(-v)); }
        __syncthreads();
        constexpr int KQ = 16, NBLK = NMOD * D / 128, NIT = DEPTH * NBLK * KQ;
        int it0 = (int)((long)vcu * NIT / G); const int it1 = (int)((long)(vcu + 1) * NIT / G);
        while (it0 < it1) {
            const int blk = it0 / KQ, ke = it1 < (blk + 1) * KQ ? it1 : (blk + 1) * KQ, nk = ke - it0;
            const int l = blk / NBLK, n0 = (blk % NBLK) * 128, kbeg = (it0 % KQ) * (D / KQ);
            const float* w = PIN(7) + (size_t)l * D * NMOD * D + n0 + (lane & 31) * 4;
            const int kb = kbeg + wave * (nk * 8) + (lane >> 5), nl = nk * 4;
            pg8::f32x4 a[5];
#pragma unroll
            for (int r = 0; r < 5; ++r) a[r] = (pg8::f32x4){0.f, 0.f, 0.f, 0.f};
#pragma unroll 1
            for (int i0 = 0; i0 < nl; i0 += 12) {
                pg8::f32x4 wv[12];
#pragma unroll
                for (int i = 0; i < 12; ++i) { const int ii = i0 + i < nl ? i0 + i : nl - 1; wv[i] = *(const pg8::f32x4*)(w + (size_t)(kb + 2 * ii) * NMOD * D); }
#pragma unroll
                for (int i = 0; i < 12; ++i) { const bool ok = i0 + i < nl; const int k = kb + 2 * (ok ? i0 + i : nl - 1);
#pragma unroll
                    for (int r = 0; r < 5; ++r) a[r] += wv[i] * (ok ? sc[r * D + k] : 0.f); }
            }
#pragma unroll
            for (int r = 0; r < 5; ++r) {
#pragma unroll
                for (int e = 0; e < 4; ++e) a[r][e] += __shfl_xor(a[r][e], 32);
                if (lane < 32) *(LAS pg8::f32x4*)(red + (wave * 5 + r) * 128 + lane * 4) = a[r]; }
            __syncthreads();
            const float* bada = PIN(8); float* modo = (float*)(PWS + WS_MOD);
            for (int o = tid; o < 5 * 128; o += NWAVES * 64) { const int r = o / 128, c = o % 128; float s = kbeg == 0 ? bada[l * NMOD * D + n0 + c] : 0.f;
#pragma unroll
                for (int w8 = 0; w8 < 8; ++w8) s += red[(w8 * 5 + r) * 128 + c];
                (void)__hip_atomic_fetch_add(modo + ((size_t)l * 5 + r) * NMOD * D + n0 + c, s, __ATOMIC_RELAXED, __HIP_MEMORY_SCOPE_AGENT); }
            __syncthreads();
            it0 = ke;
        }
        __syncthreads();
    }
    {
        LAS float* scr = (LAS float*)(lds + wave * 16384);
        const int gw = vcu * NWAVES + wave, NGW = G * NWAVES;
        constexpr int I_FIN = (D / 64) * (2 * FF / 32), I_FOUT = (FF / 64) * (D / 32), I_WIN = (D / 64) * (INC / 32), I_WOUT = (D / 64) * (D / 32);
        constexpr int I_LAYER = 2 * I_FIN + 2 * I_FOUT + I_WIN + I_WOUT;
        for (int it = gw; it < DEPTH * I_LAYER; it += NGW) {
            const int l = it / I_LAYER; int r = it % I_LAYER;
            unsigned char* wl = PWS + WS_W + (size_t)l * WL_STRIDE;
            int which = 0;
            if (r >= I_FIN) { r -= I_FIN; which = 1; if (r >= I_FOUT) { r -= I_FOUT; which = 2; if (r >= I_WIN) { r -= I_WIN; which = 3; if (r >= I_WOUT) { r -= I_WOUT; which = 4; if (r >= I_FIN) { r -= I_FIN; which = 5; } } } } }
            if (which == 0 || which == 4) {
                const float* W = (which == 0 ? PIN(10) : PIN(31)) + (size_t)l * D * 2 * FF; bf16_t* WT = (bf16_t*)(wl + (which == 0 ? WO_W1A : WO_W1B));
                const int nblk = 2 * FF / 32, kb = r / nblk, nd0 = (r % nblk) * 32; const int pn = nd0 / 256, c = nd0 % 256, bj = c / 128, x = c % 128;
                transpose_item(W, D, 2 * FF, WT, kb * 64, bj * FF + 128 * pn + x, nd0, scr, lane);
            } else if (which == 1 || which == 5) {
                const float* W = (which == 1 ? PIN(11) : PIN(32)) + (size_t)l * FF * D; bf16_t* WT = (bf16_t*)(wl + (which == 1 ? WO_W2A : WO_W2B));
                const int nblk = D / 32, kb = r / nblk, nd0 = (r % nblk) * 32;
                transpose_item(W, FF, D, WT, kb * 64, nd0, nd0, scr, lane);
            } else if (which == 2) {
                const float* W = PIN(13) + (size_t)l * D * INC; bf16_t* WT = (bf16_t*)(wl + WO_WIN);
                const int nblk = INC / 32, kb = r / nblk, nd0 = (r % nblk) * 32; const int pn = nd0 / 256, c = nd0 % 256;
                int ns0 = nd0; if (pn >= 1 && pn <= 4) { const int bj = c / 128, wc = (c % 128) / 32; ns0 = 256 * pn + 64 * wc + 32 * bj; }
                transpose_item(W, D, INC, WT, kb * 64, ns0, nd0, scr, lane);
            } else {
                const float* W = PIN(14) + (size_t)l * D * D; bf16_t* WT = (bf16_t*)(wl + WO_WOUT);
                const int nblk = D / 32, kb = r / nblk, nd0 = (r % nblk) * 32;
                transpose_item(W, D, D, WT, kb * 64, nd0, nd0, scr, lane);
            }
        }
    }
    const int gt = vcu * (NWAVES * 64) + tid, NGT = G * NWAVES * 64;
    const int gtr = (G - 1 - vcu) * (NWAVES * 64) + tid;
    {
        constexpr int NSLOT = DEPTH * 4 * 128 * 128, CTOT = DB * DEPTH * PAST * NH * HD;
        static_assert(DEPTH * SSMW * SSMW == NSLOT && CTOT == 8 * NSLOT && DEPTH * 3 * MT <= 2 * NSLOT, "slot loop layout");
        const float* gws = PIN(28); bf16_t* wsb = (bf16_t*)(PWS + WS_WSB); const float* glw = PIN(23); bf16_t* glt = (bf16_t*)(PWS + WS_GLT); float* rs = (float*)(PWS + WS_ROWSS);
        const float* cki = PIN(3); const float* cvi = PIN(4); bf16_t* cko = (bf16_t*)(PWS + WS_CK); bf16_t* cvo = (bf16_t*)(PWS + WS_CVT);
        for (int sl = gt; sl < NSLOT; sl += NGT) {
            const float w0 = gws[sl];
            const int gk = sl % SSMW, gn = (sl / SSMW) % SSMW, gl = sl / (SSMW * SSMW);
            const float g0 = glw[((size_t)gl * SSMW + gk) * SSMW + gn];
            float kv[8], vv[8];
#pragma unroll
            for (int j = 0; j < 8; ++j) { kv[j] = cki[sl + j * NSLOT]; vv[j] = cvi[sl + j * NSLOT]; }
            wsb[sl] = f2bf(w0); glt[sl] = f2bf(g0);
            rs[sl] = 0.f; if (sl + NSLOT < DEPTH * 3 * MT) rs[sl + NSLOT] = 0.f;
#pragma unroll
            for (int j = 0; j < 8; ++j) { const int idx = sl + j * NSLOT;
                const int d = idx % HD, h = (idx / HD) % NH, t = (idx / (HD * NH)) % PAST, l = (idx / (HD * NH * PAST)) % DEPTH, b = idx / (HD * NH * PAST * DEPTH);
                cko[((((size_t)l * DB + b) * NH + h) * PAST + t) * HD + d] = f2bf(kv[j]);
                cvo[((((size_t)l * DB + b) * NH + h) * HD + d) * PAST + t] = f2bf(vv[j]); }
        }
    }
    for (int idx = gtr; idx < DEPTH * 2 * SG * SP; idx += NGT) {
        const int g = (idx / SP) % SG, ld = idx / (SP * SG);
        const float lre = PIN(15)[idx], lim = PIN(16)[idx];
        const float dt = expf(PIN(17)[ld * SG + g]);
        const float er = expf(lre * dt); float sn, cs; sincosf(lim * dt, &sn, &cs);
        const float br = er * cs, bi = er * sn;
        const float nr = br - 1.f, ni = bi, den = lre * lre + lim * lim;
        const float cr = (nr * lre + ni * lim) / den, ci = (ni * lre - nr * lim) / den;
        float2* lb = (float2*)(PWS + WS_SSMP); float2* bb = (float2*)(PWS + WS_SSMP + 64 * 1024);
        lb[idx] = make_float2(br, bi);
        const float* bre = PIN(18); const float* bim = PIN(19);
        float bxr[SC], bxi[SC];
#pragma unroll
        for (int c = 0; c < SC; ++c) { const float xr = bre[(size_t)idx * SC + c], xi = bim[(size_t)idx * SC + c];
            bxr[c] = cr * xr - ci * xi; bxi[c] = cr * xi + ci * xr; bb[(size_t)idx * SC + c] = make_float2(bxr[c], bxi[c]); }
        const int pp = idx % SP; pg8::u32x4* bmf = (pg8::u32x4*)(PWS + WS_BMF) + ((size_t)(idx / SP) * 8 + pp / 8) * 64;
#pragma unroll
        for (int part = 0; part < 2; ++part)
#pragma unroll
            for (int q4 = 0; q4 < 4; ++q4) { const int c0 = 8 * (q4 & 1); pg8::u32x4 w;
                w.x = pg8::cvt_pk_bf16(part ? bxi[c0 + 0] : bxr[c0 + 0], part ? bxi[c0 + 1] : bxr[c0 + 1]); w.y = pg8::cvt_pk_bf16(part ? bxi[c0 + 2] : bxr[c0 + 2], part ? bxi[c0 + 3] : bxr[c0 + 3]);
                w.z = pg8::cvt_pk_bf16(part ? bxi[c0 + 4] : bxr[c0 + 4], part ? bxi[c0 + 5] : bxr[c0 + 5]); w.w = pg8::cvt_pk_bf16(part ? bxi[c0 + 6] : bxr[c0 + 6], part ? bxi[c0 + 7] : bxr[c0 + 7]);
                bmf[16 * q4 + 2 * (pp % 8) + part] = w; }
    }
    {
        const float* cre0 = PIN(20); const float* cim0 = PIN(21); pg8::u32x4* cff = (pg8::u32x4*)(PWS + WS_CFF);
        for (int idx = gtr; idx < DEPTH * 2 * SG * 4 * 64; idx += NGT) {
            const int ln = idx & 63, ks = (idx >> 6) & 3, ldg = idx >> 8, rr = ln & 15, qq = ln >> 4;
            const float* a = cre0 + ((size_t)ldg * SC + rr) * SP + 16 * ks + 4 * qq; const float* b = cim0 + ((size_t)ldg * SC + rr) * SP + 16 * ks + 4 * qq;
            pg8::u32x4 w; w.x = pg8::cvt_pk_bf16(a[0], -b[0]); w.y = pg8::cvt_pk_bf16(a[1], -b[1]); w.z = pg8::cvt_pk_bf16(a[2], -b[2]); w.w = pg8::cvt_pk_bf16(a[3], -b[3]);
            cff[idx] = w;
        }
    }
}
__device__ __forceinline__ void x0_phase(int vcu, int G) {
    const int tid = tid_opaque(), lane = tid & 63, wave = __builtin_amdgcn_readfirstlane(tid >> 6);
    const int gw = vcu * NWAVES + wave, NGW = G * NWAVES;
    const float* modb = (const float*)(PWS + WS_MOD);
    {
        const float* gain = PIN(9); const float* xp = PIN(0); const float* xs = PIN(1); bf16_t* Hb = (bf16_t*)(PWS + WS_H); float* rs = (float*)(PWS + WS_ROWSS);
        for (int row = gw; row < MT; row += NGW) {
            const float* src = row < MC ? xp + (size_t)row * D : xs + (size_t)(row - MC) * D;
            const float* sc = modb + (size_t)modrow(row) * NMOD * D + 1 * D;
            float4 v[4]; float ss = 0.f;
#pragma unroll
            for (int j = 0; j < 4; ++j) { v[j] = ((const float4*)src)[lane + 64 * j]; ss += v[j].x * v[j].x + v[j].y * v[j].y + v[j].z * v[j].z + v[j].w * v[j].w; }
            ss = wave_sum(ss);
            if (lane == 0) rs[row] = ss;
            bf16_t* Hr = Hb + (size_t)row * D; _Float16* Xr = (_Float16*)((unsigned char*)POUT + XH_OUT_OFF) + (size_t)row * D;
#pragma unroll
            for (int j = 0; j < 4; ++j) {
                const int c0 = (lane + 64 * j) * 4;
                { pg8::f32x4 xv; xv[0] = v[j].x; xv[1] = v[j].y; xv[2] = v[j].z; xv[3] = v[j].w; *(pg8::f16x4*)(Xr + c0) = __builtin_convertvector(xv, pg8::f16x4); }
                const float4 g4 = *(const float4*)(gain + c0), s4 = *(const float4*)(sc + c0);
                uint2 o;
                o.x = pg8::cvt_pk_bf16(v[j].x * g4.x * (1.f + s4.x), v[j].y * g4.y * (1.f + s4.y));
                o.y = pg8::cvt_pk_bf16(v[j].z * g4.z * (1.f + s4.z), v[j].w * g4.w * (1.f + s4.w));
                *(uint2*)(Hr + c0) = o;
            }
        }
    }
    {
        float* wn = (float*)(PWS + WS_WN);
        const int gt = vcu * (NWAVES * 64) + tid, NGT = G * NWAVES * 64;
        for (int idx = gt; idx < DEPTH * 3 * 5 * D; idx += NGT) {
            const int c = idx % D, mr = (idx / D) % 5, j = (idx / (5 * D)) % 3, l = idx / (15 * D);
            const float g = (j == 0 ? PIN(9) : j == 1 ? PIN(12) : PIN(30))[l * D + c];
            wn[idx] = g * (1.f + modb[((size_t)l * 5 + mr) * NMOD * D + (3 * j + 1) * D + c]);
        }
    }
    {
        float* shw = (float*)(PWS + WS_SHW);
        constexpr int TPL = (2 * 2 * FF + INC) / 16;
        const int r = lane & 15, q4 = lane >> 4;
        for (int it = gw; it < DEPTH * TPL; it += NGW) {
            const int l = it / TPL, t = it % TPL;
            int j, n0, N; size_t wo;
            if (t < 2 * FF / 16) { j = 0; n0 = t * 16; wo = WO_W1A; N = 2 * FF; } else if (t < (2 * FF + INC) / 16) { j = 1; n0 = (t - 2 * FF / 16) * 16; wo = WO_WIN; N = INC; } else { j = 2; n0 = (t - (2 * FF + INC) / 16) * 16; wo = WO_W1B; N = 2 * FF; }
            const bf16_t* wt = (const bf16_t*)(PWS + WS_W + (size_t)l * WL_STRIDE + wo) + (size_t)(n0 + r) * D + 8 * q4;
            const float* sh = modb + ((size_t)l * 5 + (r < 5 ? r : 4)) * NMOD * D + (3 * j) * D + 8 * q4;
            const bool valid = r < 5;
            pg8::f32x4 ah = (pg8::f32x4){0.f, 0.f, 0.f, 0.f}, al = ah;
#pragma unroll 4
            for (int ks = 0; ks < 32; ++ks) {
                const pg8::bf16x8 b = *(const pg8::bf16x8*)(wt + 32 * ks);
                const pg8::f32x4 s0 = *(const pg8::f32x4*)(sh + 32 * ks), s1 = *(const pg8::f32x4*)(sh + 32 * ks + 4);
                const float sv[8] = {s0[0], s0[1], s0[2], s0[3], s1[0], s1[1], s1[2], s1[3]};
                unsigned hw[4], lw[4];
#pragma unroll
                for (int i = 0; i < 4; ++i) { const unsigned hp = pg8::cvt_pk_bf16(sv[2 * i], sv[2 * i + 1]);
                    const unsigned lp = pg8::cvt_pk_bf16(sv[2 * i] - __uint_as_float(hp << 16), sv[2 * i + 1] - __uint_as_float(hp & 0xffff0000u));
                    hw[i] = valid ? hp : 0u; lw[i] = valid ? lp : 0u; }
                pg8::u32x4 hv, lv; hv.x = hw[0]; hv.y = hw[1]; hv.z = hw[2]; hv.w = hw[3]; lv.x = lw[0]; lv.y = lw[1]; lv.z = lw[2]; lv.w = lw[3];
                ah = __builtin_amdgcn_mfma_f32_16x16x32_bf16(__builtin_bit_cast(pg8::bf16x8, hv), b, ah, 0, 0, 0);
                al = __builtin_amdgcn_mfma_f32_16x16x32_bf16(__builtin_bit_cast(pg8::bf16x8, lv), b, al, 0, 0, 0);
            }
            const pg8::f32x4 sum = ah + al;
            float* o = shw + (size_t)l * SHW_LAYER + (j == 0 ? 0 : j == 1 ? SHW_J1 : SHW_J2) + n0 + r;
            if (q4 == 0) { o[0] = sum[0]; o[(size_t)N] = sum[1]; o[(size_t)2 * N] = sum[2]; o[(size_t)3 * N] = sum[3]; }
            else if (q4 == 1) o[(size_t)4 * N] = sum[0];
        }
    }
}
typedef short bf16x8 __attribute__((ext_vector_type(8)));
typedef float f32x4 __attribute__((ext_vector_type(4)));
typedef unsigned u32x4 __attribute__((ext_vector_type(4)));
typedef float f32x2 __attribute__((ext_vector_type(2)));
typedef unsigned u32x2 __attribute__((ext_vector_type(2)));
constexpr float QK_SCALE_LOG2E = 0.125f * 1.4426950408889634f;
constexpr int AK_STRIDE = 72, AV_STRIDE = 264, ATT_V_OFF = 256 * AK_STRIDE * 2, ATT_B_OFF = ATT_V_OFF + 64 * AV_STRIDE * 2;
__device__ __forceinline__ bf16x8 ldg8(const bf16_t* p) { return *(const bf16x8*)p; }
__device__ __forceinline__ void softmax_pv_step(const f32x4 sa, const f32x4 sb, float& m, float& lsum, f32x4 (&o)[4], const bf16x8 (&vf)[4]) {
    const float mx8 = fmaxf(fmaxf(fmaxf(sa[0], sa[1]), fmaxf(sa[2], sa[3])), fmaxf(fmaxf(sb[0], sb[1]), fmaxf(sb[2], sb[3])));
    if (__builtin_amdgcn_ballot_w64(mx8 > m + 8.f) != 0ull) {
        float mx = fmaxf(mx8, __shfl_xor(mx8, 16)); mx = fmaxf(mx, __shfl_xor(mx, 32));
        const float mn = fmaxf(m, mx), alpha = __builtin_amdgcn_exp2f(m - mn); m = mn; lsum *= alpha;
#pragma unroll
        for (int dt = 0; dt < 4; ++dt) o[dt] = o[dt] * alpha;
    }
    float p[8];
#pragma unroll
    for (int i = 0; i < 4; ++i) { p[i] = __builtin_amdgcn_exp2f(sa[i] - m); p[4 + i] = __builtin_amdgcn_exp2f(sb[i] - m); }
    lsum += ((p[0] + p[1]) + (p[2] + p[3])) + ((p[4] + p[5]) + (p[6] + p[7]));
    u32x4 pw; pw.x = pg8::cvt_pk_bf16(p[0], p[1]); pw.y = pg8::cvt_pk_bf16(p[2], p[3]); pw.z = pg8::cvt_pk_bf16(p[4], p[5]); pw.w = pg8::cvt_pk_bf16(p[6], p[7]);
    const bf16x8 pf = __builtin_bit_cast(bf16x8, pw);
#pragma unroll
    for (int dt = 0; dt < 4; ++dt) o[dt] = __builtin_amdgcn_mfma_f32_16x16x32_bf16(vf[dt], pf, o[dt], 0, 0, 0);
}
__device__ __forceinline__ void softmax_pv_step2(const f32x4 sa, const f32x4 sb, float& m, float& lsum, f32x4 (&o)[4], const bf16x8 (&vf)[4],
                                                 const f32x4 ta, const f32x4 tb, float& m2, float& l2, f32x4 (&o2)[4], const bf16x8 (&vf2)[4]) {
    const float mx8 = fmaxf(fmaxf(fmaxf(sa[0], sa[1]), fmaxf(sa[2], sa[3])), fmaxf(fmaxf(sb[0], sb[1]), fmaxf(sb[2], sb[3])));
    const float nx8 = fmaxf(fmaxf(fmaxf(ta[0], ta[1]), fmaxf(ta[2], ta[3])), fmaxf(fmaxf(tb[0], tb[1]), fmaxf(tb[2], tb[3])));
    if (__builtin_amdgcn_ballot_w64(mx8 > m + 8.f || nx8 > m2 + 8.f) != 0ull) {
        float mx = fmaxf(mx8, __shfl_xor(mx8, 16)); mx = fmaxf(mx, __shfl_xor(mx, 32));
        float nx = fmaxf(nx8, __shfl_xor(nx8, 16)); nx = fmaxf(nx, __shfl_xor(nx, 32));
        const float mn = fmaxf(m, mx), alpha = __builtin_amdgcn_exp2f(m - mn); m = mn; lsum *= alpha;
        const float nn = fmaxf(m2, nx), beta = __builtin_amdgcn_exp2f(m2 - nn); m2 = nn; l2 *= beta;
#pragma unroll
        for (int dt = 0; dt < 4; ++dt) { o[dt] = o[dt] * alpha; o2[dt] = o2[dt] * beta; }
    }
    float p[8], q[8];
#pragma unroll
    for (int i = 0; i < 4; ++i) { p[i] = __builtin_amdgcn_exp2f(sa[i] - m); p[4 + i] = __builtin_amdgcn_exp2f(sb[i] - m); q[i] = __builtin_amdgcn_exp2f(ta[i] - m2); q[4 + i] = __builtin_amdgcn_exp2f(tb[i] - m2); }
    lsum += ((p[0] + p[1]) + (p[2] + p[3])) + ((p[4] + p[5]) + (p[6] + p[7]));
    l2 += ((q[0] + q[1]) + (q[2] + q[3])) + ((q[4] + q[5]) + (q[6] + q[7]));
    u32x4 pw; pw.x = pg8::cvt_pk_bf16(p[0], p[1]); pw.y = pg8::cvt_pk_bf16(p[2], p[3]); pw.z = pg8::cvt_pk_bf16(p[4], p[5]); pw.w = pg8::cvt_pk_bf16(p[6], p[7]);
    u32x4 qw; qw.x = pg8::cvt_pk_bf16(q[0], q[1]); qw.y = pg8::cvt_pk_bf16(q[2], q[3]); qw.z = pg8::cvt_pk_bf16(q[4], q[5]); qw.w = pg8::cvt_pk_bf16(q[6], q[7]);
    const bf16x8 pf = __builtin_bit_cast(bf16x8, pw), qf = __builtin_bit_cast(bf16x8, qw);
#pragma unroll
    for (int dt = 0; dt < 4; ++dt) { o[dt] = __builtin_amdgcn_mfma_f32_16x16x32_bf16(vf[dt], pf, o[dt], 0, 0, 0); o2[dt] = __builtin_amdgcn_mfma_f32_16x16x32_bf16(vf2[dt], qf, o2[dt], 0, 0, 0); }
}
__device__ __forceinline__ void qk_tiles(const bf16x8 a0, const bf16x8 a1, const bf16x8 b0, const bf16x8 b1, const bf16x8 (&qf)[2], f32x4& sa, f32x4& sb) {
    sa = (f32x4){0.f, 0.f, 0.f, 0.f}; sb = (f32x4){0.f, 0.f, 0.f, 0.f};
    sa = __builtin_amdgcn_mfma_f32_16x16x32_bf16(a0, qf[0], sa, 0, 0, 0); sa = __builtin_amdgcn_mfma_f32_16x16x32_bf16(a1, qf[1], sa, 0, 0, 0);
    sb = __builtin_amdgcn_mfma_f32_16x16x32_bf16(b0, qf[0], sb, 0, 0, 0); sb = __builtin_amdgcn_mfma_f32_16x16x32_bf16(b1, qf[1], sb, 0, 0, 0);
}
__device__ __forceinline__ void attn_stage_kv(LAS unsigned char* lds, const bf16_t* ksrc, int krs, const bf16_t* vsrc, int tid) {
    LAS bf16_t* kl = (LAS bf16_t*)lds; LAS bf16_t* vl = (LAS bf16_t*)(lds + ATT_V_OFF);
#pragma unroll
    for (int i = 0; i < 4; ++i) { const int c = tid + NWAVES * 64 * i, row = c >> 3, part = c & 7;
        *(LAS bf16x8*)(kl + row * AK_STRIDE + part * 8) = ldg8(ksrc + (size_t)row * krs + part * 8); }
#pragma unroll
    for (int i = 0; i < 4; ++i) { const int c = tid + NWAVES * 64 * i, d = c >> 5, part = c & 31;
        *(LAS bf16x8*)(vl + d * AV_STRIDE + part * 8) = ldg8(vsrc + (size_t)d * 256 + part * 8); }
}
__device__ __forceinline__ void attn_lds_logits(const LAS unsigned char* lds, int k0, const bf16x8 (&qf)[2], f32x4& sa, f32x4& sb, bf16x8 (&vf)[4], int r, int q4) {
    const LAS bf16_t* ka = (const LAS bf16_t*)lds + (k0 + 8 * (r >> 2) + (r & 3)) * AK_STRIDE + 8 * q4;
    const LAS bf16_t* vl = (const LAS bf16_t*)(lds + ATT_V_OFF) + r * AV_STRIDE + 8 * q4 + k0;
    const bf16x8 a0 = *(const LAS bf16x8*)ka, a1 = *(const LAS bf16x8*)(ka + 32), b0 = *(const LAS bf16x8*)(ka + 4 * AK_STRIDE), b1 = *(const LAS bf16x8*)(ka + 4 * AK_STRIDE + 32);
#pragma unroll
    for (int dt = 0; dt < 4; ++dt) vf[dt] = *(const LAS bf16x8*)(vl + dt * 16 * AV_STRIDE);
    qk_tiles(a0, a1, b0, b1, qf, sa, sb);
    sa = sa * QK_SCALE_LOG2E; sb = sb * QK_SCALE_LOG2E;
}
__device__ __forceinline__ void attn_lds_block(const LAS unsigned char* lds, int k0, const bf16x8 (&qf)[2], float& m, float& lsum, f32x4 (&o)[4], int r, int q4) {
    const LAS bf16_t* ka = (const LAS bf16_t*)lds + (k0 + 8 * (r >> 2) + (r & 3)) * AK_STRIDE + 8 * q4;
    const LAS bf16_t* vl = (const LAS bf16_t*)(lds + ATT_V_OFF) + r * AV_STRIDE + 8 * q4 + k0;
    const bf16x8 a0 = *(const LAS bf16x8*)ka, a1 = *(const LAS bf16x8*)(ka + 32), b0 = *(const LAS bf16x8*)(ka + 4 * AK_STRIDE), b1 = *(const LAS bf16x8*)(ka + 4 * AK_STRIDE + 32);
    bf16x8 vf[4];
#pragma unroll
    for (int dt = 0; dt < 4; ++dt) vf[dt] = *(const LAS bf16x8*)(vl + dt * 16 * AV_STRIDE);
    f32x4 sa, sb; qk_tiles(a0, a1, b0, b1, qf, sa, sb);
    sa = sa * QK_SCALE_LOG2E; sb = sb * QK_SCALE_LOG2E;
    softmax_pv_step(sa, sb, m, lsum, o, vf);
}
__device__ __forceinline__ void attn_merge(float& m, float& lsum, f32x4 (&o)[4], const float m2, const float l2, const f32x4 (&o2)[4]) {
    const float mn = fmaxf(m, m2), fa = __builtin_amdgcn_exp2f(m - mn), fb = __builtin_amdgcn_exp2f(m2 - mn);
    m = mn; lsum = lsum * fa + l2 * fb;
#pragma unroll
    for (int dt = 0; dt < 4; ++dt) o[dt] = o[dt] * fa + o2[dt] * fb;
}
__device__ __forceinline__ void attn_store(bf16_t* orow, float lsum, const f32x4 (&o)[4]) {
    lsum += __shfl_xor(lsum, 16); lsum += __shfl_xor(lsum, 32);
    const float inv = 1.f / lsum;
#pragma unroll
    for (int dt = 0; dt < 4; ++dt) { uint2 w; w.x = pg8::cvt_pk_bf16(o[dt][0] * inv, o[dt][1] * inv); w.y = pg8::cvt_pk_bf16(o[dt][2] * inv, o[dt][3] * inv); *(uint2*)(orow + 16 * dt) = w; }
}
__device__ __forceinline__ void attn_ctx_phase(LAS unsigned char* lds, int vcu, int G) {
    const int tid = tid_opaque(), lane = tid & 63, wave = __builtin_amdgcn_readfirstlane(tid >> 6), r = lane & 15, q4 = lane >> 4;
    const bf16_t* Q = (const bf16_t*)(PWS + WS_Q); const bf16_t* K = (const bf16_t*)(PWS + WS_K); const bf16_t* VT = (const bf16_t*)(PWS + WS_VT);
    bf16_t* MIX = (bf16_t*)(PWS + WS_MIX);
    for (int it = vcu; it < BATCH * NH; it += G) {
        const int h = it % NH, b = it / NH;
        __syncthreads();
        attn_stage_kv(lds, K + (size_t)b * SEQ * NAW + h * HD, NAW, VT + (size_t)(b * NH + h) * HD * SEQ, tid);
        __syncthreads();
#pragma unroll 1
        for (int task = wave; task < SEQ / 16; task += NWAVES) {
            const size_t rowq = (size_t)b * SEQ + task * 16 + r;
            bf16x8 qf[2];
            qf[0] = ldg8(Q + rowq * NAW + h * HD + 8 * q4); qf[1] = ldg8(Q + rowq * NAW + h * HD + 32 + 8 * q4);
            f32x4 o[4]; float m = -1e30f, lsum = 0.f;
#pragma unroll
            for (int dt = 0; dt < 4; ++dt) o[dt] = (f32x4){0.f, 0.f, 0.f, 0.f};
            f32x4 o2[4]; float m2 = -1e30f, l2 = 0.f;
#pragma unroll
            for (int dt = 0; dt < 4; ++dt) o2[dt] = (f32x4){0.f, 0.f, 0.f, 0.f};
#pragma unroll
            for (int i = 0; i < 4; ++i) { f32x4 sa, sb, ta, tb; bf16x8 v1[4], v2[4];
                attn_lds_logits(lds, 32 * i, qf, sa, sb, v1, r, q4); attn_lds_logits(lds, 128 + 32 * i, qf, ta, tb, v2, r, q4);
                softmax_pv_step2(sa, sb, m, lsum, o, v1, ta, tb, m2, l2, o2, v2); }
            attn_merge(m, lsum, o, m2, l2, o2);
            attn_store(MIX + rowq * D + SSMW + h * HD + 4 * q4, lsum, o);
        }
    }
    __syncthreads();
}
constexpr int NAV_STRIDE = 520, NA_WV_OFF = 512 * AK_STRIDE * 2, NA_WB_OFF = NA_WV_OFF + 64 * NAV_STRIDE * 2;
static_assert(NA_WB_OFF + 15 * 32 * 4 <= LDS_CTL_OFF && ATT_V_OFF + 64 * AV_STRIDE * 2 <= NA_WB_OFF, "NA lds map");
__device__ __forceinline__ void na_stage_window(LAS unsigned char* lds, const bf16_t* kg, const bf16_t* vg, int row0, int nrows, int tid) {
    LAS bf16_t* kl = (LAS bf16_t*)lds; LAS bf16_t* vl = (LAS bf16_t*)(lds + NA_WV_OFF);
    const int ntok = nrows * 64;
#pragma unroll 1
    for (int i0 = 0; i0 < 8; i0 += 4) {
#pragma unroll
        for (int i = i0; i < i0 + 4; ++i) { const int c = tid + NWAVES * 64 * i, tok = c >> 3, part = c & 7;
            if (tok < ntok) *(LAS bf16x8*)(kl + tok * AK_STRIDE + part * 8) = ldg8(kg + (size_t)(row0 * GW + tok) * NAW + part * 8); }
    }
#pragma unroll 1
    for (int i0 = 0; i0 < 8; i0 += 4) {
#pragma unroll
        for (int i = i0; i < i0 + 4; ++i) { const int c = tid + NWAVES * 64 * i, d = c >> 6, part = c & 63;
            if (part * 8 < ntok) *(LAS bf16x8*)(vl + d * NAV_STRIDE + part * 8) = ldg8(vg + (size_t)d * DSEQ + row0 * GW + part * 8); }
    }
}
__device__ __forceinline__ void attn_na_phase(LAS unsigned char* lds, int l, int vcu, int G) {
    const int tid = tid_opaque(), lane = tid & 63, wave = __builtin_amdgcn_readfirstlane(tid >> 6), r = lane & 15, q4 = lane >> 4;
    const bf16_t* Q = (const bf16_t*)(PWS + WS_Q); const bf16_t* K = (const bf16_t*)(PWS + WS_K); const bf16_t* VT = (const bf16_t*)(PWS + WS_VT);
    bf16_t* MIX = (bf16_t*)(PWS + WS_MIX);
    const float* rpb_l = PIN(27) + (size_t)l * NH * 15 * 31;
    const int koff = 8 * (r >> 2) + (r & 3);
    constexpr int NT = 2, IR = 2 * NT;
    const int nb = wave & 3, rl0 = wave >> 2;
    const int qcol = nb * 16 + r;
    int kc0 = nb * 16 - 8; kc0 = kc0 < 0 ? 0 : (kc0 > GW - 32 ? GW - 32 : kc0);
    int cs = qcol - 8; cs = cs < 0 ? 0 : (cs > GW - 16 ? GW - 16 : cs);
    int bidx[8];
#pragma unroll
    for (int i = 0; i < 8; ++i) { const int kcol = kc0 + 8 * q4 + i; const bool valid = kcol >= cs && kcol < cs + 16;
        int dc = kcol - qcol + 15; dc = dc < 0 ? 0 : (dc > 30 ? 30 : dc); bidx[i] = valid ? dc : 31; }
    for (int it = vcu; it < DB * NH * (GW / IR); it += G) {
        const int rg = it % (GW / IR), h = (it / (GW / IR)) % NH, b = it / ((GW / IR) * NH);
        const int R0 = rg * IR;
        int lo = R0 - 4; lo = lo < 0 ? 0 : (lo > GW - 8 ? GW - 8 : lo);
        int hi = R0 + IR - 1 - 4; hi = (hi < 0 ? 0 : (hi > GW - 8 ? GW - 8 : hi)) + 7;
        const bf16_t* kg = K + ((size_t)MC + (size_t)b * DSEQ) * NAW + h * HD;
        const bf16_t* vg = VT + (size_t)MC * NAW + (size_t)(b * NH + h) * HD * DSEQ;
        __syncthreads();
        attn_stage_kv(lds, (const bf16_t*)(PWS + WS_CK) + (((size_t)l * DB + b) * NH + h) * PAST * HD, HD, (const bf16_t*)(PWS + WS_CVT) + (((size_t)l * DB + b) * NH + h) * HD * PAST, tid);
        if (tid < 15 * 32) { const int dr = tid >> 5, dc = tid & 31; ((LAS float*)(lds + NA_WB_OFF))[tid] = dc < 31 ? rpb_l[(size_t)h * 15 * 31 + dr * 31 + dc] * 1.4426950408889634f : -1e30f; }
        __syncthreads();
        f32x4 o[NT][4]; float m[NT], ls[NT];
        const bf16_t* qbase = Q + ((size_t)MC + (size_t)b * DSEQ + (R0 + rl0) * GW + qcol) * NAW + h * HD + 8 * q4;
#pragma unroll
        for (int t = 0; t < NT; ++t) {
            bf16x8 qf[2]; qf[0] = ldg8(qbase + (size_t)t * 2 * GW * NAW); qf[1] = ldg8(qbase + (size_t)t * 2 * GW * NAW + 32);
            m[t] = -1e30f; ls[t] = 0.f;
#pragma unroll
            for (int dt = 0; dt < 4; ++dt) o[t][dt] = (f32x4){0.f, 0.f, 0.f, 0.f};
#pragma unroll 2
            for (int k0 = 0; k0 < PAST; k0 += 32) { f32x4 sa, sb; bf16x8 v1[4];
                attn_lds_logits(lds, k0, qf, sa, sb, v1, r, q4);
                softmax_pv_step(sa, sb, m[t], ls[t], o[t], v1); }
            __builtin_amdgcn_sched_barrier(0);
        }
        const LAS float* btab = (const LAS float*)(lds + NA_WB_OFF);
#pragma unroll 1
        for (int pass = 0; pass < 2; ++pass) {
            const int base = lo + 8 * pass, nrows = pass == 0 ? 8 : hi - (lo + 8) + 1;
            __syncthreads();
            na_stage_window(lds, kg, vg, base, nrows, tid);
            __syncthreads();
#pragma unroll
            for (int t = 0; t < NT; ++t) {
                const int row = R0 + rl0 + 2 * t;
                bf16x8 qf[2]; qf[0] = ldg8(qbase + (size_t)t * 2 * GW * NAW); qf[1] = ldg8(qbase + (size_t)t * 2 * GW * NAW + 32);
                int rs = row - 4; rs = rs < 0 ? 0 : (rs > GW - 8 ? GW - 8 : rs);
#pragma unroll 1
                for (int sl = 0; sl < nrows; ++sl) {
                    const int wr = base + sl;
                    if (wr < rs || wr >= rs + 8) continue;
                    const LAS bf16_t* ka = (const LAS bf16_t*)lds + (sl * GW + kc0 + koff) * AK_STRIDE + 8 * q4;
                    const LAS bf16_t* vl = (const LAS bf16_t*)(lds + NA_WV_OFF) + r * NAV_STRIDE + sl * GW + kc0 + 8 * q4;
                    const bf16x8 a0 = *(const LAS bf16x8*)ka, a1 = *(const LAS bf16x8*)(ka + 32), b0 = *(const LAS bf16x8*)(ka + 4 * AK_STRIDE), b1 = *(const LAS bf16x8*)(ka + 4 * AK_STRIDE + 32);
                    bf16x8 vf[4];
#pragma unroll
                    for (int dt = 0; dt < 4; ++dt) vf[dt] = *(const LAS bf16x8*)(vl + dt * 16 * NAV_STRIDE);
                    f32x4 sa, sb; qk_tiles(a0, a1, b0, b1, qf, sa, sb);
                    const LAS float* brow = btab + (wr - row + 7) * 32;
#pragma unroll
                    for (int i = 0; i < 4; ++i) { sa[i] = fmaf(sa[i], QK_SCALE_LOG2E, brow[bidx[i]]); sb[i] = fmaf(sb[i], QK_SCALE_LOG2E, brow[bidx[4 + i]]); }
                    softmax_pv_step(sa, sb, m[t], ls[t], o[t], vf);
                }
                __builtin_amdgcn_sched_barrier(0);
            }
        }
#pragma unroll
        for (int t = 0; t < NT; ++t) {
            const size_t rowq = (size_t)MC + (size_t)b * DSEQ + (R0 + rl0 + 2 * t) * GW + qcol;
            attn_store(MIX + rowq * D + SSMW + h * HD + 4 * q4, ls[t], o[t]);
        }
    }
    __syncthreads();
}
constexpr int GT_STRIDE = 136;
__device__ __forceinline__ void gate_phase(LAS unsigned char* lds, int l, int first, int stride) {
    const int tid = tid_opaque(), lane = tid & 63, wave = __builtin_amdgcn_readfirstlane(tid >> 6), r = lane & 15, q4 = lane >> 4;
    LAS bf16_t* vt = (LAS bf16_t*)lds;
    const bf16_t* VG = (const bf16_t*)(PWS + WS_VG); const bf16_t* U = (const bf16_t*)(PWS + WS_U);
    const bf16_t* wsb = (const bf16_t*)(PWS + WS_WSB) + (size_t)l * 4 * 128 * 128;
    const float* bs = PIN(29) + (size_t)l * 4 * 128;
    bf16_t* MIX = (bf16_t*)(PWS + WS_MIX);
    for (int it = first; it < MT / 128; it += stride) {
        const size_t base = (size_t)it * 128;
        const int i = wave * 16 + r;
        bf16x8 bfrag[4][4];
#pragma unroll
        for (int g = 0; g < 4; ++g)
#pragma unroll
            for (int ks = 0; ks < 4; ++ks) bfrag[g][ks] = ldg8(wsb + ((size_t)g * 128 + i) * 128 + 8 * q4 + 32 * ks);
        __syncthreads();
        {
            const int t = tid >> 2, qc = tid & 3;
            const u32x4* vr = (const u32x4*)(VG + (base + t) * GMW + 64 * qc);
            u32x4 raw[8];
#pragma unroll
            for (int j = 0; j < 8; ++j) raw[j] = vr[j];
            float x[64]; float sm = 0.f;
#pragma unroll
            for (int j = 0; j < 8; ++j)
#pragma unroll
                for (int e = 0; e < 4; ++e) { x[8 * j + 2 * e] = __uint_as_float(raw[j][e] << 16); x[8 * j + 2 * e + 1] = __uint_as_float(raw[j][e] & 0xffff0000u); sm += x[8 * j + 2 * e] + x[8 * j + 2 * e + 1]; }
            sm += __shfl_xor(sm, 1); sm += __shfl_xor(sm, 2);
            const float mean = sm * (1.f / GMW);
            float sq = 0.f;
#pragma unroll
            for (int c = 0; c < 64; ++c) { x[c] -= mean; sq += x[c] * x[c]; }
            sq += __shfl_xor(sq, 1); sq += __shfl_xor(sq, 2);
            const float rstd = rsqrtf(sq * (1.f / GMW) + 1e-5f);
#pragma unroll
            for (int c = 0; c < 64; ++c) vt[(64 * qc + c) * GT_STRIDE + t] = f2bf(x[c] * rstd);
        }
        __syncthreads();
#pragma unroll
        for (int g = 0; g < 4; ++g) {
            f32x4 acc[4];
            uint2 uu[4];
#pragma unroll
            for (int ct = 0; ct < 4; ++ct) { acc[ct] = (f32x4){0.f, 0.f, 0.f, 0.f}; uu[ct] = *(const uint2*)(U + (base + i) * GMW + g * 64 + ct * 16 + 4 * q4); }
            const float bsv = bs[g * 128 + i];
#pragma unroll
            for (int ks = 0; ks < 4; ++ks)
#pragma unroll
                for (int ct = 0; ct < 4; ++ct) {
                    const bf16x8 afrag = *(const LAS bf16x8*)(vt + (g * 64 + ct * 16 + r) * GT_STRIDE + 32 * ks + 8 * q4);
                    acc[ct] = __builtin_amdgcn_mfma_f32_16x16x32_bf16(afrag, bfrag[g][ks], acc[ct], 0, 0, 0);
                }
#pragma unroll
            for (int ct = 0; ct < 4; ++ct) {
                const int ch = g * 64 + ct * 16 + 4 * q4;
                const float u0 = __uint_as_float(uu[ct].x << 16), u1 = __uint_as_float(uu[ct].x & 0xffff0000u), u2 = __uint_as_float(uu[ct].y << 16), u3 = __uint_as_float(uu[ct].y & 0xffff0000u);
                uint2 w; w.x = pg8::cvt_pk_bf16(u0 * (acc[ct][0] + bsv), u1 * (acc[ct][1] + bsv)); w.y = pg8::cvt_pk_bf16(u2 * (acc[ct][2] + bsv), u3 * (acc[ct][3] + bsv));
                *(uint2*)(MIX + (base + i) * D + SSMW + NAW + ch) = w;
            }
        }
    }
    __syncthreads();
}
constexpr int CH = 64, NCHUNK = MT / CH;
constexpr int BU_STRIDE = 132, SB_STRIDE = 136, YB_STRIDE = 264;
constexpr int SSM_WAVE_BYTES = 16 * BU_STRIDE * 4 + 16 * SB_STRIDE * 2, SSM_YB_OFF = NWAVES * SSM_WAVE_BYTES;
static_assert(SSM_WAVE_BYTES % 16 == 0 && SSM_YB_OFF + CH * YB_STRIDE * 2 <= LDS_CTL_OFF, "ssm lds map");
__device__ __forceinline__ float2 cmul(float2 a, float2 b) { return make_float2(a.x * b.x - a.y * b.y, a.x * b.y + a.y * b.x); }
__device__ __forceinline__ float2 cfma(float2 a, float2 b, float2 c) { return make_float2(fmaf(a.x, b.x, fmaf(-a.y, b.y, c.x)), fmaf(a.x, b.y, fmaf(a.y, b.x, c.y))); }
__device__ __forceinline__ void ssm_load_bm(bf16x8 (&bm)[8], const bf16x8* BMFg, int lane) {
#pragma unroll
    for (int tau = 0; tau < 8; ++tau) bm[tau] = BMFg[tau * 64 + lane];
}
__device__ __forceinline__ bf16x8 ssm_load_u(const float* XS, size_t trow0, int g, int r, int q4) {
    const f32x4* src = (const f32x4*)(XS + (trow0 + r) * SSMW + g * SC + 8 * (q4 & 1));
    const f32x4 a = src[0], b = src[1];
    const float u[8] = {a[0], a[1], a[2], a[3], b[0], b[1], b[2], b[3]};
    u32x4 w; unsigned ww[4];
#pragma unroll
    for (int i = 0; i < 4; ++i) {
        const unsigned hp = pg8::cvt_pk_bf16(u[2 * i], u[2 * i + 1]);
        const unsigned lp = pg8::cvt_pk_bf16(u[2 * i] - __uint_as_float(hp << 16), u[2 * i + 1] - __uint_as_float(hp & 0xffff0000u));
        ww[i] = (q4 & 2) ? lp : hp;
    }
    w.x = ww[0]; w.y = ww[1]; w.z = ww[2]; w.w = ww[3];
    return __builtin_bit_cast(bf16x8, w);
}
__device__ __forceinline__ void ssm_bu_to_lds(LAS float* bul, const bf16x8 (&bm)[8], const bf16x8 uf, int r, int q4) {
#pragma unroll
    for (int tau = 0; tau < 8; ++tau) {
        const f32x4 d = __builtin_amdgcn_mfma_f32_16x16x32_bf16(bm[tau], uf, (f32x4){0.f, 0.f, 0.f, 0.f}, 0, 0, 0);
        *(LAS f32x4*)(bul + r * BU_STRIDE + 16 * tau + 4 * q4) = d;
    }
}
template <int DIR> __device__ __forceinline__ void ssm_dir_a(const bf16x8 (&uf)[4], LAS float* bul, const float2* LB, float2* E, int l, int g, int ci, int lane, int r, int q4) {
    constexpr int d = DIR;
    const int pbase = ((l * 2 + d) * SG + g) * SP;
    const float2 lb = LB[pbase + lane];
    bf16x8 bm[8]; ssm_load_bm(bm, (const bf16x8*)(PWS + WS_BMF) + (size_t)((l * 2 + d) * SG + g) * 8 * 64, lane);
    float2 s = make_float2(0.f, 0.f);
    const LAS float* brd = bul + 2 * lane;
#pragma unroll
    for (int si = 0; si < 4; ++si) {
        ssm_bu_to_lds(bul, bm, uf[d ? 3 - si : si], r, q4);
#pragma unroll
        for (int step = 0; step < 16; ++step) { const f32x2 bv2 = *(const LAS f32x2*)(brd + (d ? 15 - step : step) * BU_STRIDE); s = cfma(lb, s, make_float2(bv2[0], bv2[1])); }
    }
    E[((size_t)ci * 2 + d) * SG * SP + g * SP + lane] = s;
}
__device__ __forceinline__ void ssm_pass_a(LAS unsigned char* lds, int l, int vcu, int G) {
    const int tid = tid_opaque(), lane = tid & 63, wave = __builtin_amdgcn_readfirstlane(tid >> 6), r = lane & 15, q4 = lane >> 4;
    LAS float* bul = (LAS float*)(lds + wave * SSM_WAVE_BYTES);
    const float* XS = (const float*)(PWS + WS_XSSM);
    const float2* LB = (const float2*)(PWS + WS_SSMP); const float2* BB = (const float2*)(PWS + WS_SSMP + 64 * 1024);
    float2* E = (float2*)(PWS + WS_E);
    for (int ci = vcu; ci < NCHUNK; ci += G) {
#pragma unroll 1
        for (int gi = 0; gi < 2; ++gi) {
            const int g = wave * 2 + gi;
            bf16x8 uf[4];
#pragma unroll
            for (int sub = 0; sub < 4; ++sub) uf[sub] = ssm_load_u(XS, (size_t)ci * CH + sub * 16, g, r, q4);
            ssm_dir_a<0>(uf, bul, LB, E, l, g, ci, lane, r, q4);
            ssm_dir_a<1>(uf, bul, LB, E, l, g, ci, lane, r, q4);
        }
    }
}
__device__ __forceinline__ void ssm_carry(int l, int vcu, int G) {
    const int tid = tid_opaque(), lane = tid & 63, wave = __builtin_amdgcn_readfirstlane(tid >> 6);
    const float2* LB = (const float2*)(PWS + WS_SSMP);
    const float2* E = (const float2*)(PWS + WS_E); float2* SIN = (float2*)(PWS + WS_SIN);
    const float* st0 = PIN(5);
    for (int wi = wave * G + vcu; wi < (BATCH + DB) * 2 * SG; wi += G * NWAVES) {
        const bool lat = wi < DB * 2 * SG;
        const int w2 = lat ? wi : wi - DB * 2 * SG, g = w2 % SG, d = (w2 / SG) & 1, sq = w2 / (2 * SG);
        const int nC = lat ? DSEQ / CH : SEQ / CH, cbase = lat ? MC / CH + sq * (DSEQ / CH) : sq * (SEQ / CH);
        float2 lt = LB[((l * 2 + d) * SG + g) * SP + lane];
#pragma unroll
        for (int i = 0; i < 6; ++i) lt = cmul(lt, lt);
        float2 s = make_float2(0.f, 0.f);
        if (lat) { const float* st = st0 + (((((size_t)sq * DEPTH + l) * 2 + d) * SG + g) * SP + lane) * 2; s = make_float2(st[0], st[1]); }
        const size_t off = (size_t)d * SG * SP + g * SP + lane, cs = (size_t)2 * SG * SP;
        if (lat) {
#pragma unroll 1
            for (int k0 = 0; k0 < DSEQ / CH; k0 += 32) {
                float2 e[32];
#pragma unroll
                for (int k = 0; k < 32; ++k) e[k] = E[(size_t)(cbase + (d ? DSEQ / CH - 1 - (k0 + k) : k0 + k)) * cs + off];
#pragma unroll
                for (int k = 0; k < 32; ++k) { SIN[(size_t)(cbase + (d ? DSEQ / CH - 1 - (k0 + k) : k0 + k)) * cs + off] = s; s = cfma(lt, s, e[k]); }
            }
        } else {
            float2 e[SEQ / CH];
#pragma unroll
            for (int k = 0; k < SEQ / CH; ++k) e[k] = E[(size_t)(cbase + (d ? SEQ / CH - 1 - k : k)) * cs + off];
#pragma unroll
            for (int k = 0; k < SEQ / CH; ++k) { SIN[(size_t)(cbase + (d ? SEQ / CH - 1 - k : k)) * cs + off] = s; s = cfma(lt, s, e[k]); }
        }
    }
}
template <int DIR> __device__ __forceinline__ void ssm_dir_b(f32x4 (&yg)[4], const bf16x8 (&uf)[4], LAS float* bul, LAS bf16_t* sbw, const float2* LB, const float2* SIN,
                                                          int l, int g, int ci, bool lat, int sq, bool edge_chunk, int lane, int r, int q4) {
    constexpr int d = DIR;
    const int pbase = ((l * 2 + d) * SG + g) * SP;
    const float2 lb = LB[pbase + lane];
    float2 s = SIN[((size_t)ci * 2 + d) * SG * SP + g * SP + lane];
    bf16x8 bm[8]; ssm_load_bm(bm, (const bf16x8*)(PWS + WS_BMF) + (size_t)((l * 2 + d) * SG + g) * 8 * 64, lane);
    bf16x8 cf[4];
    { const bf16x8* cff = (const bf16x8*)(PWS + WS_CFF) + (size_t)((l * 2 + d) * SG + g) * 4 * 64 + lane;
#pragma unroll
      for (int ks = 0; ks < 4; ++ks) cf[ks] = cff[ks * 64]; }
    const LAS float* brd = bul + 2 * lane; LAS bf16_t* swr = sbw + 2 * lane; const LAS bf16_t* srd = sbw + r * SB_STRIDE + 8 * q4;
#pragma unroll
    for (int si = 0; si < 4; ++si) {
        constexpr int dummy = 0; (void)dummy;
        const int sub = d ? 3 - si : si;
        ssm_bu_to_lds(bul, bm, uf[sub], r, q4);
        f32x2 buv[16];
#pragma unroll
        for (int step = 0; step < 16; ++step) buv[step] = *(const LAS f32x2*)(brd + (d ? 15 - step : step) * BU_STRIDE);
#pragma unroll
        for (int step = 0; step < 16; ++step) { s = cfma(lb, s, make_float2(buv[step][0], buv[step][1]));
            *(LAS unsigned*)(swr + (d ? 15 - step : step) * SB_STRIDE) = pg8::cvt_pk_bf16(s.x, s.y); }
#pragma unroll
        for (int ks = 0; ks < 4; ++ks) {
            const bf16x8 sf = *(const LAS bf16x8*)(srd + 32 * ks);
            yg[sub] = __builtin_amdgcn_mfma_f32_16x16x32_bf16(cf[ks], sf, yg[sub], 0, 0, 0);
        }
    }
    if (!lat && edge_chunk) { float* o = POUT + O_ST + (((((size_t)sq * DEPTH + l) * 2 + d) * SG + g) * SP + lane) * 2; o[0] = s.x; o[1] = s.y; }
}
__device__ __forceinline__ void ssm_group_b(f32x4 (&yg)[4], LAS float* bul, LAS bf16_t* sbw, LAS bf16_t* yb, const float* XS, const float2* LB, const float2* BB, const float2* SIN,
                                            int l, int g, int ci, bool lat, int sq, bool first_chunk, bool last_chunk, int lane, int r, int q4) {
#pragma unroll
    for (int s = 0; s < 4; ++s) yg[s] = (f32x4){0.f, 0.f, 0.f, 0.f};
    bf16x8 uf[4];
#pragma unroll
    for (int sub = 0; sub < 4; ++sub) uf[sub] = ssm_load_u(XS, (size_t)ci * CH + sub * 16, g, r, q4);
    ssm_dir_b<0>(yg, uf, bul, sbw, LB, SIN, l, g, ci, lat, sq, last_chunk, lane, r, q4);
    ssm_dir_b<1>(yg, uf, bul, sbw, LB, SIN, l, g, ci, lat, sq, first_chunk, lane, r, q4);
    const f32x4 dv = *(const f32x4*)(PIN(22) + l * SSMW + g * SC + 4 * q4);
#pragma unroll
    for (int sub = 0; sub < 4; ++sub) {
        const int t = sub * 16 + r;
        const f32x4 u = *(const f32x4*)(XS + ((size_t)ci * CH + t) * SSMW + g * SC + 4 * q4);
#pragma unroll
        for (int i = 0; i < 4; ++i) yg[sub][i] = pg8::gelu_fast(fmaf(dv[i], u[i], yg[sub][i]));
        u32x2 w; w[0] = pg8::cvt_pk_bf16(yg[sub][0], yg[sub][1]); w[1] = pg8::cvt_pk_bf16(yg[sub][2], yg[sub][3]);
        *(LAS u32x2*)(yb + t * YB_STRIDE + g * SC + 4 * q4) = w;
    }
}
__device__ __forceinline__ void ssm_pass_b(LAS unsigned char* lds, int l, int vcu, int G) {
    const int tid = tid_opaque(), lane = tid & 63, wave = __builtin_amdgcn_readfirstlane(tid >> 6), r = lane & 15, q4 = lane >> 4;
    LAS float* bul = (LAS float*)(lds + wave * SSM_WAVE_BYTES);
    LAS bf16_t* sbw = (LAS bf16_t*)(lds + wave * SSM_WAVE_BYTES + 16 * BU_STRIDE * 4);
    LAS bf16_t* yb = (LAS bf16_t*)(lds + SSM_YB_OFF);
    const float* XS = (const float*)(PWS + WS_XSSM);
    const float2* LB = (const float2*)(PWS + WS_SSMP); const float2* BB = (const float2*)(PWS + WS_SSMP + 64 * 1024);
    const float2* SIN = (const float2*)(PWS + WS_SIN);
    const bf16_t* glt = (const bf16_t*)(PWS + WS_GLT) + (size_t)l * SSMW * SSMW;
    bf16_t* MIX = (bf16_t*)(PWS + WS_MIX);
    for (int ci = vcu; ci < NCHUNK; ci += G) {
        const bool lat = ci >= MC / CH;
        const int sq = lat ? (ci - MC / CH) / (DSEQ / CH) : ci / (SEQ / CH);
        const int nC = lat ? DSEQ / CH : SEQ / CH, cbase = lat ? MC / CH + sq * (DSEQ / CH) : sq * (SEQ / CH), k = ci - cbase;
        __syncthreads();
        f32x4 yg0[4], yg1[4];
        ssm_group_b(yg0, bul, sbw, yb, XS, LB, BB, SIN, l, wave * 2 + 0, ci, lat, sq, k == 0, k == nC - 1, lane, r, q4);
        ssm_group_b(yg1, bul, sbw, yb, XS, LB, BB, SIN, l, wave * 2 + 1, ci, lat, sq, k == 0, k == nC - 1, lane, r, q4);
        __syncthreads();
        f32x4 z[2][4];
#pragma unroll
        for (int a = 0; a < 2; ++a)
#pragma unroll
            for (int b = 0; b < 4; ++b) z[a][b] = (f32x4){0.f, 0.f, 0.f, 0.f};
#pragma unroll 2
        for (int ks = 0; ks < 8; ++ks) {
            bf16x8 af[2], bfv[4];
#pragma unroll
            for (int a = 0; a < 2; ++a) af[a] = ldg8(glt + (size_t)(wave * 32 + a * 16 + r) * SSMW + 32 * ks + 8 * q4);
#pragma unroll
            for (int b = 0; b < 4; ++b) bfv[b] = *(const LAS bf16x8*)(yb + (b * 16 + r) * YB_STRIDE + 32 * ks + 8 * q4);
#pragma unroll
            for (int a = 0; a < 2; ++a)
#pragma unroll
                for (int b = 0; b < 4; ++b) z[a][b] = __builtin_amdgcn_mfma_f32_16x16x32_bf16(af[a], bfv[b], z[a][b], 0, 0, 0);
        }
        const float* gb = PIN(24) + l * SSMW;
#pragma unroll
        for (int a = 0; a < 2; ++a) {
            const int n = wave * 32 + a * 16 + 4 * q4;
            const f32x4 bv = *(const f32x4*)(gb + n);
#pragma unroll
            for (int b = 0; b < 4; ++b) {
                const f32x4 yv = a ? yg1[b] : yg0[b];
                float o[4];
#pragma unroll
                for (int i = 0; i < 4; ++i) o[i] = yv[i] * __builtin_amdgcn_rcpf(1.f + __builtin_amdgcn_exp2f(-1.4426950408889634f * (z[a][b][i] + bv[i])));
                uint2 w; w.x = pg8::cvt_pk_bf16(o[0], o[1]); w.y = pg8::cvt_pk_bf16(o[2], o[3]);
                *(uint2*)(MIX + ((size_t)ci * CH + b * 16 + r) * D + n) = w;
            }
        }
    }
    __syncthreads();
}

#define XB_TMO      128
#define XB_XCNT(j)  (256  + 64 * (j))
#define XB_XSUB(j)  (1280 + 64 * (j))
#define XB_XGEN(j)  (2304 + 64 * (j))
#define XB_TOP      3328
#define XB_TOPGEN   3392
#define XCD_BAR_WORDS 3456
#define XB_SPIN_CAP (1u << 18)

__device__ __forceinline__ unsigned xb_ld(unsigned* p)              { return __hip_atomic_load(p, __ATOMIC_RELAXED, __HIP_MEMORY_SCOPE_AGENT); }
__device__ __forceinline__ unsigned xb_add(unsigned* p, unsigned v) { return __hip_atomic_fetch_add(p, v, __ATOMIC_RELAXED, __HIP_MEMORY_SCOPE_AGENT); }
__device__ __forceinline__ unsigned xb_xcc_id() { return (unsigned)__builtin_amdgcn_s_getreg((3 << 11) | 20) & 0xFu; }
#define XB_SPIN(cond, bar) do { unsigned _sp = 0; while (cond) { __builtin_amdgcn_s_sleep(1); \
    if ((++_sp & 255u) == 0u) { if (xb_ld(&(bar)[XB_TMO])) break; if (_sp > XB_SPIN_CAP) { atomicAdd(&(bar)[XB_TMO], 1u); break; } } } } while (0)

struct XcdBarrier {
    unsigned* bar; unsigned x;
    volatile LAS unsigned* st;
};

__device__ __forceinline__ XcdBarrier xcd_barrier_post(unsigned* bar, volatile LAS unsigned* st) {
    XcdBarrier b; b.bar = bar; b.x = xb_xcc_id(); b.st = st;
    if (threadIdx.x == 0) (void)xb_add(&bar[XB_XCNT(b.x)], 1u);
    return b;
}
__device__ __forceinline__ void xcd_barrier_complete(unsigned* bar, unsigned x, unsigned& nloc, unsigned& nx) {
    const unsigned G = gridDim.x * gridDim.y * gridDim.z;
    unsigned sum, cnt, mine, sp = 0u;
    for (;;) {
        sum = 0u; cnt = 0u; mine = 0u;
#pragma unroll
        for (unsigned j = 0; j < 16; ++j) { const unsigned c = xb_ld(&bar[XB_XCNT(j)]); sum += c; cnt += (c > 0u) ? 1u : 0u; mine = (j == x) ? c : mine; }
        if (sum == G) break;
        __builtin_amdgcn_s_sleep(1);
        if ((++sp & 255u) == 0u) { if (xb_ld(&bar[XB_TMO])) break; if (sp > XB_SPIN_CAP) { atomicAdd(&bar[XB_TMO], 1u); break; } }
    }
    nloc = mine > 0u ? mine : 1u; nx = cnt > 0u ? cnt : 1u;
}

__device__ __forceinline__ void xcd_barrier(const XcdBarrier& b) {
    asm volatile("s_waitcnt vmcnt(0)" ::: "memory");
    __syncthreads();
    if (threadIdx.x == 0) {
        unsigned* bar = b.bar;
        __builtin_amdgcn_s_waitcnt(0);
        unsigned nloc = b.st[0], nx = b.st[1];
        if (nloc == 0u) { xcd_barrier_complete(bar, b.x, nloc, nx); b.st[0] = nloc; b.st[1] = nx; }
        const unsigned old = xb_add(&bar[XB_XSUB(b.x)], 1u);
        const unsigned gen = old / nloc;
        if (old + 1u == (gen + 1u) * nloc) {
            __builtin_amdgcn_fence(__ATOMIC_RELEASE, "agent");
            asm volatile("s_waitcnt vmcnt(0)" ::: "memory");
            const unsigned og = xb_add(&bar[XB_TOP], 1u);
            const unsigned tg = og / nx;
            if (og + 1u == (tg + 1u) * nx) xb_add(&bar[XB_TOPGEN], 1u);
            else XB_SPIN(xb_ld(&bar[XB_TOPGEN]) == tg, bar);
            __builtin_amdgcn_fence(__ATOMIC_ACQUIRE, "agent");
            xb_add(&bar[XB_XGEN(b.x)], 1u);
            asm volatile("s_waitcnt vmcnt(0)" ::: "memory");
        } else {
            XB_SPIN(xb_ld(&bar[XB_XGEN(b.x)]) == gen, bar);
            __builtin_amdgcn_fence(__ATOMIC_ACQUIRE, "agent");
            asm volatile("s_waitcnt vmcnt(0)" ::: "memory");
        }
    }
    __syncthreads();
}

__device__ __forceinline__ void passa_arrive(LAS unsigned char* lds, int l) {
    asm volatile("s_waitcnt vmcnt(0)" ::: "memory");
    __syncthreads();
    if (threadIdx.x == 0) {
        unsigned* ctl = (unsigned*)(PWS + WS_CTL); volatile LAS unsigned* st = (volatile LAS unsigned*)(lds + LDS_CTL_OFF);
        const unsigned nloc = st[0], x = xb_xcc_id();
        const unsigned old = xb_add(&ctl[CW_PASSA + 64 * (16 * l + (int)x)], 1u);
        if (old + 1u == nloc) { __builtin_amdgcn_fence(__ATOMIC_RELEASE, "agent"); asm volatile("s_waitcnt vmcnt(0)" ::: "memory"); xb_add(&ctl[CW_PASSA_TOP + 64 * l], 1u); }
    }
}
__device__ __forceinline__ void passa_wait(LAS unsigned char* lds, int l) {
    if (threadIdx.x == 0) {
        unsigned* ctl = (unsigned*)(PWS + WS_CTL); volatile LAS unsigned* st = (volatile LAS unsigned*)(lds + LDS_CTL_OFF);
        const unsigned nx = st[1];
        XB_SPIN(xb_ld(&ctl[CW_PASSA_TOP + 64 * l]) < nx, ctl + CW_BAR);
        __builtin_amdgcn_fence(__ATOMIC_ACQUIRE, "agent"); asm volatile("s_waitcnt vmcnt(0)" ::: "memory");
    }
    __syncthreads();
}

#define PHASE_FN __device__ __forceinline__
PHASE_FN void ph_prologue(LAS unsigned char* lds, int vcu, int G) { prologue_phase(lds, vcu, G); }
PHASE_FN void ph_x0(int vcu, int G) { x0_phase(vcu, G); }
PHASE_FN void ph_ffn_in(LAS unsigned char* lds, int l, int second, int G, int bx) {
    unsigned char* wl = PWS + WS_W + (size_t)l * WL_STRIDE;
    pg8::Gemm g{(const bf16_t*)(PWS + WS_H), (const bf16_t*)(wl + (second ? WO_W1B : WO_W1A)), MT, 2 * FF, D};
    pg8::StaticOrder S; S.init(MT, 2 * FF, G, bx);
    pg8::EpiFfnIn E{l, second};
    pg8::gemm_phase<pg8::EpiFfnIn, pg8::StaticOrder, true, true>(lds, g, S, E);
}
PHASE_FN void ph_res(LAS unsigned char* lds, int l, int kind, int G, int bx) {
    unsigned char* wl = PWS + WS_W + (size_t)l * WL_STRIDE;
    const bool wo = kind == 1;
    pg8::Gemm g{(const bf16_t*)(PWS + (wo ? WS_MIX : WS_ACT)), (const bf16_t*)(wl + (kind == 0 ? WO_W2A : wo ? WO_WOUT : WO_W2B)), MT, D, wo ? D : FF};
    pg8::StaticOrder S; S.init(MT, D, G, bx);
    pg8::EpiRes E{l, kind};
    pg8::gemm_phase<pg8::EpiRes, pg8::StaticOrder, true, true>(lds, g, S, E);
}
PHASE_FN void ph_win(LAS unsigned char* lds, int l, int G, int bx) {
    unsigned char* wl = PWS + WS_W + (size_t)l * WL_STRIDE;
    pg8::Gemm g{(const bf16_t*)(PWS + WS_H), (const bf16_t*)(wl + WO_WIN), MT, INC, D};
    pg8::StaticOrder S; S.init(MT, INC, G, bx);
    pg8::EpiWin E{l};
    pg8::gemm_phase<pg8::EpiWin, pg8::StaticOrder, true, true>(lds, g, S, E);
}
PHASE_FN void ph_mix1(LAS unsigned char* lds, int l, int vcu, int G, int sub) {
    for (int i = 0; i <= ((sub >> 0) & 1); ++i) ssm_pass_a(lds, l, vcu, G);
    passa_arrive(lds, l);
    for (int i = 0; i <= ((sub >> 1) & 1); ++i) attn_ctx_phase(lds, vcu, G);
    for (int i = 0; i <= ((sub >> 2) & 1); ++i) attn_na_phase(lds, l, vcu, G);
    (void)sub;
    passa_wait(lds, l); ssm_carry(l, vcu, G);
}
PHASE_FN void ph_mix2(LAS unsigned char* lds, int l, int vcu, int G) {
    if (G >= 2 && NCHUNK > G && NCHUNK <= 2 * G) { const int h0 = NCHUNK - G; gate_phase(lds, l, vcu >= h0 ? vcu - h0 : MT, G - h0); }
    else gate_phase(lds, l, vcu, G);
    ssm_pass_b(lds, l, vcu, G);
}

__global__ void __launch_bounds__(NWAVES * 64, 2) mega(Params p) {
    extern __shared__ __attribute__((aligned(16))) unsigned char lds_raw[];
    LAS unsigned char* lds = (LAS unsigned char*)lds_raw;
    const int G = gridDim.x, bx = blockIdx.x;
    const int vcu = (G % 8 == 0) ? (bx % 8) * (G / 8) + bx / 8 : bx;
    {
        volatile LAS unsigned* st0 = (volatile LAS unsigned*)(lds + LDS_CTL_OFF);
        if (threadIdx.x < 16) st0[threadIdx.x] = 0u;
        __syncthreads();
        (void)xcd_barrier_post((unsigned*)(PWS + WS_CTL) + CW_BAR, st0);
    }
    for (int ph = p.ph_lo, rep = 0; ph < p.ph_hi;) {
        int Gp = G, vp = vcu, bp = bx; asm volatile("" : "+s"(Gp), "+s"(vp), "+s"(bp));
        if (ph == PH_PRO) { ph_prologue(lds, vp, Gp); }
        else if (ph == PH_X0) { ph_x0(vp, Gp); }
        else {
            const int l = (ph - 2) / PH_PER_LAYER, q = (ph - 2) % PH_PER_LAYER + 2;
            if (q == PH_F1IN) ph_ffn_in(lds, l, 0, Gp, bp);
            else if (q == PH_F2IN) ph_ffn_in(lds, l, 1, Gp, bp);
            else if (q == PH_F1OUT) ph_res(lds, l, 0, Gp, bp);
            else if (q == PH_WOUT) ph_res(lds, l, 1, Gp, bp);
            else if (q == PH_F2OUT) ph_res(lds, l, 2, Gp, bp);
            else if (q == PH_WIN) ph_win(lds, l, Gp, bp);
            else if (q == PH_MIX1) ph_mix1(lds, l, vp, Gp, p.rep_mask >> 16);
            else if (q == PH_MIX2) ph_mix2(lds, l, vp, Gp);
        }
        const int kind = ph < 2 ? ph : (ph - 2) % PH_PER_LAYER + 2;
        const bool again = rep == 0 && ((p.rep_mask >> kind) & 1);
        if (again || ph + 1 < p.ph_hi) {
            if (ph == PH_PRO) cooperative_groups::this_grid().sync();
            else { XcdBarrier bar; bar.bar = (unsigned*)(PWS + WS_CTL) + CW_BAR; bar.x = xb_xcc_id(); bar.st = (volatile LAS unsigned*)(lds + LDS_CTL_OFF); xcd_barrier(bar); }
        }
        if (again) rep = 1; else { rep = 0; ++ph; }
    }
}
}

extern "C" void kernel_launch(void* const* d_in, const int* in_sizes, int n_in, void* d_out, int out_size, void* d_ws, size_t ws_size, hipStream_t stream) {
    static int grid = 0;
    if (grid == 0) {
        if (n_in != 33 || ws_size < WS_END) { fprintf(stderr, "kernel_launch: unexpected n_in %d / ws_size %zu\n", n_in, ws_size); grid = -1; return; }
        int dev = 0, cus = 0;
        if (hipGetDevice(&dev) != hipSuccess || hipDeviceGetAttribute(&cus, hipDeviceAttributeMultiprocessorCount, dev) != hipSuccess) { grid = -1; return; }
        if (hipFuncSetAttribute((const void*)mega, hipFuncAttributeMaxDynamicSharedMemorySize, LDS_BYTES) != hipSuccess) { fprintf(stderr, "hipFuncSetAttribute failed\n"); grid = -1; return; }
        grid = cus;
    }
    if (grid < 0) return;
    Params p{};
    for (int i = 0; i < 33; ++i) p.in[i] = (const float*)d_in[i];
    p.out = (float*)d_out; p.ws = (unsigned char*)d_ws;
    p.ph_lo = 0; p.ph_hi = NPHASES; p.rep_mask = PROBE_REP_MASK;
    if (hipMemsetAsync((char*)d_ws + WS_CTL, 0, WS_MOD + (size_t)DEPTH * 5 * NMOD * D * 4, stream) != hipSuccess) { fprintf(stderr, "memset of control words failed\n"); return; }
    void* args[] = {&p};
    const hipError_t e = hipLaunchCooperativeKernel((const void*)mega, dim3(grid), dim3(NWAVES * 64), args, LDS_BYTES, stream);
    if (e != hipSuccess) fprintf(stderr, "cooperative launch failed: %s (grid %d)\n", hipGetErrorString(e), grid);
}
```

```cpp
#include <hip/hip_runtime.h>
#include <hip/hip_cooperative_groups.h>
#include <cstdio>
#include <cstdint>

typedef unsigned short bf16_t;
namespace {
constexpr int D = 1024, BATCH = 32, SEQ = 256, DEPTH = 2, DB = 4, DSEQ = 4096, PAST = 256;
constexpr int GW = 64, SSMW = 256, NAW = 512, NH = 8, HD = 64, GMW = 256, FF = 2816, NMOD = 9, INC = 2304;
constexpr int SG = 16, SC = 16, SP = 64;
constexpr int MC = BATCH * SEQ, ML = DB * DSEQ, MT = MC + ML;
constexpr size_t MiB = 1u << 20;
constexpr size_t WS_CTL = 0, WS_MOD = 1 * MiB, WS_SSMP = 2 * MiB, WS_CK = 3 * MiB, WS_CVT = 5 * MiB, WS_E = 7 * MiB;
constexpr size_t WS_WSB = 13 * MiB, WS_GLT = 13 * MiB + MiB / 2;
constexpr size_t WS_BMF = 14 * MiB, WS_CFF = 14 * MiB + MiB / 2;
constexpr size_t WS_SHW = MiB + 384 * 1024, WS_ROWSS = 15 * MiB, WS_WN = 15 * MiB + 768 * 1024;
constexpr int SHW_LAYER = 5 * (2 * 2 * FF + INC), SHW_J1 = 5 * 2 * FF, SHW_J2 = 5 * (2 * FF + INC);
constexpr size_t WS_W = 16 * MiB, WS_H = 96 * MiB, WS_ACT = 144 * MiB;
constexpr size_t WS_XSSM = 144 * MiB, WS_Q = 168 * MiB, WS_K = 192 * MiB, WS_VT = 216 * MiB, WS_U = 240 * MiB, WS_VG = 252 * MiB;
constexpr size_t WS_SIN = 264 * MiB, WS_MIX = 276 * MiB, WS_XH2B = 324 * MiB, WS_END = 332 * MiB;
constexpr size_t XH_OUT_OFF = 48 * MiB; constexpr int XH2_SPLIT_PM = 80;
constexpr size_t O_YP = 0, O_YS = (size_t)MC * D, O_CK = (size_t)MT * D, O_CV = O_CK + (size_t)BATCH * DEPTH * SEQ * NAW,
                 O_ST = O_CV + (size_t)BATCH * DEPTH * SEQ * NAW;

__device__ __forceinline__ float bf2f(bf16_t v) { return __uint_as_float(((unsigned)v) << 16); }
__device__ __forceinline__ bf16_t f2bf(float f) { unsigned u = __float_as_uint(f); return (bf16_t)((u + 0x7fffu + ((u >> 16) & 1u)) >> 16); }
__device__ __forceinline__ float silu_f(float x) { return x / (1.f + __expf(-x)); }
__device__ __forceinline__ float gelu_tanh(float x) { const float u = 0.7978845608028654f * (x + 0.044715f * x * x * x); return 0.5f * x * (1.f + tanhf(u)); }
__device__ __forceinline__ int modrow(int m) { return m < MC ? 0 : 1 + (m - MC) / DSEQ; }
__device__ __forceinline__ float wave_sum(float v) {
#pragma unroll
    for (int o = 1; o < 64; o <<= 1) v += __shfl_xor(v, o);
    return v;
}

struct Params {
    const float* in[33];
    float* out;
    unsigned char* ws;
    int ph_lo, ph_hi, rep_mask, pad;
};


template <int OFF> __device__ __forceinline__ unsigned long long karg64() {
    unsigned long long v;
    asm volatile("s_load_dwordx2 %0, %1, %2\n\ts_waitcnt lgkmcnt(0)" : "=s"(v) : "s"(__builtin_amdgcn_kernarg_segment_ptr()), "i"(OFF) : "memory");
    return v;
}
__device__ __forceinline__ int tid_opaque() { int t = threadIdx.x; asm volatile("" : "+v"(t)); return t; }
#define GASP __attribute__((address_space(1)))
#define PIN(i) ((const float*)(const GASP float*)karg64<8 * (i)>())
#define POUT ((float*)(GASP float*)karg64<8 * 33>())
#define PWS ((unsigned char*)(GASP unsigned char*)karg64<8 * 34>())
constexpr int NWAVES = 8, LDS_BYTES = 147456, LDS_CTL_OFF = LDS_BYTES - 64, CW_BAR = 4096, CW_PASSA = 1024, CW_PASSA_TOP = 3200;
constexpr size_t WL_STRIDE = 40 * MiB, WO_W1A = 0, WO_W2A = 11 * MiB, WO_WIN = 16 * MiB + MiB / 2, WO_WOUT = 21 * MiB, WO_W1B = 23 * MiB, WO_W2B = 34 * MiB;
enum { PH_PRO = 0, PH_X0 = 1, PH_F1IN = 2, PH_F1OUT, PH_WIN, PH_MIX1, PH_MIX2, PH_WOUT, PH_F2IN, PH_F2OUT, PH_PER_LAYER = 8 };
constexpr int NPHASES = 2 + DEPTH * PH_PER_LAYER;
constexpr int PROBE_REP_MASK = 0;


namespace pg8 {
#define PG8_LAS __attribute__((address_space(3)))
typedef unsigned short bf16_t;
typedef short bf16x8 __attribute__((ext_vector_type(8)));
typedef float f32x4 __attribute__((ext_vector_type(4)));
typedef unsigned u32x4 __attribute__((ext_vector_type(4)));
constexpr int BM = 256, BK = 64, HALF = 128, HTB = HALF * BK * 2  , STAGE_BYTES = 8 * HTB, NXCD = 8, WGM = 8;

__host__ __device__ __forceinline__ int lds_byte(int r, int c) { const int st = (r >> 4) * 2 + (c >> 5), rr = r & 15, cc = c & 31, ob = rr * 64 + cc * 2; return st * 1024 + (ob ^ (((ob >> 9) & 1) << 5)); }
__host__ __device__ __forceinline__ void stage_rc(int b, int& R, int& C) { const int st = b / 1024, sb = b % 1024, swz = sb ^ (((sb >> 9) & 1) << 5); R = (st >> 1) * 16 + swz / 64; C = (st & 1) * 32 + (swz % 64) / 2; }
__host__ __device__ __forceinline__ int perm32(int rho) { const int n = rho >> 4, i = rho & 15; return 8 * (i >> 2) + 4 * n + (i & 3); }

struct Unit { int pm, pn, mask; };
struct Gemm { const bf16_t* A; const bf16_t* Bt; int M, N, K; };

struct StaticOrder {
    int nM, nN, nwg, G, c;
    __host__ __device__ void init(int M, int N, int G_, int c_) { nM = M / BM; nN = N / BM; nwg = nM * nN; G = G_; c = c_; }
    __host__ __device__ bool next(int i, Unit& u) const {
        const int rfull = nwg / G, left = nwg - rfull * G;
        long L = (long)i * G + c; u.mask = 3;
        if (i == rfull && left > 0 && 2 * left <= G) { if (c >= 2 * left) return false; L = (long)i * G + (c >> 1); u.mask = 1 << (c & 1); }
        if (L >= nwg) return false;
        int wgid = (int)L; { const int q = nwg / NXCD, r = nwg % NXCD, xcd = wgid % NXCD, off = wgid / NXCD; wgid = (xcd < r ? xcd * (q + 1) : r * (q + 1) + (xcd - r) * q) + off; }
        const int nig = WGM * nN, gid = wgid / nig, fm = gid * WGM, gsz = (nM - fm) < WGM ? (nM - fm) : WGM;
        u.pm = fm + ((wgid % nig) % gsz); u.pn = (wgid % nig) / gsz; return true;
    }
    __device__ __forceinline__ void a_ready(const Unit&) const {}
    __device__ __forceinline__ void done(const Unit&) const {}
};
__device__ __forceinline__ unsigned cvt_pk_bf16(float lo, float hi) { unsigned r; asm volatile("v_cvt_pk_bf16_f32 %0, %1, %2" : "=v"(r) : "v"(lo), "v"(hi)); return r; }

__device__ __forceinline__ float silu_fast(float x) { return x * __builtin_amdgcn_rcpf(1.f + __builtin_amdgcn_exp2f(-1.4426950408889634f * x)); }
__device__ __forceinline__ float gelu_fast(float x) {
    const float u2 = 1.5957691216057308f * (x + 0.044715f * x * x * x);
    return x * __builtin_amdgcn_rcpf(1.f + __builtin_amdgcn_exp2f(-1.4426950408889634f * u2));
}
struct EpiFfnIn {
    static constexpr bool PERM = true, AFTER_DRAIN = false;
    int l, second;
    __device__ __forceinline__ void operator()(const f32x4 (&acc)[2][2][4][2], const Unit& u, int wr, int wc, int fr, int fq) const {
        asm volatile("" : "+v"(fr), "+v"(fq));
        unsigned char* ws = PWS; bf16_t* ACT = (bf16_t*)(ws + WS_ACT);
        const float* rowss = (const float*)(ws + WS_ROWSS) + (size_t)(l * 3 + (second ? 2 : 0)) * MT; const float* shw = (const float*)(ws + WS_SHW) + (size_t)l * SHW_LAYER + (second ? SHW_J2 : 0);
        const int row0 = u.pm * 256 + wr * 64 + fr, col0 = u.pn * 128 + wc * 32 + 8 * fq;
        const float* sp = shw + (size_t)modrow(u.pm * 256) * (2 * FF) + u.pn * 256 + wc * 32 + 8 * fq;
        const f32x4 sg0 = *(const f32x4*)sp, sg1 = *(const f32x4*)(sp + 4), su0 = *(const f32x4*)(sp + 128), su1 = *(const f32x4*)(sp + 132);
#pragma unroll
        for (int ai = 0; ai < 2; ++ai) if ((u.mask >> ai) & 1)
#pragma unroll
            for (int m = 0; m < 4; ++m) {
                const int row = row0 + ai * 128 + m * 16;
                const float ri = rsqrtf(rowss[row] * (1.f / D) + 1e-6f);
                const f32x4 g0 = acc[ai][0][m][0] * ri + sg0, g1 = acc[ai][0][m][1] * ri + sg1, u0 = acc[ai][1][m][0] * ri + su0, u1 = acc[ai][1][m][1] * ri + su1;
                u32x4 w;
                w.x = cvt_pk_bf16(silu_fast(g0[0]) * u0[0], silu_fast(g0[1]) * u0[1]); w.y = cvt_pk_bf16(silu_fast(g0[2]) * u0[2], silu_fast(g0[3]) * u0[3]);
                w.z = cvt_pk_bf16(silu_fast(g1[0]) * u1[0], silu_fast(g1[1]) * u1[1]); w.w = cvt_pk_bf16(silu_fast(g1[2]) * u1[2], silu_fast(g1[3]) * u1[3]);
                *(u32x4*)(ACT + (size_t)row * FF + col0) = w;
            }
    }
};
typedef _Float16 f16x8 __attribute__((ext_vector_type(8)));
typedef _Float16 f16x4 __attribute__((ext_vector_type(4)));
typedef float f32x8 __attribute__((ext_vector_type(8)));
struct EpiRes {
    static constexpr bool PERM = true, AFTER_DRAIN = false;
    int l, kind;
    __device__ __forceinline__ void operator()(const f32x4 (&acc)[2][2][4][2], const Unit& u, int wr, int wc, int fr, int fq) const {
        asm volatile("" : "+v"(fr), "+v"(fq));
        unsigned char* ws = PWS; float* X = POUT;
        const int step = l * 3 + kind;
        const bool out_f32 = step == DEPTH * 3 - 1;
        const GASP unsigned char* rp; GASP unsigned char* wp;
        if (out_f32) rp = (const GASP unsigned char*)(u.pm < XH2_SPLIT_PM ? ws + WS_W : ws + WS_XH2B - (size_t)XH2_SPLIT_PM * 256 * D * 2);
        else rp = (const GASP unsigned char*)X + XH_OUT_OFF;
        if (out_f32) wp = (GASP unsigned char*)X;
        else if (step == DEPTH * 3 - 2) wp = (GASP unsigned char*)(u.pm < XH2_SPLIT_PM ? ws + WS_W : ws + WS_XH2B - (size_t)XH2_SPLIT_PM * 256 * D * 2);
        else wp = (GASP unsigned char*)X + XH_OUT_OFF;
        const int row0 = u.pm * 256 + wr * 64 + fr, mr = modrow(u.pm * 256);
        const float fac = kind == 1 ? 1.f : 0.5f;
        const float* gate = (const float*)(ws + WS_MOD) + ((size_t)l * 5 + mr) * NMOD * D + (kind == 0 ? 2 : kind == 1 ? 5 : 8) * D;
        const int nl = kind == 2 ? l + 1 : l, nn = nl * 3 + (kind == 0 ? 1 : kind == 1 ? 2 : 0);
        const bool wn = nl < DEPTH;
        bf16_t* H = (bf16_t*)(ws + WS_H); const float* wnp = (const float*)(ws + WS_WN) + ((size_t)nn * 5 + mr) * D; float* rowss_next = (float*)(ws + WS_ROWSS) + (size_t)nn * MT;
        f32x4 ga[2], gb[2], wa[2], wb[2];
#pragma unroll
        for (int bj = 0; bj < 2; ++bj) {
            const int col = u.pn * 256 + bj * 128 + wc * 32 + 8 * fq;
            ga[bj] = *(const f32x4*)(gate + col) * fac; gb[bj] = *(const f32x4*)(gate + col + 4) * fac;
            wa[bj] = (f32x4){0.f, 0.f, 0.f, 0.f}; wb[bj] = wa[bj];
            if (wn) { wa[bj] = *(const f32x4*)(wnp + col); wb[bj] = *(const f32x4*)(wnp + col + 4); }
        }
#pragma unroll
        for (int ai = 0; ai < 2; ++ai) if ((u.mask >> ai) & 1)
#pragma unroll
            for (int m = 0; m < 4; ++m) {
                const int row = row0 + ai * 128 + m * 16;
                float ssq = 0.f;
#pragma unroll
                for (int bj = 0; bj < 2; ++bj) {
                    const size_t ro = (size_t)row * D + u.pn * 256 + bj * 128 + wc * 32 + 8 * fq;
                    f32x4 x0, x1;
                    { const f32x8 fv = __builtin_convertvector(*(const GASP f16x8*)((const GASP _Float16*)rp + ro), f32x8); x0 = fv.lo; x1 = fv.hi; }
                    x0 += ga[bj] * acc[ai][bj][m][0]; x1 += gb[bj] * acc[ai][bj][m][1];
                    if (out_f32) { GASP float* x = (GASP float*)wp + ro; *(GASP f32x4*)x = x0; *(GASP f32x4*)(x + 4) = x1; }
                    else { f32x8 fv; fv.lo = x0; fv.hi = x1; *(GASP f16x8*)((GASP _Float16*)wp + ro) = __builtin_convertvector(fv, f16x8); }
                    if (wn) {
                        ssq += ((x0[0] * x0[0] + x0[1] * x0[1]) + (x0[2] * x0[2] + x0[3] * x0[3])) + ((x1[0] * x1[0] + x1[1] * x1[1]) + (x1[2] * x1[2] + x1[3] * x1[3]));
                        const f32x4 h0 = x0 * wa[bj], h1 = x1 * wb[bj];
                        u32x4 w; w.x = cvt_pk_bf16(h0[0], h0[1]); w.y = cvt_pk_bf16(h0[2], h0[3]); w.z = cvt_pk_bf16(h1[0], h1[1]); w.w = cvt_pk_bf16(h1[2], h1[3]);
                        *(u32x4*)(H + ro) = w;
                    }
                }
                if (wn) { ssq += __shfl_xor(ssq, 16); ssq += __shfl_xor(ssq, 32); if (fq == 0) (void)__hip_atomic_fetch_add(rowss_next + row, ssq, __ATOMIC_RELAXED, __HIP_MEMORY_SCOPE_AGENT); }
            }
    }
};
struct EpiWin {
    static constexpr bool PERM = true, AFTER_DRAIN = false;
    int l;
    __device__ __forceinline__ void operator()(f32x4 (&acc)[2][2][4][2], const Unit& u, int wr, int wc, int fr, int fq) const {
        asm volatile("" : "+v"(fr), "+v"(fq));
        unsigned char* ws = PWS; float* out = POUT; const float* qn = PIN(25) + l * HD; const float* kn = PIN(26) + l * HD;
        const float* rowss = (const float*)(ws + WS_ROWSS) + (size_t)(l * 3 + 1) * MT; const float* shw = (const float*)(ws + WS_SHW) + (size_t)l * SHW_LAYER + SHW_J1;
        const int row0 = u.pm * 256 + wr * 64 + fr, pn = u.pn;
        {
            const float* sp = shw + (size_t)modrow(u.pm * 256) * INC + pn * 256 + wc * 32 + 8 * fq;
            f32x4 sv[2][2];
#pragma unroll
            for (int bj = 0; bj < 2; ++bj) { sv[bj][0] = *(const f32x4*)(sp + bj * 128); sv[bj][1] = *(const f32x4*)(sp + bj * 128 + 4); }
#pragma unroll
            for (int ai = 0; ai < 2; ++ai) if ((u.mask >> ai) & 1)
#pragma unroll
                for (int m = 0; m < 4; ++m) {
                    const float ri = rsqrtf(rowss[row0 + ai * 128 + m * 16] * (1.f / D) + 1e-6f);
#pragma unroll
                    for (int bj = 0; bj < 2; ++bj) { acc[ai][bj][m][0] = acc[ai][bj][m][0] * ri + sv[bj][0]; acc[ai][bj][m][1] = acc[ai][bj][m][1] * ri + sv[bj][1]; }
                }
        }
        float* XS = (float*)(ws + WS_XSSM); bf16_t* Q = (bf16_t*)(ws + WS_Q); bf16_t* K = (bf16_t*)(ws + WS_K); bf16_t* VT = (bf16_t*)(ws + WS_VT); bf16_t* U = (bf16_t*)(ws + WS_U); bf16_t* VG = (bf16_t*)(ws + WS_VG);
        float* ock = out + O_CK; float* ocv = out + O_CV;
        if (pn == 0) {
#pragma unroll
            for (int ai = 0; ai < 2; ++ai) if ((u.mask >> ai) & 1)
#pragma unroll
                for (int m = 0; m < 4; ++m)
#pragma unroll
                    for (int bj = 0; bj < 2; ++bj) { float* o = XS + (size_t)(row0 + ai * 128 + m * 16) * SSMW + bj * 128 + wc * 32 + 8 * fq;
                        *(f32x4*)o = acc[ai][bj][m][0]; *(f32x4*)(o + 4) = acc[ai][bj][m][1]; }
        } else if (pn <= 4) {
            const bool isk = pn >= 3; const int h = 4 * ((pn - 1) & 1) + wc;
            const float* gn = isk ? kn : qn; bf16_t* O = isk ? K : Q;
            f32x4 gv[2][2];
#pragma unroll
            for (int bj = 0; bj < 2; ++bj)
#pragma unroll
                for (int n = 0; n < 2; ++n) gv[bj][n] = *(const f32x4*)(gn + 32 * bj + 8 * fq + 4 * n);
#pragma unroll
            for (int ai = 0; ai < 2; ++ai) if ((u.mask >> ai) & 1)
#pragma unroll
                for (int m = 0; m < 4; ++m) {
                    float ss = 0.f;
#pragma unroll
                    for (int bj = 0; bj < 2; ++bj)
#pragma unroll
                        for (int n = 0; n < 2; ++n) { const f32x4 v = acc[ai][bj][m][n]; ss += (v[0] * v[0] + v[1] * v[1]) + (v[2] * v[2] + v[3] * v[3]); }
                    ss += __shfl_xor(ss, 16); ss += __shfl_xor(ss, 32);
                    const float rinv = rsqrtf(ss * (1.f / HD) + 1e-6f);
                    const int row = row0 + ai * 128 + m * 16;
#pragma unroll
                    for (int bj = 0; bj < 2; ++bj) {
                        const f32x4 v0 = acc[ai][bj][m][0] * rinv * gv[bj][0], v1 = acc[ai][bj][m][1] * rinv * gv[bj][1];
                        u32x4 w; w.x = cvt_pk_bf16(v0[0], v0[1]); w.y = cvt_pk_bf16(v0[2], v0[3]); w.z = cvt_pk_bf16(v1[0], v1[1]); w.w = cvt_pk_bf16(v1[2], v1[3]);
                        const int d = 32 * bj + 8 * fq;
                        *(u32x4*)(O + (size_t)row * NAW + h * HD + d) = w;
                        if (isk && u.pm < MC / 256) { const int b = row / SEQ, t = row % SEQ; float* o = ock + ((((size_t)b * DEPTH + l) * SEQ + t) * NH + h) * HD + d;
                            *(f32x4*)o = v0; *(f32x4*)(o + 4) = v1; }
                    }
                }
        } else if (pn <= 6) {
            const bool ctx = u.pm < MC / 256;
#pragma unroll
            for (int ai = 0; ai < 2; ++ai) if ((u.mask >> ai) & 1)
#pragma unroll
                for (int m = 0; m < 4; ++m) {
                    const int row = row0 + ai * 128 + m * 16;
                    size_t vb; int Lq; float* oc = nullptr;
                    if (ctx) { const int b = row / SEQ, t = row % SEQ; vb = (size_t)b * NH * HD * SEQ + t; Lq = SEQ; oc = ocv + (((size_t)b * DEPTH + l) * SEQ + t) * NAW; }
                    else { const int r2 = row - MC, b = r2 / DSEQ, t = r2 % DSEQ; vb = (size_t)MC * NAW + (size_t)b * NH * HD * DSEQ + t; Lq = DSEQ; }
#pragma unroll
                    for (int bj = 0; bj < 2; ++bj) {
                        const int cl = (pn - 5) * 256 + bj * 128 + wc * 32 + 8 * fq;
                        const f32x4 v0 = acc[ai][bj][m][0], v1 = acc[ai][bj][m][1];
                        bf16_t* o = VT + vb + (size_t)cl * Lq;
                        o[0] = f2bf(v0[0]); o[(size_t)Lq] = f2bf(v0[1]); o[(size_t)2 * Lq] = f2bf(v0[2]); o[(size_t)3 * Lq] = f2bf(v0[3]);
                        o[(size_t)4 * Lq] = f2bf(v1[0]); o[(size_t)5 * Lq] = f2bf(v1[1]); o[(size_t)6 * Lq] = f2bf(v1[2]); o[(size_t)7 * Lq] = f2bf(v1[3]);
                        if (ctx) { *(f32x4*)(oc + cl) = v0; *(f32x4*)(oc + cl + 4) = v1; }
                    }
                }
        } else {
            bf16_t* O = pn == 7 ? U : VG;
#pragma unroll
            for (int ai = 0; ai < 2; ++ai) if ((u.mask >> ai) & 1)
#pragma unroll
                for (int m = 0; m < 4; ++m)
#pragma unroll
                    for (int bj = 0; bj < 2; ++bj) {
                        const f32x4 v0 = acc[ai][bj][m][0], v1 = acc[ai][bj][m][1];
                        u32x4 w; w.x = cvt_pk_bf16(gelu_fast(v0[0]), gelu_fast(v0[1])); w.y = cvt_pk_bf16(gelu_fast(v0[2]), gelu_fast(v0[3]));
                        w.z = cvt_pk_bf16(gelu_fast(v1[0]), gelu_fast(v1[1])); w.w = cvt_pk_bf16(gelu_fast(v1[2]), gelu_fast(v1[3]));
                        *(u32x4*)(O + (size_t)(row0 + ai * 128 + m * 16) * GMW + bj * 128 + wc * 32 + 8 * fq) = w;
                    }
        }
    }
};

template <class Epi, class Sched, bool ALIGN_EPI = false, bool SP2 = false>
__device__ __forceinline__ void gemm_phase(PG8_LAS unsigned char* lds, const Gemm g, const Sched& S, const Epi& E) {
    const int tid = tid_opaque(), wid = __builtin_amdgcn_readfirstlane(tid >> 6), lane = tid & 63, wr = wid >> 2, wc = wid & 3, fr = lane & 15, fq = lane >> 4;
    const int K = g.K, nt = K / BK;
    unsigned voffA[2], voffB[2];
#pragma unroll
    for (int i = 0; i < 2; ++i) { int R, C; stage_rc(tid * 16 + i * 8192, R, C); const int Rb = Epi::PERM ? ((R & ~31) + perm32(R & 31)) : R;
        voffA[i] = (unsigned)(R * K + C) * 2u; voffB[i] = (unsigned)(Rb * K + C) * 2u; }
    const size_t kstep = (size_t)(BK * 2);
    const size_t hstep = (size_t)HALF * K * 2;
    const size_t tstep = 2 * hstep;
    const unsigned ldsw = (unsigned)wid * 1024u;
    const int aoff = lds_byte(wr * 64 + fr, fq * 8), boff = lds_byte(wc * 32 + fr, fq * 8);
#define PG8_SA(b, h) (((b) * 2 + (h)) * HTB)
#define PG8_SB(b, h) ((4 + (b) * 2 + (h)) * HTB)
#define PG8_STAGE(bufoff, gbase, voff) do { _Pragma("unroll") for (int _i = 0; _i < 2; ++_i) \
        __builtin_amdgcn_global_load_lds((const unsigned*)((const char*)(gbase) + (voff)[_i]), (PG8_LAS unsigned*)(lds + (bufoff) + ldsw + _i * 8192), 16, 0, 0); } while (0)
#define PG8_LDA(dst, b, h) do { _Pragma("unroll") for (int m = 0; m < 4; ++m) _Pragma("unroll") for (int k = 0; k < 2; ++k) dst[m][k] = *(const PG8_LAS bf16x8*)(lds + PG8_SA(b, h) + aoff + m * 2048 + k * 1024); } while (0)
#define PG8_LDB(dst, b, h) do { _Pragma("unroll") for (int n = 0; n < 2; ++n) _Pragma("unroll") for (int k = 0; k < 2; ++k) dst[n][k] = *(const PG8_LAS bf16x8*)(lds + PG8_SB(b, h) + boff + n * 2048 + k * 1024); } while (0)
#define PG8_MMA(ai, bj, At, Bt) do { __builtin_amdgcn_s_setprio(1); _Pragma("unroll") for (int m = 0; m < 4; ++m) _Pragma("unroll") for (int n = 0; n < 2; ++n) _Pragma("unroll") for (int k = 0; k < 2; ++k) \
        acc[ai][bj][m][n] = __builtin_amdgcn_mfma_f32_16x16x32_bf16(Bt[n][k], At[m][k], acc[ai][bj][m][n], 0, 0, 0); __builtin_amdgcn_s_setprio(0); } while (0)
#define PG8_WAIT_V(n) asm volatile("s_waitcnt vmcnt(" #n ")" ::: "memory")
#define PG8_WAIT_L(n) asm volatile("s_waitcnt lgkmcnt(" #n ")" ::: "memory")
#define PG8_BAR __builtin_amdgcn_s_barrier()
#define PG8_SCHED __builtin_amdgcn_sched_barrier(0)
    Unit cur, nxt; int ui = 0;
    if (!S.next(0, cur)) return;
    f32x4 acc[2][2][4][2];
#pragma unroll
    for (int a = 0; a < 2; ++a)
#pragma unroll
        for (int b = 0; b < 2; ++b)
#pragma unroll
            for (int m = 0; m < 4; ++m)
#pragma unroll
                for (int n = 0; n < 2; ++n) acc[a][b][m][n] = (f32x4){0.f, 0.f, 0.f, 0.f};
    bf16x8 At[4][2], B0[2][2], B1[2][2];
    const char* cA = (const char*)g.A + (size_t)cur.pm * tstep; const char* cB = (const char*)g.Bt + (size_t)cur.pn * tstep;
    S.a_ready(cur);
    if constexpr (SP2) {
        PG8_STAGE(PG8_SB(0, 0), cB, voffB); PG8_STAGE(PG8_SB(0, 1), cB + hstep, voffB); PG8_STAGE(PG8_SA(0, 0), cA, voffA); PG8_STAGE(PG8_SA(0, 1), cA + hstep, voffA);
        if (wr == 1) PG8_BAR;
        PG8_WAIT_V(2); PG8_BAR;
        PG8_STAGE(PG8_SB(1, 0), cB + kstep, voffB); PG8_STAGE(PG8_SA(1, 0), cA + kstep, voffA); PG8_STAGE(PG8_SB(1, 1), cB + hstep + kstep, voffB);
        PG8_WAIT_V(6); PG8_BAR;
    } else {
        PG8_STAGE(PG8_SB(0, 0), cB, voffB); PG8_STAGE(PG8_SA(0, 0), cA, voffA); PG8_STAGE(PG8_SB(0, 1), cB + hstep, voffB); PG8_STAGE(PG8_SA(0, 1), cA + hstep, voffA);
        if (wr == 1) PG8_BAR;
        PG8_WAIT_V(4); PG8_BAR;
        PG8_STAGE(PG8_SB(1, 0), cB + kstep, voffB); PG8_STAGE(PG8_SA(1, 0), cA + kstep, voffA); PG8_STAGE(PG8_SB(1, 1), cB + hstep + kstep, voffB);
        PG8_WAIT_V(6); PG8_BAR;
    }
    for (;;) {
        const bool has_next = S.next(ui + 1, nxt);
        const char* nA = has_next ? (const char*)g.A + (size_t)nxt.pm * tstep : cA; const char* nB = has_next ? (const char*)g.Bt + (size_t)nxt.pn * tstep : cB;
        for (int t = 0; t < nt; t += 2) {
            const bool last = (t == nt - 2);
            const char* a1 = cA + (size_t)(t + 1) * kstep;
            const char* a2 = last ? nA : cA + (size_t)(t + 2) * kstep; const char* b2 = last ? nB : cB + (size_t)(t + 2) * kstep;
            const char* a3 = a2 + kstep; const char* b3 = b2 + kstep;
            if (last && has_next) S.a_ready(nxt);
            if constexpr (SP2) {
            PG8_LDB(B0, 0, 0); PG8_LDB(B1, 0, 1); PG8_SCHED; if (cur.mask & 1) PG8_LDA(At, 0, 0); PG8_STAGE(PG8_SA(1, 1), a1 + hstep, voffA);
            PG8_WAIT_V(8); PG8_WAIT_L(0); PG8_BAR; if (cur.mask & 1) { PG8_MMA(0, 0, At, B0); PG8_MMA(0, 1, At, B1); } PG8_BAR; PG8_SCHED;
            if (cur.mask & 2) PG8_LDA(At, 0, 1); PG8_STAGE(PG8_SB(0, 0), b2, voffB); PG8_STAGE(PG8_SB(0, 1), b2 + hstep, voffB); PG8_STAGE(PG8_SA(0, 0), a2, voffA);
            PG8_WAIT_V(8); PG8_WAIT_L(0); PG8_BAR; if (cur.mask & 2) { PG8_MMA(1, 0, At, B0); PG8_MMA(1, 1, At, B1); } PG8_BAR; PG8_SCHED;
            PG8_LDB(B0, 1, 0); PG8_LDB(B1, 1, 1); PG8_SCHED; if (cur.mask & 1) PG8_LDA(At, 1, 0); PG8_STAGE(PG8_SA(0, 1), a2 + hstep, voffA);
            PG8_WAIT_V(8); PG8_WAIT_L(0); PG8_BAR; if (cur.mask & 1) { PG8_MMA(0, 0, At, B0); PG8_MMA(0, 1, At, B1); } PG8_BAR; PG8_SCHED;
            if (cur.mask & 2) PG8_LDA(At, 1, 1); PG8_STAGE(PG8_SB(1, 0), b3, voffB); PG8_STAGE(PG8_SB(1, 1), b3 + hstep, voffB); PG8_STAGE(PG8_SA(1, 0), a3, voffA);
            PG8_WAIT_V(8); PG8_WAIT_L(0); PG8_BAR; if (cur.mask & 2) { PG8_MMA(1, 0, At, B0); PG8_MMA(1, 1, At, B1); } PG8_BAR; PG8_SCHED;
            } else {
            PG8_LDB(B0, 0, 0); PG8_SCHED; PG8_LDA(At, 0, 0); PG8_STAGE(PG8_SA(1, 1), a1 + hstep, voffA);
            PG8_WAIT_L(8); PG8_BAR; PG8_WAIT_L(0); PG8_MMA(0, 0, At, B0); PG8_BAR; PG8_SCHED;
            PG8_LDB(B1, 0, 1); PG8_STAGE(PG8_SB(0, 0), b2, voffB);
            PG8_BAR; PG8_WAIT_L(0); PG8_MMA(0, 1, At, B1); PG8_BAR;
            PG8_LDA(At, 0, 1); PG8_STAGE(PG8_SA(0, 0), a2, voffA);
            PG8_BAR; PG8_WAIT_L(0); PG8_MMA(1, 0, At, B0); PG8_BAR; PG8_SCHED;
            PG8_STAGE(PG8_SB(0, 1), b2 + hstep, voffB);
            PG8_WAIT_V(6); PG8_BAR; PG8_MMA(1, 1, At, B1); PG8_BAR;
            PG8_LDB(B0, 1, 0); PG8_SCHED; PG8_LDA(At, 1, 0); PG8_STAGE(PG8_SA(0, 1), a2 + hstep, voffA);
            PG8_WAIT_L(8); PG8_BAR; PG8_WAIT_L(0); PG8_MMA(0, 0, At, B0); PG8_BAR; PG8_SCHED;
            PG8_LDB(B1, 1, 1); PG8_STAGE(PG8_SB(1, 0), b3, voffB);
            PG8_BAR; PG8_WAIT_L(0); PG8_MMA(0, 1, At, B1); PG8_BAR;
            PG8_LDA(At, 1, 1); PG8_STAGE(PG8_SA(1, 0), a3, voffA);
            PG8_BAR; PG8_WAIT_L(0); PG8_MMA(1, 0, At, B0); PG8_BAR; PG8_SCHED;
            PG8_STAGE(PG8_SB(1, 1), b3 + hstep, voffB);
            PG8_WAIT_V(6); PG8_BAR; PG8_MMA(1, 1, At, B1); PG8_BAR;
            }
        }
        if constexpr (ALIGN_EPI) { if (wr == 0) PG8_BAR; }
        if constexpr (!Epi::AFTER_DRAIN) { E(acc, cur, wr, wc, fr, fq); S.done(cur); }
        if (!has_next) break;
#pragma unroll
        for (int a = 0; a < 2; ++a)
#pragma unroll
            for (int b = 0; b < 2; ++b)
#pragma unroll
                for (int m = 0; m < 4; ++m)
#pragma unroll
                    for (int n = 0; n < 2; ++n) acc[a][b][m][n] = (f32x4){0.f, 0.f, 0.f, 0.f};
        cur = nxt; cA = nA; cB = nB; ++ui;
        if constexpr (ALIGN_EPI) { if (wr == 1) PG8_BAR; }
    }
    PG8_WAIT_V(0);
    if constexpr (!ALIGN_EPI) { if (wr == 0) PG8_BAR; }
    PG8_BAR;
    if constexpr (Epi::AFTER_DRAIN) { E.fused(acc, cur, wr, wc, fr, fq, lds, wid, lane); S.done(cur); }
#undef PG8_SA
#undef PG8_SB
#undef PG8_STAGE
#undef PG8_LDA
#undef PG8_LDB
#undef PG8_MMA
#undef PG8_WAIT_V
#undef PG8_WAIT_L
#undef PG8_BAR
#undef PG8_SCHED
}

}

#define LAS __attribute__((address_space(3)))

__device__ __forceinline__ void transpose_item(const float* W, int K, int N, bf16_t* WT, int k0, int ns0, int nd0, LAS float* scr, int lane) {
    float v[32];
    const float* wp = W + (size_t)(k0 + (lane >> 5)) * N + ns0 + (lane & 31);
#pragma unroll
    for (int i = 0; i < 32; ++i) v[i] = wp[(size_t)(2 * i) * N];
#pragma unroll
    for (int i = 0; i < 32; ++i) scr[(2 * i + (lane >> 5)) * 33 + (lane & 31)] = v[i];
    asm volatile("s_waitcnt lgkmcnt(0)" ::: "memory");
    const int c = lane & 7;
#pragma unroll
    for (int j = 0; j < 4; ++j) { const int n = (lane >> 3) + 8 * j; const LAS float* s = scr + (8 * c) * 33 + n;
        pg8::u32x4 o; o.x = pg8::cvt_pk_bf16(s[0 * 33], s[1 * 33]); o.y = pg8::cvt_pk_bf16(s[2 * 33], s[3 * 33]); o.z = pg8::cvt_pk_bf16(s[4 * 33], s[5 * 33]); o.w = pg8::cvt_pk_bf16(s[6 * 33], s[7 * 33]);
        *(pg8::u32x4*)(WT + (size_t)(nd0 + n) * K + k0 + 8 * c) = o; }
    asm volatile("s_waitcnt lgkmcnt(0)" ::: "memory");
}
__device__ __forceinline__ void prologue_phase(LAS unsigned char* lds, int vcu, int G) {
    const int tid = tid_opaque(), lane = tid & 63, wave = __builtin_amdgcn_readfirstlane(tid >> 6);
    {
        LAS float* sc = (LAS float*)lds;
        LAS float* red = (LAS float*)(lds + 20480);
        const float* cctx = PIN(6); const float* cc = PIN(2);
        for (int i = tid; i < 5 * D; i += NWAVES * 64) { const int r = i / D, k = i % D; const float v = r == 0 ? cctx[k] : cc[(r - 1) * D + k]; sc[i] = v / (1.f + __expf(-v)); }
        __syncthreads();
        constexpr int KQ = 16, NBLK = NMOD * D / 128, NIT = DEPTH * NBLK * KQ;
        int it0 = (int)((long)vcu * NIT / G); const int it1 = (int)((long)(vcu + 1) * NIT / G);
        while (it0 < it1) {
            const int blk = it0 / KQ, ke = it1 < (blk + 1) * KQ ? it1 : (blk + 1) * KQ, nk = ke - it0;
            const int l = blk / NBLK, n0 = (blk % NBLK) * 128, kbeg = (it0 % KQ) * (D / KQ);
            const float* w = PIN(7) + (size_t)l * D * NMOD * D + n0 + (lane & 31) * 4;
            const int kb = kbeg + wave * (nk * 8) + (lane >> 5), nl = nk * 4;
            pg8::f32x4 a[5];
#pragma unroll
            for (int r = 0; r < 5; ++r) a[r] = (pg8::f32x4){0.f, 0.f, 0.f, 0.f};
#pragma unroll 1
            for (int i0 = 0; i0 < nl; i0 += 12) {
                pg8::f32x4 wv[12];
#pragma unroll
                for (int i = 0; i < 12; ++i) { const int ii = i0 + i < nl ? i0 + i : nl - 1; wv[i] = *(const pg8::f32x4*)(w + (size_t)(kb + 2 * ii) * NMOD * D); }
#pragma unroll
                for (int i = 0; i < 12; ++i) { const bool ok = i0 + i < nl; const int k = kb + 2 * (ok ? i0 + i : nl - 1);
#pragma unroll
                    for (int r = 0; r < 5; ++r) a[r] += wv[i] * (ok ? sc[r * D + k] : 0.f); }
            }
#pragma unroll
            for (int r = 0; r < 5; ++r) {
#pragma unroll
                for (int e = 0; e < 4; ++e) a[r][e] += __shfl_xor(a[r][e], 32);
                if (lane < 32) *(LAS pg8::f32x4*)(red + (wave * 5 + r) * 128 + lane * 4) = a[r]; }
            __syncthreads();
            const float* bada = PIN(8); float* modo = (float*)(PWS + WS_MOD);
            for (int o = tid; o < 5 * 128; o += NWAVES * 64) { const int r = o / 128, c = o % 128; float s = kbeg == 0 ? bada[l * NMOD * D + n0 + c] : 0.f;
#pragma unroll
                for (int w8 = 0; w8 < 8; ++w8) s += red[(w8 * 5 + r) * 128 + c];
                (void)__hip_atomic_fetch_add(modo + ((size_t)l * 5 + r) * NMOD * D + n0 + c, s, __ATOMIC_RELAXED, __HIP_MEMORY_SCOPE_AGENT); }
            __syncthreads();
            it0 = ke;
        }
        __syncthreads();
    }
    {
        LAS float* scr = (LAS float*)(lds + wave * 16384);
        const int gw = vcu * NWAVES + wave, NGW = G * NWAVES;
        constexpr int I_FIN = (D / 64) * (2 * FF / 32), I_FOUT = (FF / 64) * (D / 32), I_WIN = (D / 64) * (INC / 32), I_WOUT = (D / 64) * (D / 32);
        constexpr int I_LAYER = 2 * I_FIN + 2 * I_FOUT + I_WIN + I_WOUT;
        for (int it = gw; it < DEPTH * I_LAYER; it += NGW) {
            const int l = it / I_LAYER; int r = it % I_LAYER;
            unsigned char* wl = PWS + WS_W + (size_t)l * WL_STRIDE;
            int which = 0;
            if (r >= I_FIN) { r -= I_FIN; which = 1; if (r >= I_FOUT) { r -= I_FOUT; which = 2; if (r >= I_WIN) { r -= I_WIN; which = 3; if (r >= I_WOUT) { r -= I_WOUT; which = 4; if (r >= I_FIN) { r -= I_FIN; which = 5; } } } } }
            if (which == 0 || which == 4) {
                const float* W = (which == 0 ? PIN(10) : PIN(31)) + (size_t)l * D * 2 * FF; bf16_t* WT = (bf16_t*)(wl + (which == 0 ? WO_W1A : WO_W1B));
                const int nblk = 2 * FF / 32, kb = r / nblk, nd0 = (r % nblk) * 32; const int pn = nd0 / 256, c = nd0 % 256, bj = c / 128, x = c % 128;
                transpose_item(W, D, 2 * FF, WT, kb * 64, bj * FF + 128 * pn + x, nd0, scr, lane);
            } else if (which == 1 || which == 5) {
                const float* W = (which == 1 ? PIN(11) : PIN(32)) + (size_t)l * FF * D; bf16_t* WT = (bf16_t*)(wl + (which == 1 ? WO_W2A : WO_W2B));
                const int nblk = D / 32, kb = r / nblk, nd0 = (r % nblk) * 32;
                transpose_item(W, FF, D, WT, kb * 64, nd0, nd0, scr, lane);
            } else if (which == 2) {
                const float* W = PIN(13) + (size_t)l * D * INC; bf16_t* WT = (bf16_t*)(wl + WO_WIN);
                const int nblk = INC / 32, kb = r / nblk, nd0 = (r % nblk) * 32; const int pn = nd0 / 256, c = nd0 % 256;
                int ns0 = nd0; if (pn >= 1 && pn <= 4) { const int bj = c / 128, wc = (c % 128) / 32; ns0 = 256 * pn + 64 * wc + 32 * bj; }
                transpose_item(W, D, INC, WT, kb * 64, ns0, nd0, scr, lane);
            } else {
                const float* W = PIN(14) + (size_t)l * D * D; bf16_t* WT = (bf16_t*)(wl + WO_WOUT);
                const int nblk = D / 32, kb = r / nblk, nd0 = (r % nblk) * 32;
                transpose_item(W, D, D, WT, kb * 64, nd0, nd0, scr, lane);
            }
        }
    }
    const int gt = vcu * (NWAVES * 64) + tid, NGT = G * NWAVES * 64;
    const int gtr = (G - 1 - vcu) * (NWAVES * 64) + tid;
    {
        constexpr int NSLOT = DEPTH * 4 * 128 * 128, CTOT = DB * DEPTH * PAST * NH * HD;
        static_assert(DEPTH * SSMW * SSMW == NSLOT && CTOT == 8 * NSLOT && DEPTH * 3 * MT <= 2 * NSLOT, "slot loop layout");
        const float* gws = PIN(28); bf16_t* wsb = (bf16_t*)(PWS + WS_WSB); const float* glw = PIN(23); bf16_t* glt = (bf16_t*)(PWS + WS_GLT); float* rs = (float*)(PWS + WS_ROWSS);
        const float* cki = PIN(3); const float* cvi = PIN(4); bf16_t* cko = (bf16_t*)(PWS + WS_CK); bf16_t* cvo = (bf16_t*)(PWS + WS_CVT);
        for (int sl = gt; sl < NSLOT; sl += NGT) {
            const float w0 = gws[sl];
            const int gk = sl % SSMW, gn = (sl / SSMW) % SSMW, gl = sl / (SSMW * SSMW);
            const float g0 = glw[((size_t)gl * SSMW + gk) * SSMW + gn];
            float kv[8], vv[8];
#pragma unroll
            for (int j = 0; j < 8; ++j) { kv[j] = cki[sl + j * NSLOT]; vv[j] = cvi[sl + j * NSLOT]; }
            wsb[sl] = f2bf(w0); glt[sl] = f2bf(g0);
            rs[sl] = 0.f; if (sl + NSLOT < DEPTH * 3 * MT) rs[sl + NSLOT] = 0.f;
#pragma unroll
            for (int j = 0; j < 8; ++j) { const int idx = sl + j * NSLOT;
                const int d = idx % HD, h = (idx / HD) % NH, t = (idx / (HD * NH)) % PAST, l = (idx / (HD * NH * PAST)) % DEPTH, b = idx / (HD * NH * PAST * DEPTH);
                cko[((((size_t)l * DB + b) * NH + h) * PAST + t) * HD + d] = f2bf(kv[j]);
                cvo[((((size_t)l * DB + b) * NH + h) * HD + d) * PAST + t] = f2bf(vv[j]); }
        }
    }
    for (int idx = gtr; idx < DEPTH * 2 * SG * SP; idx += NGT) {
        const int g = (idx / SP) % SG, ld = idx / (SP * SG);
        const float lre = PIN(15)[idx], lim = PIN(16)[idx];
        const float dt = expf(PIN(17)[ld * SG + g]);
        const float er = expf(lre * dt); float sn, cs; sincosf(lim * dt, &sn, &cs);
        const float br = er * cs, bi = er * sn;
        const float nr = br - 1.f, ni = bi, den = lre * lre + lim * lim;
        const float cr = (nr * lre + ni * lim) / den, ci = (ni * lre - nr * lim) / den;
        float2* lb = (float2*)(PWS + WS_SSMP); float2* bb = (float2*)(PWS + WS_SSMP + 64 * 1024);
        lb[idx] = make_float2(br, bi);
        const float* bre = PIN(18); const float* bim = PIN(19);
        float bxr[SC], bxi[SC];
#pragma unroll
        for (int c = 0; c < SC; ++c) { const float xr = bre[(size_t)idx * SC + c], xi = bim[(size_t)idx * SC + c];
            bxr[c] = cr * xr - ci * xi; bxi[c] = cr * xi + ci * xr; bb[(size_t)idx * SC + c] = make_float2(bxr[c], bxi[c]); }
        const int pp = idx % SP; pg8::u32x4* bmf = (pg8::u32x4*)(PWS + WS_BMF) + ((size_t)(idx / SP) * 8 + pp / 8) * 64;
#pragma unroll
        for (int part = 0; part < 2; ++part)
#pragma unroll
            for (int q4 = 0; q4 < 4; ++q4) { const int c0 = 8 * (q4 & 1); pg8::u32x4 w;
                w.x = pg8::cvt_pk_bf16(part ? bxi[c0 + 0] : bxr[c0 + 0], part ? bxi[c0 + 1] : bxr[c0 + 1]); w.y = pg8::cvt_pk_bf16(part ? bxi[c0 + 2] : bxr[c0 + 2], part ? bxi[c0 + 3] : bxr[c0 + 3]);
                w.z = pg8::cvt_pk_bf16(part ? bxi[c0 + 4] : bxr[c0 + 4], part ? bxi[c0 + 5] : bxr[c0 + 5]); w.w = pg8::cvt_pk_bf16(part ? bxi[c0 + 6] : bxr[c0 + 6], part ? bxi[c0 + 7] : bxr[c0 + 7]);
                bmf[16 * q4 + 2 * (pp % 8) + part] = w; }
    }
    {
        const float* cre0 = PIN(20); const float* cim0 = PIN(21); pg8::u32x4* cff = (pg8::u32x4*)(PWS + WS_CFF);
        for (int idx = gtr; idx < DEPTH * 2 * SG * 4 * 64; idx += NGT) {
            const int ln = idx & 63, ks = (idx >> 6) & 3, ldg = idx >> 8, rr = ln & 15, qq = ln >> 4;
            const float* a = cre0 + ((size_t)ldg * SC + rr) * SP + 16 * ks + 4 * qq; const float* b = cim0 + ((size_t)ldg * SC + rr) * SP + 16 * ks + 4 * qq;
            pg8::u32x4 w; w.x = pg8::cvt_pk_bf16(a[0], -b[0]); w.y = pg8::cvt_pk_bf16(a[1], -b[1]); w.z = pg8::cvt_pk_bf16(a[2], -b[2]); w.w = pg8::cvt_pk_bf16(a[3], -b[3]);
            cff[idx] = w;
        }
    }
}
__device__ __forceinline__ void x0_phase(int vcu, int G) {
    const int tid = tid_opaque(), lane = tid & 63, wave = __builtin_amdgcn_readfirstlane(tid >> 6);
    const int gw = vcu * NWAVES + wave, NGW = G * NWAVES;
    const float* modb = (const float*)(PWS + WS_MOD);
    {
        const float* gain = PIN(9); const float* xp = PIN(0); const float* xs = PIN(1); bf16_t* Hb = (bf16_t*)(PWS + WS_H); float* rs = (float*)(PWS + WS_ROWSS);
        for (int row = gw; row < MT; row += NGW) {
            const float* src = row < MC ? xp + (size_t)row * D : xs + (size_t)(row - MC) * D;
            const float* sc = modb + (size_t)modrow(row) * NMOD * D + 1 * D;
            float4 v[4]; float ss = 0.f;
#pragma unroll
            for (int j = 0; j < 4; ++j) { v[j] = ((const float4*)src)[lane + 64 * j]; ss += v[j].x * v[j].x + v[j].y * v[j].y + v[j].z * v[j].z + v[j].w * v[j].w; }
            ss = wave_sum(ss);
            if (lane == 0) rs[row] = ss;
            bf16_t* Hr = Hb + (size_t)row * D; _Float16* Xr = (_Float16*)((unsigned char*)POUT + XH_OUT_OFF) + (size_t)row * D;
#pragma unroll
            for (int j = 0; j < 4; ++j) {
                const int c0 = (lane + 64 * j) * 4;
                { pg8::f32x4 xv; xv[0] = v[j].x; xv[1] = v[j].y; xv[2] = v[j].z; xv[3] = v[j].w; *(pg8::f16x4*)(Xr + c0) = __builtin_convertvector(xv, pg8::f16x4); }
                const float4 g4 = *(const float4*)(gain + c0), s4 = *(const float4*)(sc + c0);
                uint2 o;
                o.x = pg8::cvt_pk_bf16(v[j].x * g4.x * (1.f + s4.x), v[j].y * g4.y * (1.f + s4.y));
                o.y = pg8::cvt_pk_bf16(v[j].z * g4.z * (1.f + s4.z), v[j].w * g4.w * (1.f + s4.w));
                *(uint2*)(Hr + c0) = o;
            }
        }
    }
    {
        float* wn = (float*)(PWS + WS_WN);
        const int gt = vcu * (NWAVES * 64) + tid, NGT = G * NWAVES * 64;
        for (int idx = gt; idx < DEPTH * 3 * 5 * D; idx += NGT) {
            const int c = idx % D, mr = (idx / D) % 5, j = (idx / (5 * D)) % 3, l = idx / (15 * D);
            const float g = (j == 0 ? PIN(9) : j == 1 ? PIN(12) : PIN(30))[l * D + c];
            wn[idx] = g * (1.f + modb[((size_t)l * 5 + mr) * NMOD * D + (3 * j + 1) * D + c]);
        }
    }
    {
        float* shw = (float*)(PWS + WS_SHW);
        constexpr int TPL = (2 * 2 * FF + INC) / 16;
        const int r = lane & 15, q4 = lane >> 4;
        for (int it = gw; it < DEPTH * TPL; it += NGW) {
            const int l = it / TPL, t = it % TPL;
            int j, n0, N; size_t wo;
            if (t < 2 * FF / 16) { j = 0; n0 = t * 16; wo = WO_W1A; N = 2 * FF; } else if (t < (2 * FF + INC) / 16) { j = 1; n0 = (t - 2 * FF / 16) * 16; wo = WO_WIN; N = INC; } else { j = 2; n0 = (t - (2 * FF + INC) / 16) * 16; wo = WO_W1B; N = 2 * FF; }
            const bf16_t* wt = (const bf16_t*)(PWS + WS_W + (size_t)l * WL_STRIDE + wo) + (size_t)(n0 + r) * D + 8 * q4;
            const float* sh = modb + ((size_t)l * 5 + (r < 5 ? r : 4)) * NMOD * D + (3 * j) * D + 8 * q4;
            const bool valid = r < 5;
            pg8::f32x4 ah = (pg8::f32x4){0.f, 0.f, 0.f, 0.f}, al = ah;
#pragma unroll 4
            for (int ks = 0; ks < 32; ++ks) {
                const pg8::bf16x8 b = *(const pg8::bf16x8*)(wt + 32 * ks);
                const pg8::f32x4 s0 = *(const pg8::f32x4*)(sh + 32 * ks), s1 = *(const pg8::f32x4*)(sh + 32 * ks + 4);
                const float sv[8] = {s0[0], s0[1], s0[2], s0[3], s1[0], s1[1], s1[2], s1[3]};
                unsigned hw[4], lw[4];
#pragma unroll
                for (int i = 0; i < 4; ++i) { const unsigned hp = pg8::cvt_pk_bf16(sv[2 * i], sv[2 * i + 1]);
                    const unsigned lp = pg8::cvt_pk_bf16(sv[2 * i] - __uint_as_float(hp << 16), sv[2 * i + 1] - __uint_as_float(hp & 0xffff0000u));
                    hw[i] = valid ? hp : 0u; lw[i] = valid ? lp : 0u; }
                pg8::u32x4 hv, lv; hv.x = hw[0]; hv.y = hw[1]; hv.z = hw[2]; hv.w = hw[3]; lv.x = lw[0]; lv.y = lw[1]; lv.z = lw[2]; lv.w = lw[3];
                ah = __builtin_amdgcn_mfma_f32_16x16x32_bf16(__builtin_bit_cast(pg8::bf16x8, hv), b, ah, 0, 0, 0);
                al = __builtin_amdgcn_mfma_f32_16x16x32_bf16(__builtin_bit_cast(pg8::bf16x8, lv), b, al, 0, 0, 0);
            }
            const pg8::f32x4 sum = ah + al;
            float* o = shw + (size_t)l * SHW_LAYER + (j == 0 ? 0 : j == 1 ? SHW_J1 : SHW_J2) + n0 + r;
            if (q4 == 0) { o[0] = sum[0]; o[(size_t)N] = sum[1]; o[(size_t)2 * N] = sum[2]; o[(size_t)3 * N] = sum[3]; }
            else if (q4 == 1) o[(size_t)4 * N] = sum[0];
        }
    }
}
typedef short bf16x8 __attribute__((ext_vector_type(8)));
typedef float f32x4 __attribute__((ext_vector_type(4)));
typedef unsigned u32x4 __attribute__((ext_vector_type(4)));
typedef float f32x2 __attribute__((ext_vector_type(2)));
typedef unsigned u32x2 __attribute__((ext_vector_type(2)));
constexpr float QK_SCALE_LOG2E = 0.125f * 1.4426950408889634f;
constexpr int AK_STRIDE = 72, AV_STRIDE = 264, ATT_V_OFF = 256 * AK_STRIDE * 2, ATT_B_OFF = ATT_V_OFF + 64 * AV_STRIDE * 2;
__device__ __forceinline__ bf16x8 ldg8(const bf16_t* p) { return *(const bf16x8*)p; }
__device__ __forceinline__ void softmax_pv_step(const f32x4 sa, const f32x4 sb, float& m, float& lsum, f32x4 (&o)[4], const bf16x8 (&vf)[4]) {
    const float mx8 = fmaxf(fmaxf(fmaxf(sa[0], sa[1]), fmaxf(sa[2], sa[3])), fmaxf(fmaxf(sb[0], sb[1]), fmaxf(sb[2], sb[3])));
    if (__builtin_amdgcn_ballot_w64(mx8 > m + 8.f) != 0ull) {
        float mx = fmaxf(mx8, __shfl_xor(mx8, 16)); mx = fmaxf(mx, __shfl_xor(mx, 32));
        const float mn = fmaxf(m, mx), alpha = __builtin_amdgcn_exp2f(m - mn); m = mn; lsum *= alpha;
#pragma unroll
        for (int dt = 0; dt < 4; ++dt) o[dt] = o[dt] * alpha;
    }
    float p[8];
#pragma unroll
    for (int i = 0; i < 4; ++i) { p[i] = __builtin_amdgcn_exp2f(sa[i] - m); p[4 + i] = __builtin_amdgcn_exp2f(sb[i] - m); }
    lsum += ((p[0] + p[1]) + (p[2] + p[3])) + ((p[4] + p[5]) + (p[6] + p[7]));
    u32x4 pw; pw.x = pg8::cvt_pk_bf16(p[0], p[1]); pw.y = pg8::cvt_pk_bf16(p[2], p[3]); pw.z = pg8::cvt_pk_bf16(p[4], p[5]); pw.w = pg8::cvt_pk_bf16(p[6], p[7]);
    const bf16x8 pf = __builtin_bit_cast(bf16x8, pw);
#pragma unroll
    for (int dt = 0; dt < 4; ++dt) o[dt] = __builtin_amdgcn_mfma_f32_16x16x32_bf16(vf[dt], pf, o[dt], 0, 0, 0);
}
__device__ __forceinline__ void softmax_pv_step2(const f32x4 sa, const f32x4 sb, float& m, float& lsum, f32x4 (&o)[4], const bf16x8 (&vf)[4],
                                                 const f32x4 ta, const f32x4 tb, float& m2, float& l2, f32x4 (&o2)[4], const bf16x8 (&vf2)[4]) {
    const float mx8 = fmaxf(fmaxf(fmaxf(sa[0], sa[1]), fmaxf(sa[2], sa[3])), fmaxf(fmaxf(sb[0], sb[1]), fmaxf(sb[2], sb[3])));
    const float nx8 = fmaxf(fmaxf(fmaxf(ta[0], ta[1]), fmaxf(ta[2], ta[3])), fmaxf(fmaxf(tb[0], tb[1]), fmaxf(tb[2], tb[3])));
    if (__builtin_amdgcn_ballot_w64(mx8 > m + 8.f || nx8 > m2 + 8.f) != 0ull) {
        float mx = fmaxf(mx8, __shfl_xor(mx8, 16)); mx = fmaxf(mx, __shfl_xor(mx, 32));
        float nx = fmaxf(nx8, __shfl_xor(nx8, 16)); nx = fmaxf(nx, __shfl_xor(nx, 32));
        const float mn = fmaxf(m, mx), alpha = __builtin_amdgcn_exp2f(m - mn); m = mn; lsum *= alpha;
        const float nn = fmaxf(m2, nx), beta = __builtin_amdgcn_exp2f(m2 - nn); m2 = nn; l2 *= beta;
#pragma unroll
        for (int dt = 0; dt < 4; ++dt) { o[dt] = o[dt] * alpha; o2[dt] = o2[dt] * beta; }
    }
    float p[8], q[8];
#pragma unroll
    for (int i = 0; i < 4; ++i) { p[i] = __builtin_amdgcn_exp2f(sa[i] - m); p[4 + i] = __builtin_amdgcn_exp2f(sb[i] - m); q[i] = __builtin_amdgcn_exp2f(ta[i] - m2); q[4 + i] = __builtin_amdgcn_exp2f(tb[i] - m2); }
    lsum += ((p[0] + p[1]) + (p[2] + p[3])) + ((p[4] + p[5]) + (p[6] + p[7]));
    l2 += ((q[0] + q[1]) + (q[2] + q[3])) + ((q[4] + q[5]) + (q[6] + q[7]));
    u32x4 pw; pw.x = pg8::cvt_pk_bf16(p[0], p[1]); pw.y = pg8::cvt_pk_bf16(p[2], p[3]); pw.z = pg8::cvt_pk_bf16(p[4], p[5]); pw.w = pg8::cvt_pk_bf16(p[6], p[7]);
    u32x4 qw; qw.x = pg8::cvt_pk_bf16(q[0], q[1]); qw.y = pg8::cvt_pk_bf16(q[2], q[3]); qw.z = pg8::cvt_pk_bf16(q[4], q[5]); qw.w = pg8::cvt_pk_bf16(q[6], q[7]);
    const bf16x8 pf = __builtin_bit_cast(bf16x8, pw), qf = __builtin_bit_cast(bf16x8, qw);
#pragma unroll
    for (int dt = 0; dt < 4; ++dt) { o[dt] = __builtin_amdgcn_mfma_f32_16x16x32_bf16(vf[dt], pf, o[dt], 0, 0, 0); o2[dt] = __builtin_amdgcn_mfma_f32_16x16x32_bf16(vf2[dt], qf, o2[dt], 0, 0, 0); }
}
__device__ __forceinline__ void qk_tiles(const bf16x8 a0, const bf16x8 a1, const bf16x8 b0, const bf16x8 b1, const bf16x8 (&qf)[2], f32x4& sa, f32x4& sb) {
    sa = (f32x4){0.f, 0.f, 0.f, 0.f}; sb = (f32x4){0.f, 0.f, 0.f, 0.f};
    sa = __builtin_amdgcn_mfma_f32_16x16x32_bf16(a0, qf[0], sa, 0, 0, 0); sa = __builtin_amdgcn_mfma_f32_16x16x32_bf16(a1, qf[1], sa, 0, 0, 0);
    sb = __builtin_amdgcn_mfma_f32_16x16x32_bf16(b0, qf[0], sb, 0, 0, 0); sb = __builtin_amdgcn_mfma_f32_16x16x32_bf16(b1, qf[1], sb, 0, 0, 0);
}
__device__ __forceinline__ void attn_stage_kv(LAS unsigned char* lds, const bf16_t* ksrc, int krs, const bf16_t* vsrc, int tid) {
    LAS bf16_t* kl = (LAS bf16_t*)lds; LAS bf16_t* vl = (LAS bf16_t*)(lds + ATT_V_OFF);
    bf16x8 kr[4], vr[4];
#pragma unroll
    for (int i = 0; i < 4; ++i) { const int c = tid + NWAVES * 64 * i, row = c >> 3, part = c & 7; kr[i] = ldg8(ksrc + (size_t)row * krs + part * 8); }
#pragma unroll
    for (int i = 0; i < 4; ++i) { const int c = tid + NWAVES * 64 * i, d = c >> 5, part = c & 31; vr[i] = ldg8(vsrc + (size_t)d * 256 + part * 8); }
#pragma unroll
    for (int i = 0; i < 4; ++i) { const int c = tid + NWAVES * 64 * i, row = c >> 3, part = c & 7; *(LAS bf16x8*)(kl + row * AK_STRIDE + part * 8) = kr[i]; }
#pragma unroll
    for (int i = 0; i < 4; ++i) { const int c = tid + NWAVES * 64 * i, d = c >> 5, part = c & 31; *(LAS bf16x8*)(vl + d * AV_STRIDE + part * 8) = vr[i]; }
}
__device__ __forceinline__ void attn_lds_logits(const LAS unsigned char* lds, int k0, const bf16x8 (&qf)[2], f32x4& sa, f32x4& sb, bf16x8 (&vf)[4], int r, int q4) {
    const LAS bf16_t* ka = (const LAS bf16_t*)lds + (k0 + 8 * (r >> 2) + (r & 3)) * AK_STRIDE + 8 * q4;
    const LAS bf16_t* vl = (const LAS bf16_t*)(lds + ATT_V_OFF) + r * AV_STRIDE + 8 * q4 + k0;
    const bf16x8 a0 = *(const LAS bf16x8*)ka, a1 = *(const LAS bf16x8*)(ka + 32), b0 = *(const LAS bf16x8*)(ka + 4 * AK_STRIDE), b1 = *(const LAS bf16x8*)(ka + 4 * AK_STRIDE + 32);
#pragma unroll
    for (int dt = 0; dt < 4; ++dt) vf[dt] = *(const LAS bf16x8*)(vl + dt * 16 * AV_STRIDE);
    qk_tiles(a0, a1, b0, b1, qf, sa, sb);
    sa = sa * QK_SCALE_LOG2E; sb = sb * QK_SCALE_LOG2E;
}
__device__ __forceinline__ void attn_lds_block(const LAS unsigned char* lds, int k0, const bf16x8 (&qf)[2], float& m, float& lsum, f32x4 (&o)[4], int r, int q4) {
    const LAS bf16_t* ka = (const LAS bf16_t*)lds + (k0 + 8 * (r >> 2) + (r & 3)) * AK_STRIDE + 8 * q4;
    const LAS bf16_t* vl = (const LAS bf16_t*)(lds + ATT_V_OFF) + r * AV_STRIDE + 8 * q4 + k0;
    const bf16x8 a0 = *(const LAS bf16x8*)ka, a1 = *(const LAS bf16x8*)(ka + 32), b0 = *(const LAS bf16x8*)(ka + 4 * AK_STRIDE), b1 = *(const LAS bf16x8*)(ka + 4 * AK_STRIDE + 32);
    bf16x8 vf[4];
#pragma unroll
    for (int dt = 0; dt < 4; ++dt) vf[dt] = *(const LAS bf16x8*)(vl + dt * 16 * AV_STRIDE);
    f32x4 sa, sb; qk_tiles(a0, a1, b0, b1, qf, sa, sb);
    sa = sa * QK_SCALE_LOG2E; sb = sb * QK_SCALE_LOG2E;
    softmax_pv_step(sa, sb, m, lsum, o, vf);
}
__device__ __forceinline__ void attn_merge(float& m, float& lsum, f32x4 (&o)[4], const float m2, const float l2, const f32x4 (&o2)[4]) {
    const float mn = fmaxf(m, m2), fa = __builtin_amdgcn_exp2f(m - mn), fb = __builtin_amdgcn_exp2f(m2 - mn);
    m = mn; lsum = lsum * fa + l2 * fb;
#pragma unroll
    for (int dt = 0; dt < 4; ++dt) o[dt] = o[dt] * fa + o2[dt] * fb;
}
__device__ __forceinline__ void attn_store(bf16_t* orow, float lsum, const f32x4 (&o)[4]) {
    lsum += __shfl_xor(lsum, 16); lsum += __shfl_xor(lsum, 32);
    const float inv = 1.f / lsum;
#pragma unroll
    for (int dt = 0; dt < 4; ++dt) { uint2 w; w.x = pg8::cvt_pk_bf16(o[dt][0] * inv, o[dt][1] * inv); w.y = pg8::cvt_pk_bf16(o[dt][2] * inv, o[dt][3] * inv); *(uint2*)(orow + 16 * dt) = w; }
}
__device__ __forceinline__ void attn_ctx_phase(LAS unsigned char* lds, int vcu, int G) {
    const int tid = tid_opaque(), lane = tid & 63, wave = __builtin_amdgcn_readfirstlane(tid >> 6), r = lane & 15, q4 = lane >> 4;
    const bf16_t* Q = (const bf16_t*)(PWS + WS_Q); const bf16_t* K = (const bf16_t*)(PWS + WS_K); const bf16_t* VT = (const bf16_t*)(PWS + WS_VT);
    bf16_t* MIX = (bf16_t*)(PWS + WS_MIX);
    for (int it = vcu; it < BATCH * NH; it += G) {
        const int h = it % NH, b = it / NH;
        static_assert(SEQ / 16 == 2 * NWAVES, "two tasks per wave");
        bf16x8 qa[2][2];
#pragma unroll
        for (int ti = 0; ti < 2; ++ti) { const size_t rq = (size_t)b * SEQ + (wave + ti * NWAVES) * 16 + r; qa[ti][0] = ldg8(Q + rq * NAW + h * HD + 8 * q4); qa[ti][1] = ldg8(Q + rq * NAW + h * HD + 32 + 8 * q4); }
        __syncthreads();
        attn_stage_kv(lds, K + (size_t)b * SEQ * NAW + h * HD, NAW, VT + (size_t)(b * NH + h) * HD * SEQ, tid);
        __syncthreads();
#pragma unroll
        for (int ti = 0; ti < 2; ++ti) {
            const int task = wave + ti * NWAVES;
            const size_t rowq = (size_t)b * SEQ + task * 16 + r;
            bf16x8 qf[2];
            qf[0] = qa[ti][0]; qf[1] = qa[ti][1];
            f32x4 o[4]; float m = -1e30f, lsum = 0.f;
#pragma unroll
            for (int dt = 0; dt < 4; ++dt) o[dt] = (f32x4){0.f, 0.f, 0.f, 0.f};
            f32x4 o2[4]; float m2 = -1e30f, l2 = 0.f;
#pragma unroll
            for (int dt = 0; dt < 4; ++dt) o2[dt] = (f32x4){0.f, 0.f, 0.f, 0.f};
#pragma unroll
            for (int i = 0; i < 4; ++i) { f32x4 sa, sb, ta, tb; bf16x8 v1[4], v2[4];
                attn_lds_logits(lds, 32 * i, qf, sa, sb, v1, r, q4); attn_lds_logits(lds, 128 + 32 * i, qf, ta, tb, v2, r, q4);
                softmax_pv_step2(sa, sb, m, lsum, o, v1, ta, tb, m2, l2, o2, v2); }
            attn_merge(m, lsum, o, m2, l2, o2);
            attn_store(MIX + rowq * D + SSMW + h * HD + 4 * q4, lsum, o);
        }
    }
    __syncthreads();
}
constexpr int NAV_STRIDE = 520, NA_WV_OFF = 512 * AK_STRIDE * 2, NA_WB_OFF = NA_WV_OFF + 64 * NAV_STRIDE * 2;
static_assert(NA_WB_OFF + 15 * 32 * 4 <= LDS_CTL_OFF && ATT_V_OFF + 64 * AV_STRIDE * 2 <= NA_WB_OFF, "NA lds map");
__device__ __forceinline__ void na_stage_window(LAS unsigned char* lds, const bf16_t* kg, const bf16_t* vg, int row0, int nrows, int tid) {
    LAS bf16_t* kl = (LAS bf16_t*)lds; LAS bf16_t* vl = (LAS bf16_t*)(lds + NA_WV_OFF);
    const int ntok = nrows * 64;
    {
        bf16x8 kr[8];
#pragma unroll
        for (int i = 0; i < 8; ++i) { const int c = tid + NWAVES * 64 * i, part = c & 7; int tok = c >> 3; tok = tok < ntok ? tok : ntok - 1; kr[i] = ldg8(kg + (size_t)(row0 * GW + tok) * NAW + part * 8); }
#pragma unroll
        for (int i = 0; i < 8; ++i) { const int c = tid + NWAVES * 64 * i, tok = c >> 3, part = c & 7; if (tok < ntok) *(LAS bf16x8*)(kl + tok * AK_STRIDE + part * 8) = kr[i]; }
    }
    {
        bf16x8 vr[8];
#pragma unroll
        for (int i = 0; i < 8; ++i) { const int c = tid + NWAVES * 64 * i, d = c >> 6; int part = c & 63; part = part * 8 < ntok ? part : (ntok >> 3) - 1; vr[i] = ldg8(vg + (size_t)d * DSEQ + row0 * GW + part * 8); }
#pragma unroll
        for (int i = 0; i < 8; ++i) { const int c = tid + NWAVES * 64 * i, d = c >> 6, part = c & 63; if (part * 8 < ntok) *(LAS bf16x8*)(vl + d * NAV_STRIDE + part * 8) = vr[i]; }
    }
}
__device__ __forceinline__ void attn_na_phase(LAS unsigned char* lds, int l, int vcu, int G) {
    const int tid = tid_opaque(), lane = tid & 63, wave = __builtin_amdgcn_readfirstlane(tid >> 6), r = lane & 15, q4 = lane >> 4;
    const bf16_t* Q = (const bf16_t*)(PWS + WS_Q); const bf16_t* K = (const bf16_t*)(PWS + WS_K); const bf16_t* VT = (const bf16_t*)(PWS + WS_VT);
    bf16_t* MIX = (bf16_t*)(PWS + WS_MIX);
    const float* rpb_l = PIN(27) + (size_t)l * NH * 15 * 31;
    const int koff = 8 * (r >> 2) + (r & 3);
    constexpr int NT = 2, IR = 2 * NT;
    const int nb = wave & 3, rl0 = wave >> 2;
    const int qcol = nb * 16 + r;
    int kc0 = nb * 16 - 8; kc0 = kc0 < 0 ? 0 : (kc0 > GW - 32 ? GW - 32 : kc0);
    int cs = qcol - 8; cs = cs < 0 ? 0 : (cs > GW - 16 ? GW - 16 : cs);
    int bidx[8];
#pragma unroll
    for (int i = 0; i < 8; ++i) { const int kcol = kc0 + 8 * q4 + i; const bool valid = kcol >= cs && kcol < cs + 16;
        int dc = kcol - qcol + 15; dc = dc < 0 ? 0 : (dc > 30 ? 30 : dc); bidx[i] = valid ? dc : 31; }
    for (int it = vcu; it < DB * NH * (GW / IR); it += G) {
        const int rg = it % (GW / IR), h = (it / (GW / IR)) % NH, b = it / ((GW / IR) * NH);
        const int R0 = rg * IR;
        int lo = R0 - 4; lo = lo < 0 ? 0 : (lo > GW - 8 ? GW - 8 : lo);
        int hi = R0 + IR - 1 - 4; hi = (hi < 0 ? 0 : (hi > GW - 8 ? GW - 8 : hi)) + 7;
        const bf16_t* kg = K + ((size_t)MC + (size_t)b * DSEQ) * NAW + h * HD;
        const bf16_t* vg = VT + (size_t)MC * NAW + (size_t)(b * NH + h) * HD * DSEQ;
        const bf16_t* qbase = Q + ((size_t)MC + (size_t)b * DSEQ + (R0 + rl0) * GW + qcol) * NAW + h * HD + 8 * q4;
        bf16x8 qa[NT][2];
#pragma unroll
        for (int t = 0; t < NT; ++t) { qa[t][0] = ldg8(qbase + (size_t)t * 2 * GW * NAW); qa[t][1] = ldg8(qbase + (size_t)t * 2 * GW * NAW + 32); }
        __syncthreads();
        attn_stage_kv(lds, (const bf16_t*)(PWS + WS_CK) + (((size_t)l * DB + b) * NH + h) * PAST * HD, HD, (const bf16_t*)(PWS + WS_CVT) + (((size_t)l * DB + b) * NH + h) * HD * PAST, tid);
        if (tid < 15 * 32) { const int dr = tid >> 5, dc = tid & 31; ((LAS float*)(lds + NA_WB_OFF))[tid] = dc < 31 ? rpb_l[(size_t)h * 15 * 31 + dr * 31 + dc] * 1.4426950408889634f : -1e30f; }
        __syncthreads();
        f32x4 o[NT][4]; float m[NT], ls[NT];
#pragma unroll
        for (int t = 0; t < NT; ++t) {
            bf16x8 qf[2]; qf[0] = qa[t][0]; qf[1] = qa[t][1];
            m[t] = -1e30f; ls[t] = 0.f;
#pragma unroll
            for (int dt = 0; dt < 4; ++dt) o[t][dt] = (f32x4){0.f, 0.f, 0.f, 0.f};
#pragma unroll 2
            for (int k0 = 0; k0 < PAST; k0 += 32) { f32x4 sa, sb; bf16x8 v1[4];
                attn_lds_logits(lds, k0, qf, sa, sb, v1, r, q4);
                softmax_pv_step(sa, sb, m[t], ls[t], o[t], v1); }
            __builtin_amdgcn_sched_barrier(0);
        }
        const LAS float* btab = (const LAS float*)(lds + NA_WB_OFF);
#pragma unroll 1
        for (int pass = 0; pass < 2; ++pass) {
            const int base = lo + 8 * pass, nrows = pass == 0 ? 8 : hi - (lo + 8) + 1;
            __syncthreads();
            na_stage_window(lds, kg, vg, base, nrows, tid);
            __syncthreads();
#pragma unroll
            for (int t = 0; t < NT; ++t) {
                const int row = R0 + rl0 + 2 * t;
                bf16x8 qf[2]; qf[0] = qa[t][0]; qf[1] = qa[t][1];
                int rs = row - 4; rs = rs < 0 ? 0 : (rs > GW - 8 ? GW - 8 : rs);
#pragma unroll 1
                for (int sl = 0; sl < nrows; ++sl) {
                    const int wr = base + sl;
                    if (wr < rs || wr >= rs + 8) continue;
                    const LAS bf16_t* ka = (const LAS bf16_t*)lds + (sl * GW + kc0 + koff) * AK_STRIDE + 8 * q4;
                    const LAS bf16_t* vl = (const LAS bf16_t*)(lds + NA_WV_OFF) + r * NAV_STRIDE + sl * GW + kc0 + 8 * q4;
                    const bf16x8 a0 = *(const LAS bf16x8*)ka, a1 = *(const LAS bf16x8*)(ka + 32), b0 = *(const LAS bf16x8*)(ka + 4 * AK_STRIDE), b1 = *(const LAS bf16x8*)(ka + 4 * AK_STRIDE + 32);
                    bf16x8 vf[4];
#pragma unroll
                    for (int dt = 0; dt < 4; ++dt) vf[dt] = *(const LAS bf16x8*)(vl + dt * 16 * NAV_STRIDE);
                    f32x4 sa, sb; qk_tiles(a0, a1, b0, b1, qf, sa, sb);
                    const LAS float* brow = btab + (wr - row + 7) * 32;
#pragma unroll
                    for (int i = 0; i < 4; ++i) { sa[i] = fmaf(sa[i], QK_SCALE_LOG2E, brow[bidx[i]]); sb[i] = fmaf(sb[i], QK_SCALE_LOG2E, brow[bidx[4 + i]]); }
                    softmax_pv_step(sa, sb, m[t], ls[t], o[t], vf);
                }
                __builtin_amdgcn_sched_barrier(0);
            }
        }
#pragma unroll
        for (int t = 0; t < NT; ++t) {
            const size_t rowq = (size_t)MC + (size_t)b * DSEQ + (R0 + rl0 + 2 * t) * GW + qcol;
            attn_store(MIX + rowq * D + SSMW + h * HD + 4 * q4, ls[t], o[t]);
        }
    }
    __syncthreads();
}
constexpr int GT_STRIDE = 136;
__device__ __forceinline__ void gate_phase(LAS unsigned char* lds, int l, int first, int stride) {
    const int tid = tid_opaque(), lane = tid & 63, wave = __builtin_amdgcn_readfirstlane(tid >> 6), r = lane & 15, q4 = lane >> 4;
    LAS bf16_t* vt = (LAS bf16_t*)lds;
    const bf16_t* VG = (const bf16_t*)(PWS + WS_VG); const bf16_t* U = (const bf16_t*)(PWS + WS_U);
    const bf16_t* wsb = (const bf16_t*)(PWS + WS_WSB) + (size_t)l * 4 * 128 * 128;
    const float* bs = PIN(29) + (size_t)l * 4 * 128;
    bf16_t* MIX = (bf16_t*)(PWS + WS_MIX);
    for (int it = first; it < MT / 128; it += stride) {
        const size_t base = (size_t)it * 128;
        const int i = wave * 16 + r;
        bf16x8 bfrag[4][4];
#pragma unroll
        for (int g = 0; g < 4; ++g)
#pragma unroll
            for (int ks = 0; ks < 4; ++ks) bfrag[g][ks] = ldg8(wsb + ((size_t)g * 128 + i) * 128 + 8 * q4 + 32 * ks);
        uint2 uu[4][4]; float bsv[4];
#pragma unroll
        for (int g = 0; g < 4; ++g) { bsv[g] = bs[g * 128 + i];
#pragma unroll
            for (int ct = 0; ct < 4; ++ct) uu[g][ct] = *(const uint2*)(U + (base + i) * GMW + g * 64 + ct * 16 + 4 * q4); }
        __syncthreads();
        {
            const int t = tid >> 2, qc = tid & 3;
            const u32x4* vr = (const u32x4*)(VG + (base + t) * GMW + 64 * qc);
            u32x4 raw[8];
#pragma unroll
            for (int j = 0; j < 8; ++j) raw[j] = vr[j];
            float x[64]; float sm = 0.f;
#pragma unroll
            for (int j = 0; j < 8; ++j)
#pragma unroll
                for (int e = 0; e < 4; ++e) { x[8 * j + 2 * e] = __uint_as_float(raw[j][e] << 16); x[8 * j + 2 * e + 1] = __uint_as_float(raw[j][e] & 0xffff0000u); sm += x[8 * j + 2 * e] + x[8 * j + 2 * e + 1]; }
            sm += __shfl_xor(sm, 1); sm += __shfl_xor(sm, 2);
            const float mean = sm * (1.f / GMW);
            float sq = 0.f;
#pragma unroll
            for (int c = 0; c < 64; ++c) { x[c] -= mean; sq += x[c] * x[c]; }
            sq += __shfl_xor(sq, 1); sq += __shfl_xor(sq, 2);
            const float rstd = rsqrtf(sq * (1.f / GMW) + 1e-5f);
#pragma unroll
            for (int c = 0; c < 64; ++c) vt[(64 * qc + c) * GT_STRIDE + t] = f2bf(x[c] * rstd);
        }
        __syncthreads();
#pragma unroll
        for (int g = 0; g < 4; ++g) {
            f32x4 acc[4];
#pragma unroll
            for (int ct = 0; ct < 4; ++ct) acc[ct] = (f32x4){0.f, 0.f, 0.f, 0.f};
#pragma unroll
            for (int ks = 0; ks < 4; ++ks)
#pragma unroll
                for (int ct = 0; ct < 4; ++ct) {
                    const bf16x8 afrag = *(const LAS bf16x8*)(vt + (g * 64 + ct * 16 + r) * GT_STRIDE + 32 * ks + 8 * q4);
                    acc[ct] = __builtin_amdgcn_mfma_f32_16x16x32_bf16(afrag, bfrag[g][ks], acc[ct], 0, 0, 0);
                }
#pragma unroll
            for (int ct = 0; ct < 4; ++ct) {
                const int ch = g * 64 + ct * 16 + 4 * q4;
                const float u0 = __uint_as_float(uu[g][ct].x << 16), u1 = __uint_as_float(uu[g][ct].x & 0xffff0000u), u2 = __uint_as_float(uu[g][ct].y << 16), u3 = __uint_as_float(uu[g][ct].y & 0xffff0000u);
                uint2 w; w.x = pg8::cvt_pk_bf16(u0 * (acc[ct][0] + bsv[g]), u1 * (acc[ct][1] + bsv[g])); w.y = pg8::cvt_pk_bf16(u2 * (acc[ct][2] + bsv[g]), u3 * (acc[ct][3] + bsv[g]));
                *(uint2*)(MIX + (base + i) * D + SSMW + NAW + ch) = w;
            }
        }
    }
    __syncthreads();
}
constexpr int CH = 64, NCHUNK = MT / CH;
constexpr int BU_STRIDE = 132, SB_STRIDE = 136, YB_STRIDE = 264;
constexpr int SSM_WAVE_BYTES = 16 * BU_STRIDE * 4 + 16 * SB_STRIDE * 2, SSM_YB_OFF = NWAVES * SSM_WAVE_BYTES;
static_assert(SSM_WAVE_BYTES % 16 == 0 && SSM_YB_OFF + CH * YB_STRIDE * 2 <= LDS_CTL_OFF, "ssm lds map");
__device__ __forceinline__ float2 cmul(float2 a, float2 b) { return make_float2(a.x * b.x - a.y * b.y, a.x * b.y + a.y * b.x); }
__device__ __forceinline__ float2 cfma(float2 a, float2 b, float2 c) { return make_float2(fmaf(a.x, b.x, fmaf(-a.y, b.y, c.x)), fmaf(a.x, b.y, fmaf(a.y, b.x, c.y))); }
__device__ __forceinline__ void ssm_load_bm(bf16x8 (&bm)[8], const bf16x8* BMFg, int lane) {
#pragma unroll
    for (int tau = 0; tau < 8; ++tau) bm[tau] = BMFg[tau * 64 + lane];
}
__device__ __forceinline__ bf16x8 ssm_cvt_u(const f32x4 a, const f32x4 b, int q4) {
    const float u[8] = {a[0], a[1], a[2], a[3], b[0], b[1], b[2], b[3]};
    u32x4 w; unsigned ww[4];
#pragma unroll
    for (int i = 0; i < 4; ++i) {
        const unsigned hp = pg8::cvt_pk_bf16(u[2 * i], u[2 * i + 1]);
        const unsigned lp = pg8::cvt_pk_bf16(u[2 * i] - __uint_as_float(hp << 16), u[2 * i + 1] - __uint_as_float(hp & 0xffff0000u));
        ww[i] = (q4 & 2) ? lp : hp;
    }
    w.x = ww[0]; w.y = ww[1]; w.z = ww[2]; w.w = ww[3];
    return __builtin_bit_cast(bf16x8, w);
}
__device__ __forceinline__ bf16x8 ssm_load_u(const float* XS, size_t trow0, int g, int r, int q4) {
    const f32x4* src = (const f32x4*)(XS + (trow0 + r) * SSMW + g * SC + 8 * (q4 & 1));
    return ssm_cvt_u(src[0], src[1], q4);
}
__device__ __forceinline__ void ssm_bu_to_lds(LAS float* bul, const bf16x8 (&bm)[8], const bf16x8 uf, int r, int q4) {
#pragma unroll
    for (int tau = 0; tau < 8; ++tau) {
        const f32x4 d = __builtin_amdgcn_mfma_f32_16x16x32_bf16(bm[tau], uf, (f32x4){0.f, 0.f, 0.f, 0.f}, 0, 0, 0);
        *(LAS f32x4*)(bul + r * BU_STRIDE + 16 * tau + 4 * q4) = d;
    }
}
template <int DIR> __device__ __forceinline__ float2 ssm_dir_a(const bf16x8 (&uf)[4], LAS float* bul, const float2* LB, int l, int g, int lane, int r, int q4) {
    constexpr int d = DIR;
    const int pbase = ((l * 2 + d) * SG + g) * SP;
    const float2 lb = LB[pbase + lane];
    bf16x8 bm[8]; ssm_load_bm(bm, (const bf16x8*)(PWS + WS_BMF) + (size_t)((l * 2 + d) * SG + g) * 8 * 64, lane);
    float2 s = make_float2(0.f, 0.f);
    const LAS float* brd = bul + 2 * lane;
#pragma unroll
    for (int si = 0; si < 4; ++si) {
        ssm_bu_to_lds(bul, bm, uf[d ? 3 - si : si], r, q4);
#pragma unroll
        for (int step = 0; step < 16; ++step) { const f32x2 bv2 = *(const LAS f32x2*)(brd + (d ? 15 - step : step) * BU_STRIDE); s = cfma(lb, s, make_float2(bv2[0], bv2[1])); }
    }
    return s;
}
__device__ __forceinline__ void ssm_pass_a(LAS unsigned char* lds, int l, int vcu, int G) {
    const int tid = tid_opaque(), lane = tid & 63, wave = __builtin_amdgcn_readfirstlane(tid >> 6), r = lane & 15, q4 = lane >> 4;
    LAS float* bul = (LAS float*)(lds + wave * SSM_WAVE_BYTES);
    const float* XS = (const float*)(PWS + WS_XSSM);
    const float2* LB = (const float2*)(PWS + WS_SSMP);
    float2* E = (float2*)(PWS + WS_E);
    for (int ci = vcu; ci < NCHUNK; ci += G) {
        bf16x8 uf[2][4];
        {
            f32x4 ur[2][4][2];
#pragma unroll
            for (int gi = 0; gi < 2; ++gi)
#pragma unroll
                for (int sub = 0; sub < 4; ++sub) { const f32x4* src = (const f32x4*)(XS + ((size_t)ci * CH + sub * 16 + r) * SSMW + (wave * 2 + gi) * SC + 8 * (q4 & 1)); ur[gi][sub][0] = src[0]; ur[gi][sub][1] = src[1]; }
#pragma unroll
            for (int gi = 0; gi < 2; ++gi)
#pragma unroll
                for (int sub = 0; sub < 4; ++sub) uf[gi][sub] = ssm_cvt_u(ur[gi][sub][0], ur[gi][sub][1], q4);
        }
        float2 se[2][2];
        se[0][0] = ssm_dir_a<0>(uf[0], bul, LB, l, wave * 2 + 0, lane, r, q4);
        se[0][1] = ssm_dir_a<1>(uf[0], bul, LB, l, wave * 2 + 0, lane, r, q4);
        se[1][0] = ssm_dir_a<0>(uf[1], bul, LB, l, wave * 2 + 1, lane, r, q4);
        se[1][1] = ssm_dir_a<1>(uf[1], bul, LB, l, wave * 2 + 1, lane, r, q4);
#pragma unroll
        for (int gi = 0; gi < 2; ++gi)
#pragma unroll
            for (int d = 0; d < 2; ++d) E[((size_t)ci * 2 + d) * SG * SP + (wave * 2 + gi) * SP + lane] = se[gi][d];
    }
}
__device__ __forceinline__ void ssm_carry(int l, int vcu, int G) {
    const int tid = tid_opaque(), lane = tid & 63, wave = __builtin_amdgcn_readfirstlane(tid >> 6);
    const float2* LB = (const float2*)(PWS + WS_SSMP);
    const float2* E = (const float2*)(PWS + WS_E); float2* SIN = (float2*)(PWS + WS_SIN);
    const float* st0 = PIN(5);
    for (int wi = wave * G + vcu; wi < (BATCH + DB) * 2 * SG; wi += G * NWAVES) {
        const bool lat = wi < DB * 2 * SG;
        const int w2 = lat ? wi : wi - DB * 2 * SG, g = w2 % SG, d = (w2 / SG) & 1, sq = w2 / (2 * SG);
        const int nC = lat ? DSEQ / CH : SEQ / CH, cbase = lat ? MC / CH + sq * (DSEQ / CH) : sq * (SEQ / CH);
        float2 lt = LB[((l * 2 + d) * SG + g) * SP + lane];
#pragma unroll
        for (int i = 0; i < 6; ++i) lt = cmul(lt, lt);
        float2 s = make_float2(0.f, 0.f);
        if (lat) { const float* st = st0 + (((((size_t)sq * DEPTH + l) * 2 + d) * SG + g) * SP + lane) * 2; s = make_float2(st[0], st[1]); }
        const size_t off = (size_t)d * SG * SP + g * SP + lane, cs = (size_t)2 * SG * SP;
        if (lat) {
#pragma unroll 1
            for (int k0 = 0; k0 < DSEQ / CH; k0 += 32) {
                float2 e[32];
#pragma unroll
                for (int k = 0; k < 32; ++k) e[k] = E[(size_t)(cbase + (d ? DSEQ / CH - 1 - (k0 + k) : k0 + k)) * cs + off];
#pragma unroll
                for (int k = 0; k < 32; ++k) { SIN[(size_t)(cbase + (d ? DSEQ / CH - 1 - (k0 + k) : k0 + k)) * cs + off] = s; s = cfma(lt, s, e[k]); }
            }
        } else {
            float2 e[SEQ / CH];
#pragma unroll
            for (int k = 0; k < SEQ / CH; ++k) e[k] = E[(size_t)(cbase + (d ? SEQ / CH - 1 - k : k)) * cs + off];
#pragma unroll
            for (int k = 0; k < SEQ / CH; ++k) { SIN[(size_t)(cbase + (d ? SEQ / CH - 1 - k : k)) * cs + off] = s; s = cfma(lt, s, e[k]); }
        }
    }
}
template <int DIR> __device__ __forceinline__ float2 ssm_dir_b(f32x4 (&yg)[4], const bf16x8 (&uf)[4], LAS float* bul, LAS bf16_t* sbw, const float2* LB, const float2* SIN,
                                                          int l, int g, int ci, int lane, int r, int q4) {
    constexpr int d = DIR;
    const int pbase = ((l * 2 + d) * SG + g) * SP;
    const float2 lb = LB[pbase + lane];
    float2 s = SIN[((size_t)ci * 2 + d) * SG * SP + g * SP + lane];
    bf16x8 bm[8]; ssm_load_bm(bm, (const bf16x8*)(PWS + WS_BMF) + (size_t)((l * 2 + d) * SG + g) * 8 * 64, lane);
    bf16x8 cf[4];
    { const bf16x8* cff = (const bf16x8*)(PWS + WS_CFF) + (size_t)((l * 2 + d) * SG + g) * 4 * 64 + lane;
#pragma unroll
      for (int ks = 0; ks < 4; ++ks) cf[ks] = cff[ks * 64]; }
    const LAS float* brd = bul + 2 * lane; LAS bf16_t* swr = sbw + 2 * lane; const LAS bf16_t* srd = sbw + r * SB_STRIDE + 8 * q4;
#pragma unroll
    for (int si = 0; si < 4; ++si) {
        constexpr int dummy = 0; (void)dummy;
        const int sub = d ? 3 - si : si;
        ssm_bu_to_lds(bul, bm, uf[sub], r, q4);
        f32x2 buv[16];
#pragma unroll
        for (int step = 0; step < 16; ++step) buv[step] = *(const LAS f32x2*)(brd + (d ? 15 - step : step) * BU_STRIDE);
#pragma unroll
        for (int step = 0; step < 16; ++step) { s = cfma(lb, s, make_float2(buv[step][0], buv[step][1]));
            *(LAS unsigned*)(swr + (d ? 15 - step : step) * SB_STRIDE) = pg8::cvt_pk_bf16(s.x, s.y); }
#pragma unroll
        for (int ks = 0; ks < 4; ++ks) {
            const bf16x8 sf = *(const LAS bf16x8*)(srd + 32 * ks);
            yg[sub] = __builtin_amdgcn_mfma_f32_16x16x32_bf16(cf[ks], sf, yg[sub], 0, 0, 0);
        }
    }
    return s;
}
__device__ __forceinline__ void ssm_group_b(f32x4 (&yg)[4], float2 (&sfin)[2], const bf16x8 (&uf)[4], const f32x4 (&us)[4], LAS float* bul, LAS bf16_t* sbw, LAS bf16_t* yb, const float2* LB, const float2* SIN,
                                            int l, int g, int ci, int lane, int r, int q4) {
#pragma unroll
    for (int s = 0; s < 4; ++s) yg[s] = (f32x4){0.f, 0.f, 0.f, 0.f};
    const f32x4 dv = *(const f32x4*)(PIN(22) + l * SSMW + g * SC + 4 * q4);
    sfin[0] = ssm_dir_b<0>(yg, uf, bul, sbw, LB, SIN, l, g, ci, lane, r, q4);
    sfin[1] = ssm_dir_b<1>(yg, uf, bul, sbw, LB, SIN, l, g, ci, lane, r, q4);
#pragma unroll
    for (int sub = 0; sub < 4; ++sub) {
        const int t = sub * 16 + r;
#pragma unroll
        for (int i = 0; i < 4; ++i) yg[sub][i] = pg8::gelu_fast(fmaf(dv[i], us[sub][i], yg[sub][i]));
        u32x2 w; w[0] = pg8::cvt_pk_bf16(yg[sub][0], yg[sub][1]); w[1] = pg8::cvt_pk_bf16(yg[sub][2], yg[sub][3]);
        *(LAS u32x2*)(yb + t * YB_STRIDE + g * SC + 4 * q4) = w;
    }
}
__device__ __forceinline__ void ssm_pass_b(LAS unsigned char* lds, int l, int vcu, int G) {
    const int tid = tid_opaque(), lane = tid & 63, wave = __builtin_amdgcn_readfirstlane(tid >> 6), r = lane & 15, q4 = lane >> 4;
    LAS float* bul = (LAS float*)(lds + wave * SSM_WAVE_BYTES);
    LAS bf16_t* sbw = (LAS bf16_t*)(lds + wave * SSM_WAVE_BYTES + 16 * BU_STRIDE * 4);
    LAS bf16_t* yb = (LAS bf16_t*)(lds + SSM_YB_OFF);
    const float* XS = (const float*)(PWS + WS_XSSM);
    const float2* LB = (const float2*)(PWS + WS_SSMP); const float2* BB = (const float2*)(PWS + WS_SSMP + 64 * 1024);
    const float2* SIN = (const float2*)(PWS + WS_SIN);
    const bf16_t* glt = (const bf16_t*)(PWS + WS_GLT) + (size_t)l * SSMW * SSMW;
    bf16_t* MIX = (bf16_t*)(PWS + WS_MIX);
    for (int ci = vcu; ci < NCHUNK; ci += G) {
        const bool lat = ci >= MC / CH;
        const int sq = lat ? (ci - MC / CH) / (DSEQ / CH) : ci / (SEQ / CH);
        const int nC = lat ? DSEQ / CH : SEQ / CH, cbase = lat ? MC / CH + sq * (DSEQ / CH) : sq * (SEQ / CH), k = ci - cbase;
        __syncthreads();
        bf16x8 uf[2][4]; f32x4 us[2][4];
        {
            f32x4 ur[2][4][2];
#pragma unroll
            for (int gi = 0; gi < 2; ++gi)
#pragma unroll
                for (int sub = 0; sub < 4; ++sub) { const f32x4* src = (const f32x4*)(XS + ((size_t)ci * CH + sub * 16 + r) * SSMW + (wave * 2 + gi) * SC + 8 * (q4 & 1)); ur[gi][sub][0] = src[0]; ur[gi][sub][1] = src[1]; }
#pragma unroll
            for (int gi = 0; gi < 2; ++gi)
#pragma unroll
                for (int sub = 0; sub < 4; ++sub) us[gi][sub] = *(const f32x4*)(XS + ((size_t)ci * CH + sub * 16 + r) * SSMW + (wave * 2 + gi) * SC + 4 * q4);
#pragma unroll
            for (int gi = 0; gi < 2; ++gi)
#pragma unroll
                for (int sub = 0; sub < 4; ++sub) uf[gi][sub] = ssm_cvt_u(ur[gi][sub][0], ur[gi][sub][1], q4);
        }
        f32x4 yg0[4], yg1[4]; float2 sf0[2], sf1[2];
        ssm_group_b(yg0, sf0, uf[0], us[0], bul, sbw, yb, LB, SIN, l, wave * 2 + 0, ci, lane, r, q4);
        ssm_group_b(yg1, sf1, uf[1], us[1], bul, sbw, yb, LB, SIN, l, wave * 2 + 1, ci, lane, r, q4);
        const float* gb = PIN(24) + l * SSMW;
        bf16x8 af[8][2];
#pragma unroll
        for (int ks = 0; ks < 8; ++ks)
#pragma unroll
            for (int a = 0; a < 2; ++a) af[ks][a] = ldg8(glt + (size_t)(wave * 32 + a * 16 + r) * SSMW + 32 * ks + 8 * q4);
        f32x4 gbv[2];
#pragma unroll
        for (int a = 0; a < 2; ++a) gbv[a] = *(const f32x4*)(gb + wave * 32 + a * 16 + 4 * q4);
        __syncthreads();
        f32x4 z[2][4];
#pragma unroll
        for (int a = 0; a < 2; ++a)
#pragma unroll
            for (int b = 0; b < 4; ++b) z[a][b] = (f32x4){0.f, 0.f, 0.f, 0.f};
#pragma unroll
        for (int ks = 0; ks < 8; ++ks) {
            bf16x8 bfv[4];
#pragma unroll
            for (int b = 0; b < 4; ++b) bfv[b] = *(const LAS bf16x8*)(yb + (b * 16 + r) * YB_STRIDE + 32 * ks + 8 * q4);
#pragma unroll
            for (int a = 0; a < 2; ++a)
#pragma unroll
                for (int b = 0; b < 4; ++b) z[a][b] = __builtin_amdgcn_mfma_f32_16x16x32_bf16(af[ks][a], bfv[b], z[a][b], 0, 0, 0);
        }
#pragma unroll
        for (int a = 0; a < 2; ++a) {
            const int n = wave * 32 + a * 16 + 4 * q4;
            const f32x4 bv = gbv[a];
#pragma unroll
            for (int b = 0; b < 4; ++b) {
                const f32x4 yv = a ? yg1[b] : yg0[b];
                float o[4];
#pragma unroll
                for (int i = 0; i < 4; ++i) o[i] = yv[i] * __builtin_amdgcn_rcpf(1.f + __builtin_amdgcn_exp2f(-1.4426950408889634f * (z[a][b][i] + bv[i])));
                uint2 w; w.x = pg8::cvt_pk_bf16(o[0], o[1]); w.y = pg8::cvt_pk_bf16(o[2], o[3]);
                *(uint2*)(MIX + ((size_t)ci * CH + b * 16 + r) * D + n) = w;
            }
        }
        if (!lat) {
#pragma unroll
            for (int gi = 0; gi < 2; ++gi)
#pragma unroll
                for (int d = 0; d < 2; ++d)
                    if (d ? k == 0 : k == nC - 1) { const float2 sv = gi ? sf1[d] : sf0[d];
                        float* o = POUT + O_ST + (((((size_t)sq * DEPTH + l) * 2 + d) * SG + wave * 2 + gi) * SP + lane) * 2; o[0] = sv.x; o[1] = sv.y; }
        }
    }
    __syncthreads();
}

#define XB_TMO      128
#define XB_XCNT(j)  (256  + 64 * (j))
#define XB_XSUB(j)  (1280 + 64 * (j))
#define XB_XGEN(j)  (2304 + 64 * (j))
#define XB_TOP      3328
#define XB_TOPGEN   3392
#define XCD_BAR_WORDS 3456
#define XB_SPIN_CAP (1u << 18)

__device__ __forceinline__ unsigned xb_ld(unsigned* p)              { return __hip_atomic_load(p, __ATOMIC_RELAXED, __HIP_MEMORY_SCOPE_AGENT); }
__device__ __forceinline__ unsigned xb_add(unsigned* p, unsigned v) { return __hip_atomic_fetch_add(p, v, __ATOMIC_RELAXED, __HIP_MEMORY_SCOPE_AGENT); }
__device__ __forceinline__ unsigned xb_xcc_id() { return (unsigned)__builtin_amdgcn_s_getreg((3 << 11) | 20) & 0xFu; }
#define XB_SPIN(cond, bar) do { unsigned _sp = 0; while (cond) { __builtin_amdgcn_s_sleep(1); \
    if ((++_sp & 255u) == 0u) { if (xb_ld(&(bar)[XB_TMO])) break; if (_sp > XB_SPIN_CAP) { atomicAdd(&(bar)[XB_TMO], 1u); break; } } } } while (0)

struct XcdBarrier {
    unsigned* bar; unsigned x;
    volatile LAS unsigned* st;
};

__device__ __forceinline__ XcdBarrier xcd_barrier_post(unsigned* bar, volatile LAS unsigned* st) {
    XcdBarrier b; b.bar = bar; b.x = xb_xcc_id(); b.st = st;
    if (threadIdx.x == 0) (void)xb_add(&bar[XB_XCNT(b.x)], 1u);
    return b;
}
__device__ __forceinline__ void xcd_barrier_complete(unsigned* bar, unsigned x, unsigned& nloc, unsigned& nx) {
    const unsigned G = gridDim.x * gridDim.y * gridDim.z;
    unsigned sum, cnt, mine, sp = 0u;
    for (;;) {
        sum = 0u; cnt = 0u; mine = 0u;
#pragma unroll
        for (unsigned j = 0; j < 16; ++j) { const unsigned c = xb_ld(&bar[XB_XCNT(j)]); sum += c; cnt += (c > 0u) ? 1u : 0u; mine = (j == x) ? c : mine; }
        if (sum == G) break;
        __builtin_amdgcn_s_sleep(1);
        if ((++sp & 255u) == 0u) { if (xb_ld(&bar[XB_TMO])) break; if (sp > XB_SPIN_CAP) { atomicAdd(&bar[XB_TMO], 1u); break; } }
    }
    nloc = mine > 0u ? mine : 1u; nx = cnt > 0u ? cnt : 1u;
}

__device__ __forceinline__ void xcd_barrier(const XcdBarrier& b) {
    asm volatile("s_waitcnt vmcnt(0)" ::: "memory");
    __syncthreads();
    if (threadIdx.x == 0) {
        unsigned* bar = b.bar;
        __builtin_amdgcn_s_waitcnt(0);
        unsigned nloc = b.st[0], nx = b.st[1];
        if (nloc == 0u) { xcd_barrier_complete(bar, b.x, nloc, nx); b.st[0] = nloc; b.st[1] = nx; }
        const unsigned old = xb_add(&bar[XB_XSUB(b.x)], 1u);
        const unsigned gen = old / nloc;
        if (old + 1u == (gen + 1u) * nloc) {
            __builtin_amdgcn_fence(__ATOMIC_RELEASE, "agent");
            asm volatile("s_waitcnt vmcnt(0)" ::: "memory");
            const unsigned og = xb_add(&bar[XB_TOP], 1u);
            const unsigned tg = og / nx;
            if (og + 1u == (tg + 1u) * nx) xb_add(&bar[XB_TOPGEN], 1u);
            else XB_SPIN(xb_ld(&bar[XB_TOPGEN]) == tg, bar);
            __builtin_amdgcn_fence(__ATOMIC_ACQUIRE, "agent");
            xb_add(&bar[XB_XGEN(b.x)], 1u);
            asm volatile("s_waitcnt vmcnt(0)" ::: "memory");
        } else {
            XB_SPIN(xb_ld(&bar[XB_XGEN(b.x)]) == gen, bar);
            __builtin_amdgcn_fence(__ATOMIC_ACQUIRE, "agent");
            asm volatile("s_waitcnt vmcnt(0)" ::: "memory");
        }
    }
    __syncthreads();
}

__device__ __forceinline__ void passa_arrive(LAS unsigned char* lds, int l) {
    asm volatile("s_waitcnt vmcnt(0)" ::: "memory");
    __syncthreads();
    if (threadIdx.x == 0) {
        unsigned* ctl = (unsigned*)(PWS + WS_CTL); volatile LAS unsigned* st = (volatile LAS unsigned*)(lds + LDS_CTL_OFF);
        const unsigned nloc = st[0], x = xb_xcc_id();
        const unsigned old = xb_add(&ctl[CW_PASSA + 64 * (16 * l + (int)x)], 1u);
        if (old + 1u == nloc) { __builtin_amdgcn_fence(__ATOMIC_RELEASE, "agent"); asm volatile("s_waitcnt vmcnt(0)" ::: "memory"); xb_add(&ctl[CW_PASSA_TOP + 64 * l], 1u); }
    }
}
__device__ __forceinline__ void passa_wait(LAS unsigned char* lds, int l) {
    if (threadIdx.x == 0) {
        unsigned* ctl = (unsigned*)(PWS + WS_CTL); volatile LAS unsigned* st = (volatile LAS unsigned*)(lds + LDS_CTL_OFF);
        const unsigned nx = st[1];
        XB_SPIN(xb_ld(&ctl[CW_PASSA_TOP + 64 * l]) < nx, ctl + CW_BAR);
        __builtin_amdgcn_fence(__ATOMIC_ACQUIRE, "agent"); asm volatile("s_waitcnt vmcnt(0)" ::: "memory");
    }
    __syncthreads();
}

#define PHASE_FN __device__ __forceinline__
PHASE_FN void ph_prologue(LAS unsigned char* lds, int vcu, int G) { prologue_phase(lds, vcu, G); }
PHASE_FN void ph_x0(int vcu, int G) { x0_phase(vcu, G); }
PHASE_FN void ph_ffn_in(LAS unsigned char* lds, int l, int second, int G, int bx) {
    unsigned char* wl = PWS + WS_W + (size_t)l * WL_STRIDE;
    pg8::Gemm g{(const bf16_t*)(PWS + WS_H), (const bf16_t*)(wl + (second ? WO_W1B : WO_W1A)), MT, 2 * FF, D};
    pg8::StaticOrder S; S.init(MT, 2 * FF, G, bx);
    pg8::EpiFfnIn E{l, second};
    pg8::gemm_phase<pg8::EpiFfnIn, pg8::StaticOrder, true, true>(lds, g, S, E);
}
PHASE_FN void ph_res(LAS unsigned char* lds, int l, int kind, int G, int bx) {
    unsigned char* wl = PWS + WS_W + (size_t)l * WL_STRIDE;
    const bool wo = kind == 1;
    pg8::Gemm g{(const bf16_t*)(PWS + (wo ? WS_MIX : WS_ACT)), (const bf16_t*)(wl + (kind == 0 ? WO_W2A : wo ? WO_WOUT : WO_W2B)), MT, D, wo ? D : FF};
    pg8::StaticOrder S; S.init(MT, D, G, bx);
    pg8::EpiRes E{l, kind};
    pg8::gemm_phase<pg8::EpiRes, pg8::StaticOrder, true, true>(lds, g, S, E);
}
PHASE_FN void ph_win(LAS unsigned char* lds, int l, int G, int bx) {
    unsigned char* wl = PWS + WS_W + (size_t)l * WL_STRIDE;
    pg8::Gemm g{(const bf16_t*)(PWS + WS_H), (const bf16_t*)(wl + WO_WIN), MT, INC, D};
    pg8::StaticOrder S; S.init(MT, INC, G, bx);
    pg8::EpiWin E{l};
    pg8::gemm_phase<pg8::EpiWin, pg8::StaticOrder, true, true>(lds, g, S, E);
}
PHASE_FN void ph_mix1(LAS unsigned char* lds, int l, int vcu, int G, int sub) {
    for (int i = 0; i <= ((sub >> 0) & 1); ++i) ssm_pass_a(lds, l, vcu, G);
    passa_arrive(lds, l);
    for (int i = 0; i <= ((sub >> 1) & 1); ++i) attn_ctx_phase(lds, vcu, G);
    for (int i = 0; i <= ((sub >> 2) & 1); ++i) attn_na_phase(lds, l, vcu, G);
    (void)sub;
    passa_wait(lds, l); ssm_carry(l, vcu, G);
}
PHASE_FN void ph_mix2(LAS unsigned char* lds, int l, int vcu, int G) {
    if (G >= 2 && NCHUNK > G && NCHUNK <= 2 * G) { const int h0 = NCHUNK - G; gate_phase(lds, l, vcu >= h0 ? vcu - h0 : MT, G - h0); }
    else gate_phase(lds, l, vcu, G);
    ssm_pass_b(lds, l, vcu, G);
}

__global__ void __launch_bounds__(NWAVES * 64, 2) mega(Params p) {
    extern __shared__ __attribute__((aligned(16))) unsigned char lds_raw[];
    LAS unsigned char* lds = (LAS unsigned char*)lds_raw;
    const int G = gridDim.x, bx = blockIdx.x;
    const int vcu = (G % 8 == 0) ? (bx % 8) * (G / 8) + bx / 8 : bx;
    {
        volatile LAS unsigned* st0 = (volatile LAS unsigned*)(lds + LDS_CTL_OFF);
        if (threadIdx.x < 16) st0[threadIdx.x] = 0u;
        __syncthreads();
        (void)xcd_barrier_post((unsigned*)(PWS + WS_CTL) + CW_BAR, st0);
    }
    for (int ph = p.ph_lo, rep = 0; ph < p.ph_hi;) {
        int Gp = G, vp = vcu, bp = bx; asm volatile("" : "+s"(Gp), "+s"(vp), "+s"(bp));
        if (ph == PH_PRO) { ph_prologue(lds, vp, Gp); }
        else if (ph == PH_X0) { ph_x0(vp, Gp); }
        else {
            const int l = (ph - 2) / PH_PER_LAYER, q = (ph - 2) % PH_PER_LAYER + 2;
            if (q == PH_F1IN) ph_ffn_in(lds, l, 0, Gp, bp);
            else if (q == PH_F2IN) ph_ffn_in(lds, l, 1, Gp, bp);
            else if (q == PH_F1OUT) ph_res(lds, l, 0, Gp, bp);
            else if (q == PH_WOUT) ph_res(lds, l, 1, Gp, bp);
            else if (q == PH_F2OUT) ph_res(lds, l, 2, Gp, bp);
            else if (q == PH_WIN) ph_win(lds, l, Gp, bp);
            else if (q == PH_MIX1) ph_mix1(lds, l, vp, Gp, p.rep_mask >> 16);
            else if (q == PH_MIX2) ph_mix2(lds, l, vp, Gp);
        }
        const int kind = ph < 2 ? ph : (ph - 2) % PH_PER_LAYER + 2;
        const bool again = rep == 0 && ((p.rep_mask >> kind) & 1);
        if (again || ph + 1 < p.ph_hi) {
            if (ph == PH_PRO) cooperative_groups::this_grid().sync();
            else { XcdBarrier bar; bar.bar = (unsigned*)(PWS + WS_CTL) + CW_BAR; bar.x = xb_xcc_id(); bar.st = (volatile LAS unsigned*)(lds + LDS_CTL_OFF); xcd_barrier(bar); }
        }
        if (again) rep = 1; else { rep = 0; ++ph; }
    }
}
}

extern "C" void kernel_launch(void* const* d_in, const int* in_sizes, int n_in, void* d_out, int out_size, void* d_ws, size_t ws_size, hipStream_t stream) {
    static int grid = 0;
    if (grid == 0) {
        if (n_in != 33 || ws_size < WS_END) { fprintf(stderr, "kernel_launch: unexpected n_in %d / ws_size %zu\n", n_in, ws_size); grid = -1; return; }
        int dev = 0, cus = 0;
        if (hipGetDevice(&dev) != hipSuccess || hipDeviceGetAttribute(&cus, hipDeviceAttributeMultiprocessorCount, dev) != hipSuccess) { grid = -1; return; }
        if (hipFuncSetAttribute((const void*)mega, hipFuncAttributeMaxDynamicSharedMemorySize, LDS_BYTES) != hipSuccess) { fprintf(stderr, "hipFuncSetAttribute failed\n"); grid = -1; return; }
        grid = cus;
    }
    if (grid < 0) return;
    Params p{};
    for (int i = 0; i < 33; ++i) p.in[i] = (const float*)d_in[i];
    p.out = (float*)d_out; p.ws = (unsigned char*)d_ws;
    p.ph_lo = 0; p.ph_hi = NPHASES; p.rep_mask = PROBE_REP_MASK;
    if (hipMemsetAsync((char*)d_ws + WS_CTL, 0, WS_MOD + (size_t)DEPTH * 5 * NMOD * D * 4, stream) != hipSuccess) { fprintf(stderr, "memset of control words failed\n"); return; }
    void* args[] = {&p};
    const hipError_t e = hipLaunchCooperativeKernel((const void*)mega, dim3(grid), dim3(NWAVES * 64), args, LDS_BYTES, stream);
    if (e != hipSuccess) fprintf(stderr, "cooperative launch failed: %s (grid %d)\n", hipGetErrorString(e), grid);
}
```

```cpp
#include <hip/hip_runtime.h>
#include <hip/hip_cooperative_groups.h>
#include <cstdio>
#include <cstdint>

typedef unsigned short bf16_t;
namespace {
constexpr int D = 1024, BATCH = 32, SEQ = 256, DEPTH = 2, DB = 4, DSEQ = 4096, PAST = 256;
constexpr int GW = 64, SSMW = 256, NAW = 512, NH = 8, HD = 64, GMW = 256, FF = 2816, NMOD = 9, INC = 2304;
constexpr int SG = 16, SC = 16, SP = 64;
constexpr int MC = BATCH * SEQ, ML = DB * DSEQ, MT = MC + ML;
constexpr size_t MiB = 1u << 20;
constexpr size_t WS_CTL = 0, WS_MOD = 1 * MiB, WS_SSMP = 2 * MiB, WS_CK = 3 * MiB, WS_CVT = 5 * MiB, WS_E = 7 * MiB;
constexpr size_t WS_WSB = 13 * MiB, WS_GLT = 13 * MiB + MiB / 2;
constexpr size_t WS_BMF = 14 * MiB, WS_CFF = 14 * MiB + MiB / 2;
constexpr size_t WS_SHW = MiB + 384 * 1024, WS_ROWSS = 15 * MiB, WS_WN = 15 * MiB + 768 * 1024;
constexpr int SHW_LAYER = 5 * (2 * 2 * FF + INC), SHW_J1 = 5 * 2 * FF, SHW_J2 = 5 * (2 * FF + INC);
constexpr size_t WS_W = 16 * MiB, WS_H = 96 * MiB, WS_ACT = 144 * MiB;
constexpr size_t WS_XSSM = 144 * MiB, WS_Q = 168 * MiB, WS_K = 192 * MiB, WS_VT = 216 * MiB, WS_U = 240 * MiB, WS_VG = 252 * MiB;
constexpr size_t WS_SIN = 264 * MiB, WS_MIX = 276 * MiB, WS_XH2B = 324 * MiB, WS_END = 332 * MiB;
constexpr size_t XH_OUT_OFF = 48 * MiB; constexpr int XH2_SPLIT_PM = 80;
constexpr size_t O_YP = 0, O_YS = (size_t)MC * D, O_CK = (size_t)MT * D, O_CV = O_CK + (size_t)BATCH * DEPTH * SEQ * NAW,
                 O_ST = O_CV + (size_t)BATCH * DEPTH * SEQ * NAW;

__device__ __forceinline__ float bf2f(bf16_t v) { return __uint_as_float(((unsigned)v) << 16); }
__device__ __forceinline__ bf16_t f2bf(float f) { unsigned u = __float_as_uint(f); return (bf16_t)((u + 0x7fffu + ((u >> 16) & 1u)) >> 16); }
__device__ __forceinline__ float silu_f(float x) { return x / (1.f + __expf(-x)); }
__device__ __forceinline__ float gelu_tanh(float x) { const float u = 0.7978845608028654f * (x + 0.044715f * x * x * x); return 0.5f * x * (1.f + tanhf(u)); }
__device__ __forceinline__ int modrow(int m) { return m < MC ? 0 : 1 + (m - MC) / DSEQ; }
__device__ __forceinline__ float wave_sum(float v) {
#pragma unroll
    for (int o = 1; o < 64; o <<= 1) v += __shfl_xor(v, o);
    return v;
}

struct Params {
    const float* in[33];
    float* out;
    unsigned char* ws;
    int ph_lo, ph_hi, rep_mask, pad;
};


template <int OFF> __device__ __forceinline__ unsigned long long karg64() {
    unsigned long long v;
    asm volatile("s_load_dwordx2 %0, %1, %2\n\ts_waitcnt lgkmcnt(0)" : "=s"(v) : "s"(__builtin_amdgcn_kernarg_segment_ptr()), "i"(OFF) : "memory");
    return v;
}
__device__ __forceinline__ int tid_opaque() { int t = threadIdx.x; asm volatile("" : "+v"(t)); return t; }
#define GASP __attribute__((address_space(1)))
#define PIN(i) ((const float*)(const GASP float*)karg64<8 * (i)>())
#define POUT ((float*)(GASP float*)karg64<8 * 33>())
#define PWS ((unsigned char*)(GASP unsigned char*)karg64<8 * 34>())
constexpr int NWAVES = 8, LDS_BYTES = 147456, LDS_CTL_OFF = LDS_BYTES - 64, CW_BAR = 4096, CW_PASSA = 1024, CW_PASSA_TOP = 3200;
constexpr size_t WL_STRIDE = 40 * MiB, WO_W1A = 0, WO_W2A = 11 * MiB, WO_WIN = 16 * MiB + MiB / 2, WO_WOUT = 21 * MiB, WO_W1B = 23 * MiB, WO_W2B = 34 * MiB;
enum { PH_PRO = 0, PH_X0 = 1, PH_F1IN = 2, PH_F1OUT, PH_WIN, PH_MIX1, PH_MIX2, PH_WOUT, PH_F2IN, PH_F2OUT, PH_PER_LAYER = 8 };
constexpr int NPHASES = 2 + DEPTH * PH_PER_LAYER;
constexpr int PROBE_REP_MASK = 0;


namespace pg8 {
#define PG8_LAS __attribute__((address_space(3)))
typedef unsigned short bf16_t;
typedef short bf16x8 __attribute__((ext_vector_type(8)));
typedef float f32x4 __attribute__((ext_vector_type(4)));
typedef unsigned u32x4 __attribute__((ext_vector_type(4)));
constexpr int BM = 256, BK = 64, HALF = 128, HTB = HALF * BK * 2  , STAGE_BYTES = 8 * HTB, NXCD = 8, WGM = 8;

__host__ __device__ __forceinline__ int lds_byte(int r, int c) { const int st = (r >> 4) * 2 + (c >> 5), rr = r & 15, cc = c & 31, ob = rr * 64 + cc * 2; return st * 1024 + (ob ^ (((ob >> 9) & 1) << 5)); }
__host__ __device__ __forceinline__ void stage_rc(int b, int& R, int& C) { const int st = b / 1024, sb = b % 1024, swz = sb ^ (((sb >> 9) & 1) << 5); R = (st >> 1) * 16 + swz / 64; C = (st & 1) * 32 + (swz % 64) / 2; }
__host__ __device__ __forceinline__ int perm32(int rho) { const int n = rho >> 4, i = rho & 15; return 8 * (i >> 2) + 4 * n + (i & 3); }

struct Unit { int pm, pn, mask; };
struct Gemm { const bf16_t* A; const bf16_t* Bt; int M, N, K; };

struct StaticOrder {
    int nM, nN, nwg, G, c;
    __host__ __device__ void init(int M, int N, int G_, int c_) { nM = M / BM; nN = N / BM; nwg = nM * nN; G = G_; c = c_; }
    __host__ __device__ bool next(int i, Unit& u) const {
        const int rfull = nwg / G, left = nwg - rfull * G;
        long L = (long)i * G + c; u.mask = 3;
        if (i == rfull && left > 0 && 2 * left <= G) { if (c >= 2 * left) return false; L = (long)i * G + (c >> 1); u.mask = 1 << (c & 1); }
        if (L >= nwg) return false;
        int wgid = (int)L; { const int q = nwg / NXCD, r = nwg % NXCD, xcd = wgid % NXCD, off = wgid / NXCD; wgid = (xcd < r ? xcd * (q + 1) : r * (q + 1) + (xcd - r) * q) + off; }
        const int nig = WGM * nN, gid = wgid / nig, fm = gid * WGM, gsz = (nM - fm) < WGM ? (nM - fm) : WGM;
        u.pm = fm + ((wgid % nig) % gsz); u.pn = (wgid % nig) / gsz; return true;
    }
    __device__ __forceinline__ void a_ready(const Unit&) const {}
    __device__ __forceinline__ void done(const Unit&) const {}
};
__device__ __forceinline__ unsigned cvt_pk_bf16(float lo, float hi) { unsigned r; asm volatile("v_cvt_pk_bf16_f32 %0, %1, %2" : "=v"(r) : "v"(lo), "v"(hi)); return r; }

__device__ __forceinline__ float silu_fast(float x) { return x * __builtin_amdgcn_rcpf(1.f + __builtin_amdgcn_exp2f(-1.4426950408889634f * x)); }
__device__ __forceinline__ float gelu_fast(float x) {
    const float u2 = 1.5957691216057308f * (x + 0.044715f * x * x * x);
    return x * __builtin_amdgcn_rcpf(1.f + __builtin_amdgcn_exp2f(-1.4426950408889634f * u2));
}
struct EpiFfnIn {
    static constexpr bool PERM = true, AFTER_DRAIN = false;
    int l, second;
    __device__ __forceinline__ void operator()(const f32x4 (&acc)[2][2][4][2], const Unit& u, int wr, int wc, int fr, int fq) const {
        asm volatile("" : "+v"(fr), "+v"(fq));
        unsigned char* ws = PWS; bf16_t* ACT = (bf16_t*)(ws + WS_ACT);
        const float* rowss = (const float*)(ws + WS_ROWSS) + (size_t)(l * 3 + (second ? 2 : 0)) * MT; const float* shw = (const float*)(ws + WS_SHW) + (size_t)l * SHW_LAYER + (second ? SHW_J2 : 0);
        const int row0 = u.pm * 256 + wr * 64 + fr, col0 = u.pn * 128 + wc * 32 + 8 * fq;
        const float* sp = shw + (size_t)modrow(u.pm * 256) * (2 * FF) + u.pn * 256 + wc * 32 + 8 * fq;
        const f32x4 sg0 = *(const f32x4*)sp, sg1 = *(const f32x4*)(sp + 4), su0 = *(const f32x4*)(sp + 128), su1 = *(const f32x4*)(sp + 132);
#pragma unroll
        for (int ai = 0; ai < 2; ++ai) if ((u.mask >> ai) & 1)
#pragma unroll
            for (int m = 0; m < 4; ++m) {
                const int row = row0 + ai * 128 + m * 16;
                const float ri = rsqrtf(rowss[row] * (1.f / D) + 1e-6f);
                const f32x4 g0 = acc[ai][0][m][0] * ri + sg0, g1 = acc[ai][0][m][1] * ri + sg1, u0 = acc[ai][1][m][0] * ri + su0, u1 = acc[ai][1][m][1] * ri + su1;
                u32x4 w;
                w.x = cvt_pk_bf16(silu_fast(g0[0]) * u0[0], silu_fast(g0[1]) * u0[1]); w.y = cvt_pk_bf16(silu_fast(g0[2]) * u0[2], silu_fast(g0[3]) * u0[3]);
                w.z = cvt_pk_bf16(silu_fast(g1[0]) * u1[0], silu_fast(g1[1]) * u1[1]); w.w = cvt_pk_bf16(silu_fast(g1[2]) * u1[2], silu_fast(g1[3]) * u1[3]);
                *(u32x4*)(ACT + (size_t)row * FF + col0) = w;
            }
    }
};
typedef _Float16 f16x8 __attribute__((ext_vector_type(8)));
typedef _Float16 f16x4 __attribute__((ext_vector_type(4)));
typedef float f32x8 __attribute__((ext_vector_type(8)));
struct EpiRes {
    static constexpr bool PERM = true, AFTER_DRAIN = false;
    int l, kind;
    __device__ __forceinline__ void operator()(const f32x4 (&acc)[2][2][4][2], const Unit& u, int wr, int wc, int fr, int fq) const {
        asm volatile("" : "+v"(fr), "+v"(fq));
        unsigned char* ws = PWS; float* X = POUT;
        const int step = l * 3 + kind;
        const bool out_f32 = step == DEPTH * 3 - 1;
        const GASP unsigned char* rp; GASP unsigned char* wp;
        if (out_f32) rp = (const GASP unsigned char*)(u.pm < XH2_SPLIT_PM ? ws + WS_W : ws + WS_XH2B - (size_t)XH2_SPLIT_PM * 256 * D * 2);
        else rp = (const GASP unsigned char*)X + XH_OUT_OFF;
        if (out_f32) wp = (GASP unsigned char*)X;
        else if (step == DEPTH * 3 - 2) wp = (GASP unsigned char*)(u.pm < XH2_SPLIT_PM ? ws + WS_W : ws + WS_XH2B - (size_t)XH2_SPLIT_PM * 256 * D * 2);
        else wp = (GASP unsigned char*)X + XH_OUT_OFF;
        const int row0 = u.pm * 256 + wr * 64 + fr, mr = modrow(u.pm * 256);
        const float fac = kind == 1 ? 1.f : 0.5f;
        const float* gate = (const float*)(ws + WS_MOD) + ((size_t)l * 5 + mr) * NMOD * D + (kind == 0 ? 2 : kind == 1 ? 5 : 8) * D;
        const int nl = kind == 2 ? l + 1 : l, nn = nl * 3 + (kind == 0 ? 1 : kind == 1 ? 2 : 0);
        const bool wn = nl < DEPTH;
        bf16_t* H = (bf16_t*)(ws + WS_H); const float* wnp = (const float*)(ws + WS_WN) + ((size_t)nn * 5 + mr) * D; float* rowss_next = (float*)(ws + WS_ROWSS) + (size_t)nn * MT;
        f32x4 ga[2], gb[2], wa[2], wb[2];
#pragma unroll
        for (int bj = 0; bj < 2; ++bj) {
            const int col = u.pn * 256 + bj * 128 + wc * 32 + 8 * fq;
            ga[bj] = *(const f32x4*)(gate + col) * fac; gb[bj] = *(const f32x4*)(gate + col + 4) * fac;
            wa[bj] = (f32x4){0.f, 0.f, 0.f, 0.f}; wb[bj] = wa[bj];
            if (wn) { wa[bj] = *(const f32x4*)(wnp + col); wb[bj] = *(const f32x4*)(wnp + col + 4); }
        }
#pragma unroll
        for (int ai = 0; ai < 2; ++ai) if ((u.mask >> ai) & 1)
#pragma unroll
            for (int m = 0; m < 4; ++m) {
                const int row = row0 + ai * 128 + m * 16;
                float ssq = 0.f;
#pragma unroll
                for (int bj = 0; bj < 2; ++bj) {
                    const size_t ro = (size_t)row * D + u.pn * 256 + bj * 128 + wc * 32 + 8 * fq;
                    f32x4 x0, x1;
                    { const f32x8 fv = __builtin_convertvector(*(const GASP f16x8*)((const GASP _Float16*)rp + ro), f32x8); x0 = fv.lo; x1 = fv.hi; }
                    x0 += ga[bj] * acc[ai][bj][m][0]; x1 += gb[bj] * acc[ai][bj][m][1];
                    if (out_f32) { GASP float* x = (GASP float*)wp + ro; *(GASP f32x4*)x = x0; *(GASP f32x4*)(x + 4) = x1; }
                    else { f32x8 fv; fv.lo = x0; fv.hi = x1; *(GASP f16x8*)((GASP _Float16*)wp + ro) = __builtin_convertvector(fv, f16x8); }
                    if (wn) {
                        ssq += ((x0[0] * x0[0] + x0[1] * x0[1]) + (x0[2] * x0[2] + x0[3] * x0[3])) + ((x1[0] * x1[0] + x1[1] * x1[1]) + (x1[2] * x1[2] + x1[3] * x1[3]));
                        const f32x4 h0 = x0 * wa[bj], h1 = x1 * wb[bj];
                        u32x4 w; w.x = cvt_pk_bf16(h0[0], h0[1]); w.y = cvt_pk_bf16(h0[2], h0[3]); w.z = cvt_pk_bf16(h1[0], h1[1]); w.w = cvt_pk_bf16(h1[2], h1[3]);
                        *(u32x4*)(H + ro) = w;
                    }
                }
                if (wn) { ssq += __shfl_xor(ssq, 16); ssq += __shfl_xor(ssq, 32); if (fq == 0) (void)__hip_atomic_fetch_add(rowss_next + row, ssq, __ATOMIC_RELAXED, __HIP_MEMORY_SCOPE_AGENT); }
            }
    }
};
struct EpiWin {
    static constexpr bool PERM = true, AFTER_DRAIN = false;
    int l;
    __device__ __forceinline__ void operator()(f32x4 (&acc)[2][2][4][2], const Unit& u, int wr, int wc, int fr, int fq) const {
        asm volatile("" : "+v"(fr), "+v"(fq));
        unsigned char* ws = PWS; float* out = POUT; const float* qn = PIN(25) + l * HD; const float* kn = PIN(26) + l * HD;
        const float* rowss = (const float*)(ws + WS_ROWSS) + (size_t)(l * 3 + 1) * MT; const float* shw = (const float*)(ws + WS_SHW) + (size_t)l * SHW_LAYER + SHW_J1;
        const int row0 = u.pm * 256 + wr * 64 + fr, pn = u.pn;
        {
            const float* sp = shw + (size_t)modrow(u.pm * 256) * INC + pn * 256 + wc * 32 + 8 * fq;
            f32x4 sv[2][2];
#pragma unroll
            for (int bj = 0; bj < 2; ++bj) { sv[bj][0] = *(const f32x4*)(sp + bj * 128); sv[bj][1] = *(const f32x4*)(sp + bj * 128 + 4); }
#pragma unroll
            for (int ai = 0; ai < 2; ++ai) if ((u.mask >> ai) & 1)
#pragma unroll
                for (int m = 0; m < 4; ++m) {
                    const float ri = rsqrtf(rowss[row0 + ai * 128 + m * 16] * (1.f / D) + 1e-6f);
#pragma unroll
                    for (int bj = 0; bj < 2; ++bj) { acc[ai][bj][m][0] = acc[ai][bj][m][0] * ri + sv[bj][0]; acc[ai][bj][m][1] = acc[ai][bj][m][1] * ri + sv[bj][1]; }
                }
        }
        float* XS = (float*)(ws + WS_XSSM); bf16_t* Q = (bf16_t*)(ws + WS_Q); bf16_t* K = (bf16_t*)(ws + WS_K); bf16_t* VT = (bf16_t*)(ws + WS_VT); bf16_t* U = (bf16_t*)(ws + WS_U); bf16_t* VG = (bf16_t*)(ws + WS_VG);
        float* ock = out + O_CK; float* ocv = out + O_CV;
        if (pn == 0) {
#pragma unroll
            for (int ai = 0; ai < 2; ++ai) if ((u.mask >> ai) & 1)
#pragma unroll
                for (int m = 0; m < 4; ++m)
#pragma unroll
                    for (int bj = 0; bj < 2; ++bj) { float* o = XS + (size_t)(row0 + ai * 128 + m * 16) * SSMW + bj * 128 + wc * 32 + 8 * fq;
                        *(f32x4*)o = acc[ai][bj][m][0]; *(f32x4*)(o + 4) = acc[ai][bj][m][1]; }
        } else if (pn <= 4) {
            const bool isk = pn >= 3; const int h = 4 * ((pn - 1) & 1) + wc;
            const float* gn = isk ? kn : qn; bf16_t* O = isk ? K : Q;
            f32x4 gv[2][2];
#pragma unroll
            for (int bj = 0; bj < 2; ++bj)
#pragma unroll
                for (int n = 0; n < 2; ++n) gv[bj][n] = *(const f32x4*)(gn + 32 * bj + 8 * fq + 4 * n);
#pragma unroll
            for (int ai = 0; ai < 2; ++ai) if ((u.mask >> ai) & 1)
#pragma unroll
                for (int m = 0; m < 4; ++m) {
                    float ss = 0.f;
#pragma unroll
                    for (int bj = 0; bj < 2; ++bj)
#pragma unroll
                        for (int n = 0; n < 2; ++n) { const f32x4 v = acc[ai][bj][m][n]; ss += (v[0] * v[0] + v[1] * v[1]) + (v[2] * v[2] + v[3] * v[3]); }
                    ss += __shfl_xor(ss, 16); ss += __shfl_xor(ss, 32);
                    const float rinv = rsqrtf(ss * (1.f / HD) + 1e-6f);
                    const int row = row0 + ai * 128 + m * 16;
#pragma unroll
                    for (int bj = 0; bj < 2; ++bj) {
                        const f32x4 v0 = acc[ai][bj][m][0] * rinv * gv[bj][0], v1 = acc[ai][bj][m][1] * rinv * gv[bj][1];
                        u32x4 w; w.x = cvt_pk_bf16(v0[0], v0[1]); w.y = cvt_pk_bf16(v0[2], v0[3]); w.z = cvt_pk_bf16(v1[0], v1[1]); w.w = cvt_pk_bf16(v1[2], v1[3]);
                        const int d = 32 * bj + 8 * fq;
                        *(u32x4*)(O + (size_t)row * NAW + h * HD + d) = w;
                        if (isk && u.pm < MC / 256) { const int b = row / SEQ, t = row % SEQ; float* o = ock + ((((size_t)b * DEPTH + l) * SEQ + t) * NH + h) * HD + d;
                            *(f32x4*)o = v0; *(f32x4*)(o + 4) = v1; }
                    }
                }
        } else if (pn <= 6) {
            const bool ctx = u.pm < MC / 256;
#pragma unroll
            for (int ai = 0; ai < 2; ++ai) if ((u.mask >> ai) & 1)
#pragma unroll
                for (int m = 0; m < 4; ++m) {
                    const int row = row0 + ai * 128 + m * 16;
                    size_t vb; int Lq; float* oc = nullptr;
                    if (ctx) { const int b = row / SEQ, t = row % SEQ; vb = (size_t)b * NH * HD * SEQ + t; Lq = SEQ; oc = ocv + (((size_t)b * DEPTH + l) * SEQ + t) * NAW; }
                    else { const int r2 = row - MC, b = r2 / DSEQ, t = r2 % DSEQ; vb = (size_t)MC * NAW + (size_t)b * NH * HD * DSEQ + t; Lq = DSEQ; }
#pragma unroll
                    for (int bj = 0; bj < 2; ++bj) {
                        const int cl = (pn - 5) * 256 + bj * 128 + wc * 32 + 8 * fq;
                        const f32x4 v0 = acc[ai][bj][m][0], v1 = acc[ai][bj][m][1];
                        bf16_t* o = VT + vb + (size_t)cl * Lq;
                        o[0] = f2bf(v0[0]); o[(size_t)Lq] = f2bf(v0[1]); o[(size_t)2 * Lq] = f2bf(v0[2]); o[(size_t)3 * Lq] = f2bf(v0[3]);
                        o[(size_t)4 * Lq] = f2bf(v1[0]); o[(size_t)5 * Lq] = f2bf(v1[1]); o[(size_t)6 * Lq] = f2bf(v1[2]); o[(size_t)7 * Lq] = f2bf(v1[3]);
                        if (ctx) { *(f32x4*)(oc + cl) = v0; *(f32x4*)(oc + cl + 4) = v1; }
                    }
                }
        } else {
            bf16_t* O = pn == 7 ? U : VG;
#pragma unroll
            for (int ai = 0; ai < 2; ++ai) if ((u.mask >> ai) & 1)
#pragma unroll
                for (int m = 0; m < 4; ++m)
#pragma unroll
                    for (int bj = 0; bj < 2; ++bj) {
                        const f32x4 v0 = acc[ai][bj][m][0], v1 = acc[ai][bj][m][1];
                        u32x4 w; w.x = cvt_pk_bf16(gelu_fast(v0[0]), gelu_fast(v0[1])); w.y = cvt_pk_bf16(gelu_fast(v0[2]), gelu_fast(v0[3]));
                        w.z = cvt_pk_bf16(gelu_fast(v1[0]), gelu_fast(v1[1])); w.w = cvt_pk_bf16(gelu_fast(v1[2]), gelu_fast(v1[3]));
                        *(u32x4*)(O + (size_t)(row0 + ai * 128 + m * 16) * GMW + bj * 128 + wc * 32 + 8 * fq) = w;
                    }
        }
    }
};

template <class Epi, class Sched, bool ALIGN_EPI = false, bool SP2 = false>
__device__ __forceinline__ void gemm_phase(PG8_LAS unsigned char* lds, const Gemm g, const Sched& S, const Epi& E) {
    const int tid = tid_opaque(), wid = __builtin_amdgcn_readfirstlane(tid >> 6), lane = tid & 63, wr = wid >> 2, wc = wid & 3, fr = lane & 15, fq = lane >> 4;
    const int K = g.K, nt = K / BK;
    unsigned voffA[2], voffB[2];
#pragma unroll
    for (int i = 0; i < 2; ++i) { int R, C; stage_rc(tid * 16 + i * 8192, R, C); const int Rb = Epi::PERM ? ((R & ~31) + perm32(R & 31)) : R;
        voffA[i] = (unsigned)(R * K + C) * 2u; voffB[i] = (unsigned)(Rb * K + C) * 2u; }
    const size_t kstep = (size_t)(BK * 2);
    const size_t hstep = (size_t)HALF * K * 2;
    const size_t tstep = 2 * hstep;
    const unsigned ldsw = (unsigned)wid * 1024u;
    const int aoff = lds_byte(wr * 64 + fr, fq * 8), boff = lds_byte(wc * 32 + fr, fq * 8);
#define PG8_SA(b, h) (((b) * 2 + (h)) * HTB)
#define PG8_SB(b, h) ((4 + (b) * 2 + (h)) * HTB)
#define PG8_STAGE(bufoff, gbase, voff) do { _Pragma("unroll") for (int _i = 0; _i < 2; ++_i) \
        __builtin_amdgcn_global_load_lds((const unsigned*)((const char*)(gbase) + (voff)[_i]), (PG8_LAS unsigned*)(lds + (bufoff) + ldsw + _i * 8192), 16, 0, 0); } while (0)
#define PG8_LDA(dst, b, h) do { _Pragma("unroll") for (int m = 0; m < 4; ++m) _Pragma("unroll") for (int k = 0; k < 2; ++k) dst[m][k] = *(const PG8_LAS bf16x8*)(lds + PG8_SA(b, h) + aoff + m * 2048 + k * 1024); } while (0)
#define PG8_LDB(dst, b, h) do { _Pragma("unroll") for (int n = 0; n < 2; ++n) _Pragma("unroll") for (int k = 0; k < 2; ++k) dst[n][k] = *(const PG8_LAS bf16x8*)(lds + PG8_SB(b, h) + boff + n * 2048 + k * 1024); } while (0)
#define PG8_MMA(ai, bj, At, Bt) do { __builtin_amdgcn_s_setprio(1); _Pragma("unroll") for (int m = 0; m < 4; ++m) _Pragma("unroll") for (int n = 0; n < 2; ++n) _Pragma("unroll") for (int k = 0; k < 2; ++k) \
        acc[ai][bj][m][n] = __builtin_amdgcn_mfma_f32_16x16x32_bf16(Bt[n][k], At[m][k], acc[ai][bj][m][n], 0, 0, 0); __builtin_amdgcn_s_setprio(0); } while (0)
#define PG8_WAIT_V(n) asm volatile("s_waitcnt vmcnt(" #n ")" ::: "memory")
#define PG8_WAIT_L(n) asm volatile("s_waitcnt lgkmcnt(" #n ")" ::: "memory")
#define PG8_BAR __builtin_amdgcn_s_barrier()
#define PG8_SCHED __builtin_amdgcn_sched_barrier(0)
    Unit cur, nxt; int ui = 0;
    if (!S.next(0, cur)) return;
    f32x4 acc[2][2][4][2];
#pragma unroll
    for (int a = 0; a < 2; ++a)
#pragma unroll
        for (int b = 0; b < 2; ++b)
#pragma unroll
            for (int m = 0; m < 4; ++m)
#pragma unroll
                for (int n = 0; n < 2; ++n) acc[a][b][m][n] = (f32x4){0.f, 0.f, 0.f, 0.f};
    bf16x8 At[4][2], B0[2][2], B1[2][2];
    const char* cA = (const char*)g.A + (size_t)cur.pm * tstep; const char* cB = (const char*)g.Bt + (size_t)cur.pn * tstep;
    S.a_ready(cur);
    if constexpr (SP2) {
        PG8_STAGE(PG8_SB(0, 0), cB, voffB); PG8_STAGE(PG8_SB(0, 1), cB + hstep, voffB); PG8_STAGE(PG8_SA(0, 0), cA, voffA); PG8_STAGE(PG8_SA(0, 1), cA + hstep, voffA);
        if (wr == 1) PG8_BAR;
        PG8_WAIT_V(2); PG8_BAR;
        PG8_STAGE(PG8_SB(1, 0), cB + kstep, voffB); PG8_STAGE(PG8_SA(1, 0), cA + kstep, voffA); PG8_STAGE(PG8_SB(1, 1), cB + hstep + kstep, voffB);
        PG8_WAIT_V(6); PG8_BAR;
    } else {
        PG8_STAGE(PG8_SB(0, 0), cB, voffB); PG8_STAGE(PG8_SA(0, 0), cA, voffA); PG8_STAGE(PG8_SB(0, 1), cB + hstep, voffB); PG8_STAGE(PG8_SA(0, 1), cA + hstep, voffA);
        if (wr == 1) PG8_BAR;
        PG8_WAIT_V(4); PG8_BAR;
        PG8_STAGE(PG8_SB(1, 0), cB + kstep, voffB); PG8_STAGE(PG8_SA(1, 0), cA + kstep, voffA); PG8_STAGE(PG8_SB(1, 1), cB + hstep + kstep, voffB);
        PG8_WAIT_V(6); PG8_BAR;
    }
    for (;;) {
        const bool has_next = S.next(ui + 1, nxt);
        const char* nA = has_next ? (const char*)g.A + (size_t)nxt.pm * tstep : cA; const char* nB = has_next ? (const char*)g.Bt + (size_t)nxt.pn * tstep : cB;
        for (int t = 0; t < nt; t += 2) {
            const bool last = (t == nt - 2);
            const char* a1 = cA + (size_t)(t + 1) * kstep;
            const char* a2 = last ? nA : cA + (size_t)(t + 2) * kstep; const char* b2 = last ? nB : cB + (size_t)(t + 2) * kstep;
            const char* a3 = a2 + kstep; const char* b3 = b2 + kstep;
            if (last && has_next) S.a_ready(nxt);
            if constexpr (SP2) {
            PG8_LDB(B0, 0, 0); PG8_LDB(B1, 0, 1); PG8_SCHED; if (cur.mask & 1) PG8_LDA(At, 0, 0); PG8_STAGE(PG8_SA(1, 1), a1 + hstep, voffA);
            PG8_WAIT_V(8); PG8_WAIT_L(0); PG8_BAR; if (cur.mask & 1) { PG8_MMA(0, 0, At, B0); PG8_MMA(0, 1, At, B1); } PG8_BAR; PG8_SCHED;
            if (cur.mask & 2) PG8_LDA(At, 0, 1); PG8_STAGE(PG8_SB(0, 0), b2, voffB); PG8_STAGE(PG8_SB(0, 1), b2 + hstep, voffB); PG8_STAGE(PG8_SA(0, 0), a2, voffA);
            PG8_WAIT_V(8); PG8_WAIT_L(0); PG8_BAR; if (cur.mask & 2) { PG8_MMA(1, 0, At, B0); PG8_MMA(1, 1, At, B1); } PG8_BAR; PG8_SCHED;
            PG8_LDB(B0, 1, 0); PG8_LDB(B1, 1, 1); PG8_SCHED; if (cur.mask & 1) PG8_LDA(At, 1, 0); PG8_STAGE(PG8_SA(0, 1), a2 + hstep, voffA);
            PG8_WAIT_V(8); PG8_WAIT_L(0); PG8_BAR; if (cur.mask & 1) { PG8_MMA(0, 0, At, B0); PG8_MMA(0, 1, At, B1); } PG8_BAR; PG8_SCHED;
            if (cur.mask & 2) PG8_LDA(At, 1, 1); PG8_STAGE(PG8_SB(1, 0), b3, voffB); PG8_STAGE(PG8_SB(1, 1), b3 + hstep, voffB); PG8_STAGE(PG8_SA(1, 0), a3, voffA);
            PG8_WAIT_V(8); PG8_WAIT_L(0); PG8_BAR; if (cur.mask & 2) { PG8_MMA(1, 0, At, B0); PG8_MMA(1, 1, At, B1); } PG8_BAR; PG8_SCHED;
            } else {
            PG8_LDB(B0, 0, 0); PG8_SCHED; PG8_LDA(At, 0, 0); PG8_STAGE(PG8_SA(1, 1), a1 + hstep, voffA);
            PG8_WAIT_L(8); PG8_BAR; PG8_WAIT_L(0); PG8_MMA(0, 0, At, B0); PG8_BAR; PG8_SCHED;
            PG8_LDB(B1, 0, 1); PG8_STAGE(PG8_SB(0, 0), b2, voffB);
            PG8_BAR; PG8_WAIT_L(0); PG8_MMA(0, 1, At, B1); PG8_BAR;
            PG8_LDA(At, 0, 1); PG8_STAGE(PG8_SA(0, 0), a2, voffA);
            PG8_BAR; PG8_WAIT_L(0); PG8_MMA(1, 0, At, B0); PG8_BAR; PG8_SCHED;
            PG8_STAGE(PG8_SB(0, 1), b2 + hstep, voffB);
            PG8_WAIT_V(6); PG8_BAR; PG8_MMA(1, 1, At, B1); PG8_BAR;
            PG8_LDB(B0, 1, 0); PG8_SCHED; PG8_LDA(At, 1, 0); PG8_STAGE(PG8_SA(0, 1), a2 + hstep, voffA);
            PG8_WAIT_L(8); PG8_BAR; PG8_WAIT_L(0); PG8_MMA(0, 0, At, B0); PG8_BAR; PG8_SCHED;
            PG8_LDB(B1, 1, 1); PG8_STAGE(PG8_SB(1, 0), b3, voffB);
            PG8_BAR; PG8_WAIT_L(0); PG8_MMA(0, 1, At, B1); PG8_BAR;
            PG8_LDA(At, 1, 1); PG8_STAGE(PG8_SA(1, 0), a3, voffA);
            PG8_BAR; PG8_WAIT_L(0); PG8_MMA(1, 0, At, B0); PG8_BAR; PG8_SCHED;
            PG8_STAGE(PG8_SB(1, 1), b3 + hstep, voffB);
            PG8_WAIT_V(6); PG8_BAR; PG8_MMA(1, 1, At, B1); PG8_BAR;
            }
        }
        if constexpr (ALIGN_EPI) { if (wr == 0) PG8_BAR; }
        if constexpr (!Epi::AFTER_DRAIN) { E(acc, cur, wr, wc, fr, fq); S.done(cur); }
        if (!has_next) break;
#pragma unroll
        for (int a = 0; a < 2; ++a)
#pragma unroll
            for (int b = 0; b < 2; ++b)
#pragma unroll
                for (int m = 0; m < 4; ++m)
#pragma unroll
                    for (int n = 0; n < 2; ++n) acc[a][b][m][n] = (f32x4){0.f, 0.f, 0.f, 0.f};
        cur = nxt; cA = nA; cB = nB; ++ui;
        if constexpr (ALIGN_EPI) { if (wr == 1) PG8_BAR; }
    }
    PG8_WAIT_V(0);
    if constexpr (!ALIGN_EPI) { if (wr == 0) PG8_BAR; }
    PG8_BAR;
    if constexpr (Epi::AFTER_DRAIN) { E.fused(acc, cur, wr, wc, fr, fq, lds, wid, lane); S.done(cur); }
#undef PG8_SA
#undef PG8_SB
#undef PG8_STAGE
#undef PG8_LDA
#undef PG8_LDB
#undef PG8_MMA
#undef PG8_WAIT_V
#undef PG8_WAIT_L
#undef PG8_BAR
#undef PG8_SCHED
}

}

#define LAS __attribute__((address_space(3)))

__device__ __forceinline__ void transpose_item(const float* W, int K, int N, bf16_t* WT, int k0, int ns0, int nd0, LAS float* scr, int lane) {
    float v[32];
    const float* wp = W + (size_t)(k0 + (lane >> 5)) * N + ns0 + (lane & 31);
#pragma unroll
    for (int i = 0; i < 32; ++i) v[i] = wp[(size_t)(2 * i) * N];
#pragma unroll
    for (int i = 0; i < 32; ++i) scr[(2 * i + (lane >> 5)) * 33 + (lane & 31)] = v[i];
    asm volatile("s_waitcnt lgkmcnt(0)" ::: "memory");
    const int c = lane & 7;
#pragma unroll
    for (int j = 0; j < 4; ++j) { const int n = (lane >> 3) + 8 * j; const LAS float* s = scr + (8 * c) * 33 + n;
        pg8::u32x4 o; o.x = pg8::cvt_pk_bf16(s[0 * 33], s[1 * 33]); o.y = pg8::cvt_pk_bf16(s[2 * 33], s[3 * 33]); o.z = pg8::cvt_pk_bf16(s[4 * 33], s[5 * 33]); o.w = pg8::cvt_pk_bf16(s[6 * 33], s[7 * 33]);
        *(pg8::u32x4*)(WT + (size_t)(nd0 + n) * K + k0 + 8 * c) = o; }
    asm volatile("s_waitcnt lgkmcnt(0)" ::: "memory");
}
__device__ __forceinline__ void prologue_phase(LAS unsigned char* lds, int vcu, int G) {
    const int tid = tid_opaque(), lane = tid & 63, wave = __builtin_amdgcn_readfirstlane(tid >> 6);
    {
        LAS float* sc = (LAS float*)lds;
        LAS float* red = (LAS float*)(lds + 20480);
        const float* cctx = PIN(6); const float* cc = PIN(2);
        for (int i = tid; i < 5 * D; i += NWAVES * 64) { const int r = i / D, k = i % D; const float v = r == 0 ? cctx[k] : cc[(r - 1) * D + k]; sc[i] = v / (1.f + __expf(-v)); }
        __syncthreads();
        constexpr int KQ = 16, NBLK = NMOD * D / 128, NIT = DEPTH * NBLK * KQ;
        int it0 = (int)((long)vcu * NIT / G); const int it1 = (int)((long)(vcu + 1) * NIT / G);
        while (it0 < it1) {
            const int blk = it0 / KQ, ke = it1 < (blk + 1) * KQ ? it1 : (blk + 1) * KQ, nk = ke - it0;
            const int l = blk / NBLK, n0 = (blk % NBLK) * 128, kbeg = (it0 % KQ) * (D / KQ);
            const float* w = PIN(7) + (size_t)l * D * NMOD * D + n0 + (lane & 31) * 4;
            const int kb = kbeg + wave * (nk * 8) + (lane >> 5), nl = nk * 4;
            pg8::f32x4 a[5];
#pragma unroll
            for (int r = 0; r < 5; ++r) a[r] = (pg8::f32x4){0.f, 0.f, 0.f, 0.f};
#pragma unroll 1
            for (int i0 = 0; i0 < nl; i0 += 12) {
                pg8::f32x4 wv[12];
#pragma unroll
                for (int i = 0; i < 12; ++i) { const int ii = i0 + i < nl ? i0 + i : nl - 1; wv[i] = *(const pg8::f32x4*)(w + (size_t)(kb + 2 * ii) * NMOD * D); }
#pragma unroll
                for (int i = 0; i < 12; ++i) { const bool ok = i0 + i < nl; const int k = kb + 2 * (ok ? i0 + i : nl - 1);
#pragma unroll
                    for (int r = 0; r < 5; ++r) a[r] += wv[i] * (ok ? sc[r * D + k] : 0.f); }
            }
#pragma unroll
            for (int r = 0; r < 5; ++r) {
#pragma unroll
                for (int e = 0; e < 4; ++e) a[r][e] += __shfl_xor(a[r][e], 32);
                if (lane < 32) *(LAS pg8::f32x4*)(red + (wave * 5 + r) * 128 + lane * 4) = a[r]; }
            __syncthreads();
            const float* bada = PIN(8); float* modo = (float*)(PWS + WS_MOD);
            for (int o = tid; o < 5 * 128; o += NWAVES * 64) { const int r = o / 128, c = o % 128; float s = kbeg == 0 ? bada[l * NMOD * D + n0 + c] : 0.f;
#pragma unroll
                for (int w8 = 0; w8 < 8; ++w8) s += red[(w8 * 5 + r) * 128 + c];
                (void)__hip_atomic_fetch_add(modo + ((size_t)l * 5 + r) * NMOD * D + n0 + c, s, __ATOMIC_RELAXED, __HIP_MEMORY_SCOPE_AGENT); }
            __syncthreads();
            it0 = ke;
        }
        __syncthreads();
    }
    {
        LAS float* scr = (LAS float*)(lds + wave * 16384);
        const int gw = vcu * NWAVES + wave, NGW = G * NWAVES;
        constexpr int I_FIN = (D / 64) * (2 * FF / 32), I_FOUT = (FF / 64) * (D / 32), I_WIN = (D / 64) * (INC / 32), I_WOUT = (D / 64) * (D / 32);
        constexpr int I_LAYER = 2 * I_FIN + 2 * I_FOUT + I_WIN + I_WOUT;
        for (int it = gw; it < DEPTH * I_LAYER; it += NGW) {
            const int l = it / I_LAYER; int r = it % I_LAYER;
            unsigned char* wl = PWS + WS_W + (size_t)l * WL_STRIDE;
            int which = 0;
            if (r >= I_FIN) { r -= I_FIN; which = 1; if (r >= I_FOUT) { r -= I_FOUT; which = 2; if (r >= I_WIN) { r -= I_WIN; which = 3; if (r >= I_WOUT) { r -= I_WOUT; which = 4; if (r >= I_FIN) { r -= I_FIN; which = 5; } } } } }
            if (which == 0 || which == 4) {
                const float* W = (which == 0 ? PIN(10) : PIN(31)) + (size_t)l * D * 2 * FF; bf16_t* WT = (bf16_t*)(wl + (which == 0 ? WO_W1A : WO_W1B));
                const int nblk = 2 * FF / 32, kb = r / nblk, nd0 = (r % nblk) * 32; const int pn = nd0 / 256, c = nd0 % 256, bj = c / 128, x = c % 128;
                transpose_item(W, D, 2 * FF, WT, kb * 64, bj * FF + 128 * pn + x, nd0, scr, lane);
            } else if (which == 1 || which == 5) {
                const float* W = (which == 1 ? PIN(11) : PIN(32)) + (size_t)l * FF * D; bf16_t* WT = (bf16_t*)(wl + (which == 1 ? WO_W2A : WO_W2B));
                const int nblk = D / 32, kb = r / nblk, nd0 = (r % nblk) * 32;
                transpose_item(W, FF, D, WT, kb * 64, nd0, nd0, scr, lane);
            } else if (which == 2) {
                const float* W = PIN(13) + (size_t)l * D * INC; bf16_t* WT = (bf16_t*)(wl + WO_WIN);
                const int nblk = INC / 32, kb = r / nblk, nd0 = (r % nblk) * 32; const int pn = nd0 / 256, c = nd0 % 256;
                int ns0 = nd0; if (pn >= 1 && pn <= 4) { const int bj = c / 128, wc = (c % 128) / 32; ns0 = 256 * pn + 64 * wc + 32 * bj; }
                transpose_item(W, D, INC, WT, kb * 64, ns0, nd0, scr, lane);
            } else {
                const float* W = PIN(14) + (size_t)l * D * D; bf16_t* WT = (bf16_t*)(wl + WO_WOUT);
                const int nblk = D / 32, kb = r / nblk, nd0 = (r % nblk) * 32;
                transpose_item(W, D, D, WT, kb * 64, nd0, nd0, scr, lane);
            }
        }
    }
    const int gt = vcu * (NWAVES * 64) + tid, NGT = G * NWAVES * 64;
    const int gtr = (G - 1 - vcu) * (NWAVES * 64) + tid;
    {
        constexpr int NSLOT = DEPTH * 4 * 128 * 128, CTOT = DB * DEPTH * PAST * NH * HD;
        static_assert(DEPTH * SSMW * SSMW == NSLOT && CTOT == 8 * NSLOT && DEPTH * 3 * MT <= 2 * NSLOT, "slot loop layout");
        const float* gws = PIN(28); bf16_t* wsb = (bf16_t*)(PWS + WS_WSB); const float* glw = PIN(23); bf16_t* glt = (bf16_t*)(PWS + WS_GLT); float* rs = (float*)(PWS + WS_ROWSS);
        const float* cki = PIN(3); const float* cvi = PIN(4); bf16_t* cko = (bf16_t*)(PWS + WS_CK); bf16_t* cvo = (bf16_t*)(PWS + WS_CVT);
        for (int sl = gt; sl < NSLOT; sl += NGT) {
            const float w0 = gws[sl];
            const int gk = sl % SSMW, gn = (sl / SSMW) % SSMW, gl = sl / (SSMW * SSMW);
            const float g0 = glw[((size_t)gl * SSMW + gk) * SSMW + gn];
            float kv[8], vv[8];
#pragma unroll
            for (int j = 0; j < 8; ++j) { kv[j] = cki[sl + j * NSLOT]; vv[j] = cvi[sl + j * NSLOT]; }
            wsb[sl] = f2bf(w0); glt[sl] = f2bf(g0);
            rs[sl] = 0.f; if (sl + NSLOT < DEPTH * 3 * MT) rs[sl + NSLOT] = 0.f;
#pragma unroll
            for (int j = 0; j < 8; ++j) { const int idx = sl + j * NSLOT;
                const int d = idx % HD, h = (idx / HD) % NH, t = (idx / (HD * NH)) % PAST, l = (idx / (HD * NH * PAST)) % DEPTH, b = idx / (HD * NH * PAST * DEPTH);
                cko[((((size_t)l * DB + b) * NH + h) * PAST + t) * HD + d] = f2bf(kv[j]);
                cvo[((((size_t)l * DB + b) * NH + h) * HD + d) * PAST + t] = f2bf(vv[j]); }
        }
    }
    for (int idx = gtr; idx < DEPTH * 2 * SG * SP; idx += NGT) {
        const int g = (idx / SP) % SG, ld = idx / (SP * SG);
        const float lre = PIN(15)[idx], lim = PIN(16)[idx];
        const float dt = expf(PIN(17)[ld * SG + g]);
        const float er = expf(lre * dt); float sn, cs; sincosf(lim * dt, &sn, &cs);
        const float br = er * cs, bi = er * sn;
        const float nr = br - 1.f, ni = bi, den = lre * lre + lim * lim;
        const float cr = (nr * lre + ni * lim) / den, ci = (ni * lre - nr * lim) / den;
        float2* lb = (float2*)(PWS + WS_SSMP); float2* bb = (float2*)(PWS + WS_SSMP + 64 * 1024);
        lb[idx] = make_float2(br, bi);
        const float* bre = PIN(18); const float* bim = PIN(19);
        float bxr[SC], bxi[SC];
#pragma unroll
        for (int c = 0; c < SC; ++c) { const float xr = bre[(size_t)idx * SC + c], xi = bim[(size_t)idx * SC + c];
            bxr[c] = cr * xr - ci * xi; bxi[c] = cr * xi + ci * xr; bb[(size_t)idx * SC + c] = make_float2(bxr[c], bxi[c]); }
        const int pp = idx % SP; pg8::u32x4* bmf = (pg8::u32x4*)(PWS + WS_BMF) + ((size_t)(idx / SP) * 8 + pp / 8) * 64;
#pragma unroll
        for (int part = 0; part < 2; ++part)
#pragma unroll
            for (int q4 = 0; q4 < 4; ++q4) { const int c0 = 8 * (q4 & 1); pg8::u32x4 w;
                w.x = pg8::cvt_pk_bf16(part ? bxi[c0 + 0] : bxr[c0 + 0], part ? bxi[c0 + 1] : bxr[c0 + 1]); w.y = pg8::cvt_pk_bf16(part ? bxi[c0 + 2] : bxr[c0 + 2], part ? bxi[c0 + 3] : bxr[c0 + 3]);
                w.z = pg8::cvt_pk_bf16(part ? bxi[c0 + 4] : bxr[c0 + 4], part ? bxi[c0 + 5] : bxr[c0 + 5]); w.w = pg8::cvt_pk_bf16(part ? bxi[c0 + 6] : bxr[c0 + 6], part ? bxi[c0 + 7] : bxr[c0 + 7]);
                bmf[16 * q4 + 2 * (pp % 8) + part] = w; }
    }
    {
        const float* cre0 = PIN(20); const float* cim0 = PIN(21); pg8::u32x4* cff = (pg8::u32x4*)(PWS + WS_CFF);
        for (int idx = gtr; idx < DEPTH * 2 * SG * 4 * 64; idx += NGT) {
            const int ln = idx & 63, ks = (idx >> 6) & 3, ldg = idx >> 8, rr = ln & 15, qq = ln >> 4;
            const float* a = cre0 + ((size_t)ldg * SC + rr) * SP + 16 * ks + 4 * qq; const float* b = cim0 + ((size_t)ldg * SC + rr) * SP + 16 * ks + 4 * qq;
            pg8::u32x4 w; w.x = pg8::cvt_pk_bf16(a[0], -b[0]); w.y = pg8::cvt_pk_bf16(a[1], -b[1]); w.z = pg8::cvt_pk_bf16(a[2], -b[2]); w.w = pg8::cvt_pk_bf16(a[3], -b[3]);
            cff[idx] = w;
        }
    }
}
__device__ __forceinline__ void x0_phase(int vcu, int G) {
    const int tid = tid_opaque(), lane = tid & 63, wave = __builtin_amdgcn_readfirstlane(tid >> 6);
    const int gw = vcu * NWAVES + wave, NGW = G * NWAVES;
    const float* modb = (const float*)(PWS + WS_MOD);
    {
        const float* gain = PIN(9); const float* xp = PIN(0); const float* xs = PIN(1); bf16_t* Hb = (bf16_t*)(PWS + WS_H); float* rs = (float*)(PWS + WS_ROWSS);
        for (int row = gw; row < MT; row += NGW) {
            const float* src = row < MC ? xp + (size_t)row * D : xs + (size_t)(row - MC) * D;
            const float* sc = modb + (size_t)modrow(row) * NMOD * D + 1 * D;
            float4 v[4]; float ss = 0.f;
#pragma unroll
            for (int j = 0; j < 4; ++j) { v[j] = ((const float4*)src)[lane + 64 * j]; ss += v[j].x * v[j].x + v[j].y * v[j].y + v[j].z * v[j].z + v[j].w * v[j].w; }
            ss = wave_sum(ss);
            if (lane == 0) rs[row] = ss;
            bf16_t* Hr = Hb + (size_t)row * D; _Float16* Xr = (_Float16*)((unsigned char*)POUT + XH_OUT_OFF) + (size_t)row * D;
#pragma unroll
            for (int j = 0; j < 4; ++j) {
                const int c0 = (lane + 64 * j) * 4;
                { pg8::f32x4 xv; xv[0] = v[j].x; xv[1] = v[j].y; xv[2] = v[j].z; xv[3] = v[j].w; *(pg8::f16x4*)(Xr + c0) = __builtin_convertvector(xv, pg8::f16x4); }
                const float4 g4 = *(const float4*)(gain + c0), s4 = *(const float4*)(sc + c0);
                uint2 o;
                o.x = pg8::cvt_pk_bf16(v[j].x * g4.x * (1.f + s4.x), v[j].y * g4.y * (1.f + s4.y));
                o.y = pg8::cvt_pk_bf16(v[j].z * g4.z * (1.f + s4.z), v[j].w * g4.w * (1.f + s4.w));
                *(uint2*)(Hr + c0) = o;
            }
        }
    }
    {
        float* wn = (float*)(PWS + WS_WN);
        const int gt = vcu * (NWAVES * 64) + tid, NGT = G * NWAVES * 64;
        for (int idx = gt; idx < DEPTH * 3 * 5 * D; idx += NGT) {
            const int c = idx % D, mr = (idx / D) % 5, j = (idx / (5 * D)) % 3, l = idx / (15 * D);
            const float g = (j == 0 ? PIN(9) : j == 1 ? PIN(12) : PIN(30))[l * D + c];
            wn[idx] = g * (1.f + modb[((size_t)l * 5 + mr) * NMOD * D + (3 * j + 1) * D + c]);
        }
    }
    {
        float* shw = (float*)(PWS + WS_SHW);
        constexpr int TPL = (2 * 2 * FF + INC) / 16;
        const int r = lane & 15, q4 = lane >> 4;
        for (int it = gw; it < DEPTH * TPL; it += NGW) {
            const int l = it / TPL, t = it % TPL;
            int j, n0, N; size_t wo;
            if (t < 2 * FF / 16) { j = 0; n0 = t * 16; wo = WO_W1A; N = 2 * FF; } else if (t < (2 * FF + INC) / 16) { j = 1; n0 = (t - 2 * FF / 16) * 16; wo = WO_WIN; N = INC; } else { j = 2; n0 = (t - (2 * FF + INC) / 16) * 16; wo = WO_W1B; N = 2 * FF; }
            const bf16_t* wt = (const bf16_t*)(PWS + WS_W + (size_t)l * WL_STRIDE + wo) + (size_t)(n0 + r) * D + 8 * q4;
            const float* sh = modb + ((size_t)l * 5 + (r < 5 ? r : 4)) * NMOD * D + (3 * j) * D + 8 * q4;
            const bool valid = r < 5;
            pg8::f32x4 ah = (pg8::f32x4){0.f, 0.f, 0.f, 0.f}, al = ah;
#pragma unroll 4
            for (int ks = 0; ks < 32; ++ks) {
                const pg8::bf16x8 b = *(const pg8::bf16x8*)(wt + 32 * ks);
                const pg8::f32x4 s0 = *(const pg8::f32x4*)(sh + 32 * ks), s1 = *(const pg8::f32x4*)(sh + 32 * ks + 4);
                const float sv[8] = {s0[0], s0[1], s0[2], s0[3], s1[0], s1[1], s1[2], s1[3]};
                unsigned hw[4], lw[4];
#pragma unroll
                for (int i = 0; i < 4; ++i) { const unsigned hp = pg8::cvt_pk_bf16(sv[2 * i], sv[2 * i + 1]);
                    const unsigned lp = pg8::cvt_pk_bf16(sv[2 * i] - __uint_as_float(hp << 16), sv[2 * i + 1] - __uint_as_float(hp & 0xffff0000u));
                    hw[i] = valid ? hp : 0u; lw[i] = valid ? lp : 0u; }
                pg8::u32x4 hv, lv; hv.x = hw[0]; hv.y = hw[1]; hv.z = hw[2]; hv.w = hw[3]; lv.x = lw[0]; lv.y = lw[1]; lv.z = lw[2]; lv.w = lw[3];
                ah = __builtin_amdgcn_mfma_f32_16x16x32_bf16(__builtin_bit_cast(pg8::bf16x8, hv), b, ah, 0, 0, 0);
                al = __builtin_amdgcn_mfma_f32_16x16x32_bf16(__builtin_bit_cast(pg8::bf16x8, lv), b, al, 0, 0, 0);
            }
            const pg8::f32x4 sum = ah + al;
            float* o = shw + (size_t)l * SHW_LAYER + (j == 0 ? 0 : j == 1 ? SHW_J1 : SHW_J2) + n0 + r;
            if (q4 == 0) { o[0] = sum[0]; o[(size_t)N] = sum[1]; o[(size_t)2 * N] = sum[2]; o[(size_t)3 * N] = sum[3]; }
            else if (q4 == 1) o[(size_t)4 * N] = sum[0];
        }
    }
}
typedef short bf16x8 __attribute__((ext_vector_type(8)));
typedef float f32x4 __attribute__((ext_vector_type(4)));
typedef unsigned u32x4 __attribute__((ext_vector_type(4)));
typedef float f32x2 __attribute__((ext_vector_type(2)));
typedef unsigned u32x2 __attribute__((ext_vector_type(2)));
constexpr float QK_SCALE_LOG2E = 0.125f * 1.4426950408889634f;
constexpr int AK_STRIDE = 72, AV_STRIDE = 264, ATT_V_OFF = 256 * AK_STRIDE * 2, ATT_B_OFF = ATT_V_OFF + 64 * AV_STRIDE * 2;
__device__ __forceinline__ bf16x8 ldg8(const bf16_t* p) { return *(const bf16x8*)p; }
__device__ __forceinline__ void softmax_pv_step(const f32x4 sa, const f32x4 sb, float& m, float& lsum, f32x4 (&o)[4], const bf16x8 (&vf)[4]) {
    const float mx8 = fmaxf(fmaxf(fmaxf(sa[0], sa[1]), fmaxf(sa[2], sa[3])), fmaxf(fmaxf(sb[0], sb[1]), fmaxf(sb[2], sb[3])));
    if (__builtin_amdgcn_ballot_w64(mx8 > m + 8.f) != 0ull) {
        float mx = fmaxf(mx8, __shfl_xor(mx8, 16)); mx = fmaxf(mx, __shfl_xor(mx, 32));
        const float mn = fmaxf(m, mx), alpha = __builtin_amdgcn_exp2f(m - mn); m = mn; lsum *= alpha;
#pragma unroll
        for (int dt = 0; dt < 4; ++dt) o[dt] = o[dt] * alpha;
    }
    float p[8];
#pragma unroll
    for (int i = 0; i < 4; ++i) { p[i] = __builtin_amdgcn_exp2f(sa[i] - m); p[4 + i] = __builtin_amdgcn_exp2f(sb[i] - m); }
    lsum += ((p[0] + p[1]) + (p[2] + p[3])) + ((p[4] + p[5]) + (p[6] + p[7]));
    u32x4 pw; pw.x = pg8::cvt_pk_bf16(p[0], p[1]); pw.y = pg8::cvt_pk_bf16(p[2], p[3]); pw.z = pg8::cvt_pk_bf16(p[4], p[5]); pw.w = pg8::cvt_pk_bf16(p[6], p[7]);
    const bf16x8 pf = __builtin_bit_cast(bf16x8, pw);
#pragma unroll
    for (int dt = 0; dt < 4; ++dt) o[dt] = __builtin_amdgcn_mfma_f32_16x16x32_bf16(vf[dt], pf, o[dt], 0, 0, 0);
}
__device__ __forceinline__ void softmax_pv_step2(const f32x4 sa, const f32x4 sb, float& m, float& lsum, f32x4 (&o)[4], const bf16x8 (&vf)[4],
                                                 const f32x4 ta, const f32x4 tb, float& m2, float& l2, f32x4 (&o2)[4], const bf16x8 (&vf2)[4]) {
    const float mx8 = fmaxf(fmaxf(fmaxf(sa[0], sa[1]), fmaxf(sa[2], sa[3])), fmaxf(fmaxf(sb[0], sb[1]), fmaxf(sb[2], sb[3])));
    const float nx8 = fmaxf(fmaxf(fmaxf(ta[0], ta[1]), fmaxf(ta[2], ta[3])), fmaxf(fmaxf(tb[0], tb[1]), fmaxf(tb[2], tb[3])));
    if (__builtin_amdgcn_ballot_w64(mx8 > m + 8.f || nx8 > m2 + 8.f) != 0ull) {
        float mx = fmaxf(mx8, __shfl_xor(mx8, 16)); mx = fmaxf(mx, __shfl_xor(mx, 32));
        float nx = fmaxf(nx8, __shfl_xor(nx8, 16)); nx = fmaxf(nx, __shfl_xor(nx, 32));
        const float mn = fmaxf(m, mx), alpha = __builtin_amdgcn_exp2f(m - mn); m = mn; lsum *= alpha;
        const float nn = fmaxf(m2, nx), beta = __builtin_amdgcn_exp2f(m2 - nn); m2 = nn; l2 *= beta;
#pragma unroll
        for (int dt = 0; dt < 4; ++dt) { o[dt] = o[dt] * alpha; o2[dt] = o2[dt] * beta; }
    }
    float p[8], q[8];
#pragma unroll
    for (int i = 0; i < 4; ++i) { p[i] = __builtin_amdgcn_exp2f(sa[i] - m); p[4 + i] = __builtin_amdgcn_exp2f(sb[i] - m); q[i] = __builtin_amdgcn_exp2f(ta[i] - m2); q[4 + i] = __builtin_amdgcn_exp2f(tb[i] - m2); }
    lsum += ((p[0] + p[1]) + (p[2] + p[3])) + ((p[4] + p[5]) + (p[6] + p[7]));
    l2 += ((q[0] + q[1]) + (q[2] + q[3])) + ((q[4] + q[5]) + (q[6] + q[7]));
    u32x4 pw; pw.x = pg8::cvt_pk_bf16(p[0], p[1]); pw.y = pg8::cvt_pk_bf16(p[2], p[3]); pw.z = pg8::cvt_pk_bf16(p[4], p[5]); pw.w = pg8::cvt_pk_bf16(p[6], p[7]);
    u32x4 qw; qw.x = pg8::cvt_pk_bf16(q[0], q[1]); qw.y = pg8::cvt_pk_bf16(q[2], q[3]); qw.z = pg8::cvt_pk_bf16(q[4], q[5]); qw.w = pg8::cvt_pk_bf16(q[6], q[7]);
    const bf16x8 pf = __builtin_bit_cast(bf16x8, pw), qf = __builtin_bit_cast(bf16x8, qw);
#pragma unroll
    for (int dt = 0; dt < 4; ++dt) { o[dt] = __builtin_amdgcn_mfma_f32_16x16x32_bf16(vf[dt], pf, o[dt], 0, 0, 0); o2[dt] = __builtin_amdgcn_mfma_f32_16x16x32_bf16(vf2[dt], qf, o2[dt], 0, 0, 0); }
}
__device__ __forceinline__ void qk_tiles(const bf16x8 a0, const bf16x8 a1, const bf16x8 b0, const bf16x8 b1, const bf16x8 (&qf)[2], f32x4& sa, f32x4& sb) {
    sa = (f32x4){0.f, 0.f, 0.f, 0.f}; sb = (f32x4){0.f, 0.f, 0.f, 0.f};
    sa = __builtin_amdgcn_mfma_f32_16x16x32_bf16(a0, qf[0], sa, 0, 0, 0); sa = __builtin_amdgcn_mfma_f32_16x16x32_bf16(a1, qf[1], sa, 0, 0, 0);
    sb = __builtin_amdgcn_mfma_f32_16x16x32_bf16(b0, qf[0], sb, 0, 0, 0); sb = __builtin_amdgcn_mfma_f32_16x16x32_bf16(b1, qf[1], sb, 0, 0, 0);
}
__device__ __forceinline__ void attn_stage_kv(LAS unsigned char* lds, const bf16_t* ksrc, int krs, const bf16_t* vsrc, int tid) {
    LAS bf16_t* kl = (LAS bf16_t*)lds; LAS bf16_t* vl = (LAS bf16_t*)(lds + ATT_V_OFF);
    bf16x8 kr[4], vr[4];
#pragma unroll
    for (int i = 0; i < 4; ++i) { const int c = tid + NWAVES * 64 * i, row = c >> 3, part = c & 7; kr[i] = ldg8(ksrc + (size_t)row * krs + part * 8); }
#pragma unroll
    for (int i = 0; i < 4; ++i) { const int c = tid + NWAVES * 64 * i, d = c >> 5, part = c & 31; vr[i] = ldg8(vsrc + (size_t)d * 256 + part * 8); }
#pragma unroll
    for (int i = 0; i < 4; ++i) { const int c = tid + NWAVES * 64 * i, row = c >> 3, part = c & 7; *(LAS bf16x8*)(kl + row * AK_STRIDE + part * 8) = kr[i]; }
#pragma unroll
    for (int i = 0; i < 4; ++i) { const int c = tid + NWAVES * 64 * i, d = c >> 5, part = c & 31; *(LAS bf16x8*)(vl + d * AV_STRIDE + part * 8) = vr[i]; }
}
__device__ __forceinline__ void attn_lds_logits(const LAS unsigned char* lds, int k0, const bf16x8 (&qf)[2], f32x4& sa, f32x4& sb, bf16x8 (&vf)[4], int r, int q4) {
    const LAS bf16_t* ka = (const LAS bf16_t*)lds + (k0 + 8 * (r >> 2) + (r & 3)) * AK_STRIDE + 8 * q4;
    const LAS bf16_t* vl = (const LAS bf16_t*)(lds + ATT_V_OFF) + r * AV_STRIDE + 8 * q4 + k0;
    const bf16x8 a0 = *(const LAS bf16x8*)ka, a1 = *(const LAS bf16x8*)(ka + 32), b0 = *(const LAS bf16x8*)(ka + 4 * AK_STRIDE), b1 = *(const LAS bf16x8*)(ka + 4 * AK_STRIDE + 32);
#pragma unroll
    for (int dt = 0; dt < 4; ++dt) vf[dt] = *(const LAS bf16x8*)(vl + dt * 16 * AV_STRIDE);
    qk_tiles(a0, a1, b0, b1, qf, sa, sb);
    sa = sa * QK_SCALE_LOG2E; sb = sb * QK_SCALE_LOG2E;
}
__device__ __forceinline__ void attn_lds_block(const LAS unsigned char* lds, int k0, const bf16x8 (&qf)[2], float& m, float& lsum, f32x4 (&o)[4], int r, int q4) {
    const LAS bf16_t* ka = (const LAS bf16_t*)lds + (k0 + 8 * (r >> 2) + (r & 3)) * AK_STRIDE + 8 * q4;
    const LAS bf16_t* vl = (const LAS bf16_t*)(lds + ATT_V_OFF) + r * AV_STRIDE + 8 * q4 + k0;
    const bf16x8 a0 = *(const LAS bf16x8*)ka, a1 = *(const LAS bf16x8*)(ka + 32), b0 = *(const LAS bf16x8*)(ka + 4 * AK_STRIDE), b1 = *(const LAS bf16x8*)(ka + 4 * AK_STRIDE + 32);
    bf16x8 vf[4];
#pragma unroll
    for (int dt = 0; dt < 4; ++dt) vf[dt] = *(const LAS bf16x8*)(vl + dt * 16 * AV_STRIDE);
    f32x4 sa, sb; qk_tiles(a0, a1, b0, b1, qf, sa, sb);
    sa = sa * QK_SCALE_LOG2E; sb = sb * QK_SCALE_LOG2E;
    softmax_pv_step(sa, sb, m, lsum, o, vf);
}
__device__ __forceinline__ void attn_merge(float& m, float& lsum, f32x4 (&o)[4], const float m2, const float l2, const f32x4 (&o2)[4]) {
    const float mn = fmaxf(m, m2), fa = __builtin_amdgcn_exp2f(m - mn), fb = __builtin_amdgcn_exp2f(m2 - mn);
    m = mn; lsum = lsum * fa + l2 * fb;
#pragma unroll
    for (int dt = 0; dt < 4; ++dt) o[dt] = o[dt] * fa + o2[dt] * fb;
}
__device__ __forceinline__ void attn_store(bf16_t* orow, float lsum, const f32x4 (&o)[4]) {
    lsum += __shfl_xor(lsum, 16); lsum += __shfl_xor(lsum, 32);
    const float inv = 1.f / lsum;
#pragma unroll
    for (int dt = 0; dt < 4; ++dt) { uint2 w; w.x = pg8::cvt_pk_bf16(o[dt][0] * inv, o[dt][1] * inv); w.y = pg8::cvt_pk_bf16(o[dt][2] * inv, o[dt][3] * inv); *(uint2*)(orow + 16 * dt) = w; }
}
__device__ __forceinline__ void attn_ctx_phase(LAS unsigned char* lds, int vcu, int G) {
    const int tid = tid_opaque(), lane = tid & 63, wave = __builtin_amdgcn_readfirstlane(tid >> 6), r = lane & 15, q4 = lane >> 4;
    const bf16_t* Q = (const bf16_t*)(PWS + WS_Q); const bf16_t* K = (const bf16_t*)(PWS + WS_K); const bf16_t* VT = (const bf16_t*)(PWS + WS_VT);
    bf16_t* MIX = (bf16_t*)(PWS + WS_MIX);
    for (int it = vcu; it < BATCH * NH; it += G) {
        const int h = it % NH, b = it / NH;
        static_assert(SEQ / 16 == 2 * NWAVES, "two tasks per wave");
        bf16x8 qa[2][2];
#pragma unroll
        for (int ti = 0; ti < 2; ++ti) { const size_t rq = (size_t)b * SEQ + (wave + ti * NWAVES) * 16 + r; qa[ti][0] = ldg8(Q + rq * NAW + h * HD + 8 * q4); qa[ti][1] = ldg8(Q + rq * NAW + h * HD + 32 + 8 * q4); }
        __syncthreads();
        attn_stage_kv(lds, K + (size_t)b * SEQ * NAW + h * HD, NAW, VT + (size_t)(b * NH + h) * HD * SEQ, tid);
        __syncthreads();
#pragma unroll
        for (int ti = 0; ti < 2; ++ti) {
            const int task = wave + ti * NWAVES;
            const size_t rowq = (size_t)b * SEQ + task * 16 + r;
            bf16x8 qf[2];
            qf[0] = qa[ti][0]; qf[1] = qa[ti][1];
            f32x4 o[4]; float m = -1e30f, lsum = 0.f;
#pragma unroll
            for (int dt = 0; dt < 4; ++dt) o[dt] = (f32x4){0.f, 0.f, 0.f, 0.f};
            f32x4 o2[4]; float m2 = -1e30f, l2 = 0.f;
#pragma unroll
            for (int dt = 0; dt < 4; ++dt) o2[dt] = (f32x4){0.f, 0.f, 0.f, 0.f};
#pragma unroll
            for (int i = 0; i < 4; ++i) { f32x4 sa, sb, ta, tb; bf16x8 v1[4], v2[4];
                attn_lds_logits(lds, 32 * i, qf, sa, sb, v1, r, q4); attn_lds_logits(lds, 128 + 32 * i, qf, ta, tb, v2, r, q4);
                softmax_pv_step2(sa, sb, m, lsum, o, v1, ta, tb, m2, l2, o2, v2); }
            attn_merge(m, lsum, o, m2, l2, o2);
            attn_store(MIX + rowq * D + SSMW + h * HD + 4 * q4, lsum, o);
        }
    }
    __syncthreads();
}
constexpr int NAV_STRIDE = 520, NA_WV_OFF = 512 * AK_STRIDE * 2, NA_WB_OFF = NA_WV_OFF + 64 * NAV_STRIDE * 2;
static_assert(NA_WB_OFF + 15 * 32 * 4 <= LDS_CTL_OFF && ATT_V_OFF + 64 * AV_STRIDE * 2 <= NA_WB_OFF, "NA lds map");
__device__ __forceinline__ void na_stage_window(LAS unsigned char* lds, const bf16_t* kg, const bf16_t* vg, int row0, int nrows, int tid) {
    LAS bf16_t* kl = (LAS bf16_t*)lds; LAS bf16_t* vl = (LAS bf16_t*)(lds + NA_WV_OFF);
    const int ntok = nrows * 64;
    {
        bf16x8 kr[8];
#pragma unroll
        for (int i = 0; i < 8; ++i) { const int c = tid + NWAVES * 64 * i, part = c & 7; int tok = c >> 3; tok = tok < ntok ? tok : ntok - 1; kr[i] = ldg8(kg + (size_t)(row0 * GW + tok) * NAW + part * 8); }
#pragma unroll
        for (int i = 0; i < 8; ++i) { const int c = tid + NWAVES * 64 * i, tok = c >> 3, part = c & 7; if (tok < ntok) *(LAS bf16x8*)(kl + tok * AK_STRIDE + part * 8) = kr[i]; }
    }
    {
        bf16x8 vr[8];
#pragma unroll
        for (int i = 0; i < 8; ++i) { const int c = tid + NWAVES * 64 * i, d = c >> 6; int part = c & 63; part = part * 8 < ntok ? part : (ntok >> 3) - 1; vr[i] = ldg8(vg + (size_t)d * DSEQ + row0 * GW + part * 8); }
#pragma unroll
        for (int i = 0; i < 8; ++i) { const int c = tid + NWAVES * 64 * i, d = c >> 6, part = c & 63; if (part * 8 < ntok) *(LAS bf16x8*)(vl + d * NAV_STRIDE + part * 8) = vr[i]; }
    }
}
__device__ __forceinline__ void attn_na_phase(LAS unsigned char* lds, int l, int vcu, int G) {
    const int tid = tid_opaque(), lane = tid & 63, wave = __builtin_amdgcn_readfirstlane(tid >> 6), r = lane & 15, q4 = lane >> 4;
    const bf16_t* Q = (const bf16_t*)(PWS + WS_Q); const bf16_t* K = (const bf16_t*)(PWS + WS_K); const bf16_t* VT = (const bf16_t*)(PWS + WS_VT);
    bf16_t* MIX = (bf16_t*)(PWS + WS_MIX);
    const float* rpb_l = PIN(27) + (size_t)l * NH * 15 * 31;
    const int koff = 8 * (r >> 2) + (r & 3);
    constexpr int NT = 2, IR = 2 * NT;
    const int nb = wave & 3, rl0 = wave >> 2;
    const int qcol = nb * 16 + r;
    int kc0 = nb * 16 - 8; kc0 = kc0 < 0 ? 0 : (kc0 > GW - 32 ? GW - 32 : kc0);
    int cs = qcol - 8; cs = cs < 0 ? 0 : (cs > GW - 16 ? GW - 16 : cs);
    int bidx[8];
#pragma unroll
    for (int i = 0; i < 8; ++i) { const int kcol = kc0 + 8 * q4 + i; const bool valid = kcol >= cs && kcol < cs + 16;
        int dc = kcol - qcol + 15; dc = dc < 0 ? 0 : (dc > 30 ? 30 : dc); bidx[i] = valid ? dc : 31; }
    for (int it = vcu; it < DB * NH * (GW / IR); it += G) {
        const int rg = it % (GW / IR), h = (it / (GW / IR)) % NH, b = it / ((GW / IR) * NH);
        const int R0 = rg * IR;
        int lo = R0 - 4; lo = lo < 0 ? 0 : (lo > GW - 8 ? GW - 8 : lo);
        int hi = R0 + IR - 1 - 4; hi = (hi < 0 ? 0 : (hi > GW - 8 ? GW - 8 : hi)) + 7;
        const bf16_t* kg = K + ((size_t)MC + (size_t)b * DSEQ) * NAW + h * HD;
        const bf16_t* vg = VT + (size_t)MC * NAW + (size_t)(b * NH + h) * HD * DSEQ;
        const bf16_t* qbase = Q + ((size_t)MC + (size_t)b * DSEQ + (R0 + rl0) * GW + qcol) * NAW + h * HD + 8 * q4;
        bf16x8 qa[NT][2];
#pragma unroll
        for (int t = 0; t < NT; ++t) { qa[t][0] = ldg8(qbase + (size_t)t * 2 * GW * NAW); qa[t][1] = ldg8(qbase + (size_t)t * 2 * GW * NAW + 32); }
        __syncthreads();
        attn_stage_kv(lds, (const bf16_t*)(PWS + WS_CK) + (((size_t)l * DB + b) * NH + h) * PAST * HD, HD, (const bf16_t*)(PWS + WS_CVT) + (((size_t)l * DB + b) * NH + h) * HD * PAST, tid);
        if (tid < 15 * 32) { const int dr = tid >> 5, dc = tid & 31; ((LAS float*)(lds + NA_WB_OFF))[tid] = dc < 31 ? rpb_l[(size_t)h * 15 * 31 + dr * 31 + dc] * 1.4426950408889634f : -1e30f; }
        __syncthreads();
        f32x4 o[NT][4]; float m[NT], ls[NT];
#pragma unroll
        for (int t = 0; t < NT; ++t) {
            bf16x8 qf[2]; qf[0] = qa[t][0]; qf[1] = qa[t][1];
            m[t] = -1e30f; ls[t] = 0.f;
#pragma unroll
            for (int dt = 0; dt < 4; ++dt) o[t][dt] = (f32x4){0.f, 0.f, 0.f, 0.f};
#pragma unroll 2
            for (int k0 = 0; k0 < PAST; k0 += 32) { f32x4 sa, sb; bf16x8 v1[4];
                attn_lds_logits(lds, k0, qf, sa, sb, v1, r, q4);
                softmax_pv_step(sa, sb, m[t], ls[t], o[t], v1); }
            __builtin_amdgcn_sched_barrier(0);
        }
        const LAS float* btab = (const LAS float*)(lds + NA_WB_OFF);
#pragma unroll 1
        for (int pass = 0; pass < 2; ++pass) {
            const int base = lo + 8 * pass, nrows = pass == 0 ? 8 : hi - (lo + 8) + 1;
            __syncthreads();
            na_stage_window(lds, kg, vg, base, nrows, tid);
            __syncthreads();
#pragma unroll
            for (int t = 0; t < NT; ++t) {
                const int row = R0 + rl0 + 2 * t;
                bf16x8 qf[2]; qf[0] = qa[t][0]; qf[1] = qa[t][1];
                int rs = row - 4; rs = rs < 0 ? 0 : (rs > GW - 8 ? GW - 8 : rs);
#pragma unroll 1
                for (int sl = 0; sl < nrows; ++sl) {
                    const int wr = base + sl;
                    if (wr < rs || wr >= rs + 8) continue;
                    const LAS bf16_t* ka = (const LAS bf16_t*)lds + (sl * GW + kc0 + koff) * AK_STRIDE + 8 * q4;
                    const LAS bf16_t* vl = (const LAS bf16_t*)(lds + NA_WV_OFF) + r * NAV_STRIDE + sl * GW + kc0 + 8 * q4;
                    const bf16x8 a0 = *(const LAS bf16x8*)ka, a1 = *(const LAS bf16x8*)(ka + 32), b0 = *(const LAS bf16x8*)(ka + 4 * AK_STRIDE), b1 = *(const LAS bf16x8*)(ka + 4 * AK_STRIDE + 32);
                    bf16x8 vf[4];
#pragma unroll
                    for (int dt = 0; dt < 4; ++dt) vf[dt] = *(const LAS bf16x8*)(vl + dt * 16 * NAV_STRIDE);
                    f32x4 sa, sb; qk_tiles(a0, a1, b0, b1, qf, sa, sb);
                    const LAS float* brow = btab + (wr - row + 7) * 32;
#pragma unroll
                    for (int i = 0; i < 4; ++i) { sa[i] = fmaf(sa[i], QK_SCALE_LOG2E, brow[bidx[i]]); sb[i] = fmaf(sb[i], QK_SCALE_LOG2E, brow[bidx[4 + i]]); }
                    softmax_pv_step(sa, sb, m[t], ls[t], o[t], vf);
                }
                __builtin_amdgcn_sched_barrier(0);
            }
        }
#pragma unroll
        for (int t = 0; t < NT; ++t) {
            const size_t rowq = (size_t)MC + (size_t)b * DSEQ + (R0 + rl0 + 2 * t) * GW + qcol;
            attn_store(MIX + rowq * D + SSMW + h * HD + 4 * q4, ls[t], o[t]);
        }
    }
    __syncthreads();
}
constexpr int GT_STRIDE = 136;
template <int GLO, int GHI>
__device__ __forceinline__ void gate_item(LAS unsigned char* lds, int l, int it, int tid, int wave, int r, int q4) {
    LAS bf16_t* vt = (LAS bf16_t*)lds;
    const bf16_t* VG = (const bf16_t*)(PWS + WS_VG); const bf16_t* U = (const bf16_t*)(PWS + WS_U);
    const bf16_t* wsb = (const bf16_t*)(PWS + WS_WSB) + (size_t)l * 4 * 128 * 128;
    const float* bs = PIN(29) + (size_t)l * 4 * 128;
    bf16_t* MIX = (bf16_t*)(PWS + WS_MIX);
    {
        const size_t base = (size_t)it * 128;
        const int i = wave * 16 + r;
        bf16x8 bfrag[4][4];
#pragma unroll
        for (int g = GLO; g < GHI; ++g)
#pragma unroll
            for (int ks = 0; ks < 4; ++ks) bfrag[g][ks] = ldg8(wsb + ((size_t)g * 128 + i) * 128 + 8 * q4 + 32 * ks);
        uint2 uu[4][4]; float bsv[4];
#pragma unroll
        for (int g = GLO; g < GHI; ++g) { bsv[g] = bs[g * 128 + i];
#pragma unroll
            for (int ct = 0; ct < 4; ++ct) uu[g][ct] = *(const uint2*)(U + (base + i) * GMW + g * 64 + ct * 16 + 4 * q4); }
        __syncthreads();
        {
            const int t = tid >> 2, qc = tid & 3;
            const u32x4* vr = (const u32x4*)(VG + (base + t) * GMW + 64 * qc);
            u32x4 raw[8];
#pragma unroll
            for (int j = 0; j < 8; ++j) raw[j] = vr[j];
            float x[64]; float sm = 0.f;
#pragma unroll
            for (int j = 0; j < 8; ++j)
#pragma unroll
                for (int e = 0; e < 4; ++e) { x[8 * j + 2 * e] = __uint_as_float(raw[j][e] << 16); x[8 * j + 2 * e + 1] = __uint_as_float(raw[j][e] & 0xffff0000u); sm += x[8 * j + 2 * e] + x[8 * j + 2 * e + 1]; }
            sm += __shfl_xor(sm, 1); sm += __shfl_xor(sm, 2);
            const float mean = sm * (1.f / GMW);
            float sq = 0.f;
#pragma unroll
            for (int c = 0; c < 64; ++c) { x[c] -= mean; sq += x[c] * x[c]; }
            sq += __shfl_xor(sq, 1); sq += __shfl_xor(sq, 2);
            const float rstd = rsqrtf(sq * (1.f / GMW) + 1e-5f);
            if (qc >= GLO && qc < GHI) {
#pragma unroll
                for (int c = 0; c < 64; ++c) vt[(64 * qc + c) * GT_STRIDE + t] = f2bf(x[c] * rstd);
            }
        }
        __syncthreads();
#pragma unroll
        for (int g = GLO; g < GHI; ++g) {
            f32x4 acc[4];
#pragma unroll
            for (int ct = 0; ct < 4; ++ct) acc[ct] = (f32x4){0.f, 0.f, 0.f, 0.f};
#pragma unroll
            for (int ks = 0; ks < 4; ++ks)
#pragma unroll
                for (int ct = 0; ct < 4; ++ct) {
                    const bf16x8 afrag = *(const LAS bf16x8*)(vt + (g * 64 + ct * 16 + r) * GT_STRIDE + 32 * ks + 8 * q4);
                    acc[ct] = __builtin_amdgcn_mfma_f32_16x16x32_bf16(afrag, bfrag[g][ks], acc[ct], 0, 0, 0);
                }
#pragma unroll
            for (int ct = 0; ct < 4; ++ct) {
                const int ch = g * 64 + ct * 16 + 4 * q4;
                const float u0 = __uint_as_float(uu[g][ct].x << 16), u1 = __uint_as_float(uu[g][ct].x & 0xffff0000u), u2 = __uint_as_float(uu[g][ct].y << 16), u3 = __uint_as_float(uu[g][ct].y & 0xffff0000u);
                uint2 w; w.x = pg8::cvt_pk_bf16(u0 * (acc[ct][0] + bsv[g]), u1 * (acc[ct][1] + bsv[g])); w.y = pg8::cvt_pk_bf16(u2 * (acc[ct][2] + bsv[g]), u3 * (acc[ct][3] + bsv[g]));
                *(uint2*)(MIX + (base + i) * D + SSMW + NAW + ch) = w;
            }
        }
    }
}
__device__ __forceinline__ void gate_phase(LAS unsigned char* lds, int l, int first, int stride) {
    const int tid = tid_opaque(), lane = tid & 63, wave = __builtin_amdgcn_readfirstlane(tid >> 6), r = lane & 15, q4 = lane >> 4;
    for (int it = first; it < MT / 128; it += stride) gate_item<0, 4>(lds, l, it, tid, wave, r, q4);
    __syncthreads();
}
__device__ __forceinline__ void gate_phase_split(LAS unsigned char* lds, int l, int rb, int nb) {
    const int tid = tid_opaque(), lane = tid & 63, wave = __builtin_amdgcn_readfirstlane(tid >> 6), r = lane & 15, q4 = lane >> 4;
    gate_item<0, 4>(lds, l, rb, tid, wave, r, q4);
    if (rb & 1) gate_item<2, 4>(lds, l, nb + (rb >> 1), tid, wave, r, q4); else gate_item<0, 2>(lds, l, nb + (rb >> 1), tid, wave, r, q4);
    __syncthreads();
}
constexpr int CH = 64, NCHUNK = MT / CH;
constexpr int BU_STRIDE = 132, SB_STRIDE = 136, YB_STRIDE = 264;
constexpr int SSM_WAVE_BYTES = 16 * BU_STRIDE * 4 + 16 * SB_STRIDE * 2, SSM_YB_OFF = NWAVES * SSM_WAVE_BYTES;
static_assert(SSM_WAVE_BYTES % 16 == 0 && SSM_YB_OFF + CH * YB_STRIDE * 2 <= LDS_CTL_OFF, "ssm lds map");
__device__ __forceinline__ float2 cmul(float2 a, float2 b) { return make_float2(a.x * b.x - a.y * b.y, a.x * b.y + a.y * b.x); }
__device__ __forceinline__ float2 cfma(float2 a, float2 b, float2 c) { return make_float2(fmaf(a.x, b.x, fmaf(-a.y, b.y, c.x)), fmaf(a.x, b.y, fmaf(a.y, b.x, c.y))); }
__device__ __forceinline__ void ssm_load_bm(bf16x8 (&bm)[8], const bf16x8* BMFg, int lane) {
#pragma unroll
    for (int tau = 0; tau < 8; ++tau) bm[tau] = BMFg[tau * 64 + lane];
}
__device__ __forceinline__ bf16x8 ssm_cvt_u(const f32x4 a, const f32x4 b, int q4) {
    const float u[8] = {a[0], a[1], a[2], a[3], b[0], b[1], b[2], b[3]};
    u32x4 w; unsigned ww[4];
#pragma unroll
    for (int i = 0; i < 4; ++i) {
        const unsigned hp = pg8::cvt_pk_bf16(u[2 * i], u[2 * i + 1]);
        const unsigned lp = pg8::cvt_pk_bf16(u[2 * i] - __uint_as_float(hp << 16), u[2 * i + 1] - __uint_as_float(hp & 0xffff0000u));
        ww[i] = (q4 & 2) ? lp : hp;
    }
    w.x = ww[0]; w.y = ww[1]; w.z = ww[2]; w.w = ww[3];
    return __builtin_bit_cast(bf16x8, w);
}
__device__ __forceinline__ bf16x8 ssm_load_u(const float* XS, size_t trow0, int g, int r, int q4) {
    const f32x4* src = (const f32x4*)(XS + (trow0 + r) * SSMW + g * SC + 8 * (q4 & 1));
    return ssm_cvt_u(src[0], src[1], q4);
}
__device__ __forceinline__ void ssm_bu_to_lds(LAS float* bul, const bf16x8 (&bm)[8], const bf16x8 uf, int r, int q4) {
#pragma unroll
    for (int tau = 0; tau < 8; ++tau) {
        const f32x4 d = __builtin_amdgcn_mfma_f32_16x16x32_bf16(bm[tau], uf, (f32x4){0.f, 0.f, 0.f, 0.f}, 0, 0, 0);
        *(LAS f32x4*)(bul + r * BU_STRIDE + 16 * tau + 4 * q4) = d;
    }
}
template <int DIR> __device__ __forceinline__ float2 ssm_dir_a(const bf16x8 (&uf)[4], LAS float* bul, const float2* LB, int l, int g, int lane, int r, int q4) {
    constexpr int d = DIR;
    const int pbase = ((l * 2 + d) * SG + g) * SP;
    const float2 lb = LB[pbase + lane];
    bf16x8 bm[8]; ssm_load_bm(bm, (const bf16x8*)(PWS + WS_BMF) + (size_t)((l * 2 + d) * SG + g) * 8 * 64, lane);
    float2 s = make_float2(0.f, 0.f);
    const LAS float* brd = bul + 2 * lane;
#pragma unroll
    for (int si = 0; si < 4; ++si) {
        ssm_bu_to_lds(bul, bm, uf[d ? 3 - si : si], r, q4);
#pragma unroll
        for (int step = 0; step < 16; ++step) { const f32x2 bv2 = *(const LAS f32x2*)(brd + (d ? 15 - step : step) * BU_STRIDE); s = cfma(lb, s, make_float2(bv2[0], bv2[1])); }
    }
    return s;
}
__device__ __forceinline__ void ssm_pass_a(LAS unsigned char* lds, int l, int vcu, int G) {
    const int tid = tid_opaque(), lane = tid & 63, wave = __builtin_amdgcn_readfirstlane(tid >> 6), r = lane & 15, q4 = lane >> 4;
    LAS float* bul = (LAS float*)(lds + wave * SSM_WAVE_BYTES);
    const float* XS = (const float*)(PWS + WS_XSSM);
    const float2* LB = (const float2*)(PWS + WS_SSMP);
    float2* E = (float2*)(PWS + WS_E);
    for (int it = vcu; it < 2 * NCHUNK; it += G) {
        const int ci = it >> 1, g = wave * 2 + (it & 1);
        bf16x8 uf[4];
        {
            f32x4 ur[4][2];
#pragma unroll
            for (int sub = 0; sub < 4; ++sub) { const f32x4* src = (const f32x4*)(XS + ((size_t)ci * CH + sub * 16 + r) * SSMW + g * SC + 8 * (q4 & 1)); ur[sub][0] = src[0]; ur[sub][1] = src[1]; }
#pragma unroll
            for (int sub = 0; sub < 4; ++sub) uf[sub] = ssm_cvt_u(ur[sub][0], ur[sub][1], q4);
        }
        float2 se[2];
        se[0] = ssm_dir_a<0>(uf, bul, LB, l, g, lane, r, q4);
        se[1] = ssm_dir_a<1>(uf, bul, LB, l, g, lane, r, q4);
#pragma unroll
        for (int d = 0; d < 2; ++d) E[((size_t)ci * 2 + d) * SG * SP + g * SP + lane] = se[d];
    }
}
__device__ __forceinline__ void ssm_carry(int l, int vcu, int G) {
    const int tid = tid_opaque(), lane = tid & 63, wave = __builtin_amdgcn_readfirstlane(tid >> 6);
    const float2* LB = (const float2*)(PWS + WS_SSMP);
    const float2* E = (const float2*)(PWS + WS_E); float2* SIN = (float2*)(PWS + WS_SIN);
    const float* st0 = PIN(5);
    for (int wi = wave * G + vcu; wi < (BATCH + DB) * 2 * SG; wi += G * NWAVES) {
        const bool lat = wi < DB * 2 * SG;
        const int w2 = lat ? wi : wi - DB * 2 * SG, g = w2 % SG, d = (w2 / SG) & 1, sq = w2 / (2 * SG);
        const int nC = lat ? DSEQ / CH : SEQ / CH, cbase = lat ? MC / CH + sq * (DSEQ / CH) : sq * (SEQ / CH);
        float2 lt = LB[((l * 2 + d) * SG + g) * SP + lane];
#pragma unroll
        for (int i = 0; i < 6; ++i) lt = cmul(lt, lt);
        float2 s = make_float2(0.f, 0.f);
        if (lat) { const float* st = st0 + (((((size_t)sq * DEPTH + l) * 2 + d) * SG + g) * SP + lane) * 2; s = make_float2(st[0], st[1]); }
        const size_t off = (size_t)d * SG * SP + g * SP + lane, cs = (size_t)2 * SG * SP;
        if (lat) {
#pragma unroll 1
            for (int k0 = 0; k0 < DSEQ / CH; k0 += 32) {
                float2 e[32];
#pragma unroll
                for (int k = 0; k < 32; ++k) e[k] = E[(size_t)(cbase + (d ? DSEQ / CH - 1 - (k0 + k) : k0 + k)) * cs + off];
#pragma unroll
                for (int k = 0; k < 32; ++k) { SIN[(size_t)(cbase + (d ? DSEQ / CH - 1 - (k0 + k) : k0 + k)) * cs + off] = s; s = cfma(lt, s, e[k]); }
            }
        } else {
            float2 e[SEQ / CH];
#pragma unroll
            for (int k = 0; k < SEQ / CH; ++k) e[k] = E[(size_t)(cbase + (d ? SEQ / CH - 1 - k : k)) * cs + off];
#pragma unroll
            for (int k = 0; k < SEQ / CH; ++k) { SIN[(size_t)(cbase + (d ? SEQ / CH - 1 - k : k)) * cs + off] = s; s = cfma(lt, s, e[k]); }
        }
    }
}
template <int DIR> __device__ __forceinline__ float2 ssm_dir_b(f32x4 (&yg)[4], const bf16x8 (&uf)[4], LAS float* bul, LAS bf16_t* sbw, const float2* LB, const float2* SIN,
                                                          int l, int g, int ci, int lane, int r, int q4) {
    constexpr int d = DIR;
    const int pbase = ((l * 2 + d) * SG + g) * SP;
    const float2 lb = LB[pbase + lane];
    float2 s = SIN[((size_t)ci * 2 + d) * SG * SP + g * SP + lane];
    bf16x8 bm[8]; ssm_load_bm(bm, (const bf16x8*)(PWS + WS_BMF) + (size_t)((l * 2 + d) * SG + g) * 8 * 64, lane);
    bf16x8 cf[4];
    { const bf16x8* cff = (const bf16x8*)(PWS + WS_CFF) + (size_t)((l * 2 + d) * SG + g) * 4 * 64 + lane;
#pragma unroll
      for (int ks = 0; ks < 4; ++ks) cf[ks] = cff[ks * 64]; }
    const LAS float* brd = bul + 2 * lane; LAS bf16_t* swr = sbw + 2 * lane; const LAS bf16_t* srd = sbw + r * SB_STRIDE + 8 * q4;
#pragma unroll
    for (int si = 0; si < 4; ++si) {
        constexpr int dummy = 0; (void)dummy;
        const int sub = d ? 3 - si : si;
        ssm_bu_to_lds(bul, bm, uf[sub], r, q4);
        f32x2 buv[16];
#pragma unroll
        for (int step = 0; step < 16; ++step) buv[step] = *(const LAS f32x2*)(brd + (d ? 15 - step : step) * BU_STRIDE);
#pragma unroll
        for (int step = 0; step < 16; ++step) { s = cfma(lb, s, make_float2(buv[step][0], buv[step][1]));
            *(LAS unsigned*)(swr + (d ? 15 - step : step) * SB_STRIDE) = pg8::cvt_pk_bf16(s.x, s.y); }
#pragma unroll
        for (int ks = 0; ks < 4; ++ks) {
            const bf16x8 sf = *(const LAS bf16x8*)(srd + 32 * ks);
            yg[sub] = __builtin_amdgcn_mfma_f32_16x16x32_bf16(cf[ks], sf, yg[sub], 0, 0, 0);
        }
    }
    return s;
}
__device__ __forceinline__ void ssm_group_b(f32x4 (&yg)[4], float2 (&sfin)[2], const bf16x8 (&uf)[4], const f32x4 (&us)[4], LAS float* bul, LAS bf16_t* sbw, LAS bf16_t* yb, const float2* LB, const float2* SIN,
                                            int l, int g, int ci, int lane, int r, int q4) {
#pragma unroll
    for (int s = 0; s < 4; ++s) yg[s] = (f32x4){0.f, 0.f, 0.f, 0.f};
    const f32x4 dv = *(const f32x4*)(PIN(22) + l * SSMW + g * SC + 4 * q4);
    sfin[0] = ssm_dir_b<0>(yg, uf, bul, sbw, LB, SIN, l, g, ci, lane, r, q4);
    sfin[1] = ssm_dir_b<1>(yg, uf, bul, sbw, LB, SIN, l, g, ci, lane, r, q4);
#pragma unroll
    for (int sub = 0; sub < 4; ++sub) {
        const int t = sub * 16 + r;
#pragma unroll
        for (int i = 0; i < 4; ++i) yg[sub][i] = pg8::gelu_fast(fmaf(dv[i], us[sub][i], yg[sub][i]));
        u32x2 w; w[0] = pg8::cvt_pk_bf16(yg[sub][0], yg[sub][1]); w[1] = pg8::cvt_pk_bf16(yg[sub][2], yg[sub][3]);
        *(LAS u32x2*)(yb + t * YB_STRIDE + g * SC + 4 * q4) = w;
    }
}
__device__ __forceinline__ void ssm_pass_b(LAS unsigned char* lds, int l, int vcu, int G) {
    const int tid = tid_opaque(), lane = tid & 63, wave = __builtin_amdgcn_readfirstlane(tid >> 6), r = lane & 15, q4 = lane >> 4;
    LAS float* bul = (LAS float*)(lds + wave * SSM_WAVE_BYTES);
    LAS bf16_t* sbw = (LAS bf16_t*)(lds + wave * SSM_WAVE_BYTES + 16 * BU_STRIDE * 4);
    LAS bf16_t* yb = (LAS bf16_t*)(lds + SSM_YB_OFF);
    const float* XS = (const float*)(PWS + WS_XSSM);
    const float2* LB = (const float2*)(PWS + WS_SSMP); const float2* BB = (const float2*)(PWS + WS_SSMP + 64 * 1024);
    const float2* SIN = (const float2*)(PWS + WS_SIN);
    const bf16_t* glt = (const bf16_t*)(PWS + WS_GLT) + (size_t)l * SSMW * SSMW;
    bf16_t* MIX = (bf16_t*)(PWS + WS_MIX);
    for (int ci = vcu; ci < NCHUNK; ci += G) {
        const bool lat = ci >= MC / CH;
        const int sq = lat ? (ci - MC / CH) / (DSEQ / CH) : ci / (SEQ / CH);
        const int nC = lat ? DSEQ / CH : SEQ / CH, cbase = lat ? MC / CH + sq * (DSEQ / CH) : sq * (SEQ / CH), k = ci - cbase;
        __syncthreads();
        bf16x8 uf[2][4]; f32x4 us[2][4];
        {
            f32x4 ur[2][4][2];
#pragma unroll
            for (int gi = 0; gi < 2; ++gi)
#pragma unroll
                for (int sub = 0; sub < 4; ++sub) { const f32x4* src = (const f32x4*)(XS + ((size_t)ci * CH + sub * 16 + r) * SSMW + (wave * 2 + gi) * SC + 8 * (q4 & 1)); ur[gi][sub][0] = src[0]; ur[gi][sub][1] = src[1]; }
#pragma unroll
            for (int gi = 0; gi < 2; ++gi)
#pragma unroll
                for (int sub = 0; sub < 4; ++sub) us[gi][sub] = *(const f32x4*)(XS + ((size_t)ci * CH + sub * 16 + r) * SSMW + (wave * 2 + gi) * SC + 4 * q4);
#pragma unroll
            for (int gi = 0; gi < 2; ++gi)
#pragma unroll
                for (int sub = 0; sub < 4; ++sub) uf[gi][sub] = ssm_cvt_u(ur[gi][sub][0], ur[gi][sub][1], q4);
        }
        f32x4 yg0[4], yg1[4]; float2 sf0[2], sf1[2];
        ssm_group_b(yg0, sf0, uf[0], us[0], bul, sbw, yb, LB, SIN, l, wave * 2 + 0, ci, lane, r, q4);
        ssm_group_b(yg1, sf1, uf[1], us[1], bul, sbw, yb, LB, SIN, l, wave * 2 + 1, ci, lane, r, q4);
        const float* gb = PIN(24) + l * SSMW;
        bf16x8 af[8][2];
#pragma unroll
        for (int ks = 0; ks < 8; ++ks)
#pragma unroll
            for (int a = 0; a < 2; ++a) af[ks][a] = ldg8(glt + (size_t)(wave * 32 + a * 16 + r) * SSMW + 32 * ks + 8 * q4);
        f32x4 gbv[2];
#pragma unroll
        for (int a = 0; a < 2; ++a) gbv[a] = *(const f32x4*)(gb + wave * 32 + a * 16 + 4 * q4);
        __syncthreads();
        f32x4 z[2][4];
#pragma unroll
        for (int a = 0; a < 2; ++a)
#pragma unroll
            for (int b = 0; b < 4; ++b) z[a][b] = (f32x4){0.f, 0.f, 0.f, 0.f};
#pragma unroll
        for (int ks = 0; ks < 8; ++ks) {
            bf16x8 bfv[4];
#pragma unroll
            for (int b = 0; b < 4; ++b) bfv[b] = *(const LAS bf16x8*)(yb + (b * 16 + r) * YB_STRIDE + 32 * ks + 8 * q4);
#pragma unroll
            for (int a = 0; a < 2; ++a)
#pragma unroll
                for (int b = 0; b < 4; ++b) z[a][b] = __builtin_amdgcn_mfma_f32_16x16x32_bf16(af[ks][a], bfv[b], z[a][b], 0, 0, 0);
        }
#pragma unroll
        for (int a = 0; a < 2; ++a) {
            const int n = wave * 32 + a * 16 + 4 * q4;
            const f32x4 bv = gbv[a];
#pragma unroll
            for (int b = 0; b < 4; ++b) {
                const f32x4 yv = a ? yg1[b] : yg0[b];
                float o[4];
#pragma unroll
                for (int i = 0; i < 4; ++i) o[i] = yv[i] * __builtin_amdgcn_rcpf(1.f + __builtin_amdgcn_exp2f(-1.4426950408889634f * (z[a][b][i] + bv[i])));
                uint2 w; w.x = pg8::cvt_pk_bf16(o[0], o[1]); w.y = pg8::cvt_pk_bf16(o[2], o[3]);
                *(uint2*)(MIX + ((size_t)ci * CH + b * 16 + r) * D + n) = w;
            }
        }
        if (!lat) {
#pragma unroll
            for (int gi = 0; gi < 2; ++gi)
#pragma unroll
                for (int d = 0; d < 2; ++d)
                    if (d ? k == 0 : k == nC - 1) { const float2 sv = gi ? sf1[d] : sf0[d];
                        float* o = POUT + O_ST + (((((size_t)sq * DEPTH + l) * 2 + d) * SG + wave * 2 + gi) * SP + lane) * 2; o[0] = sv.x; o[1] = sv.y; }
        }
    }
    __syncthreads();
}

#define XB_TMO      128
#define XB_XCNT(j)  (256  + 64 * (j))
#define XB_XSUB(j)  (1280 + 64 * (j))
#define XB_XGEN(j)  (2304 + 64 * (j))
#define XB_TOP      3328
#define XB_TOPGEN   3392
#define XCD_BAR_WORDS 3456
#define XB_SPIN_CAP (1u << 18)

__device__ __forceinline__ unsigned xb_ld(unsigned* p)              { return __hip_atomic_load(p, __ATOMIC_RELAXED, __HIP_MEMORY_SCOPE_AGENT); }
__device__ __forceinline__ unsigned xb_add(unsigned* p, unsigned v) { return __hip_atomic_fetch_add(p, v, __ATOMIC_RELAXED, __HIP_MEMORY_SCOPE_AGENT); }
__device__ __forceinline__ unsigned xb_xcc_id() { return (unsigned)__builtin_amdgcn_s_getreg((3 << 11) | 20) & 0xFu; }
#define XB_SPIN(cond, bar) do { unsigned _sp = 0; while (cond) { __builtin_amdgcn_s_sleep(1); \
    if ((++_sp & 255u) == 0u) { if (xb_ld(&(bar)[XB_TMO])) break; if (_sp > XB_SPIN_CAP) { atomicAdd(&(bar)[XB_TMO], 1u); break; } } } } while (0)

struct XcdBarrier {
    unsigned* bar; unsigned x;
    volatile LAS unsigned* st;
};

__device__ __forceinline__ XcdBarrier xcd_barrier_post(unsigned* bar, volatile LAS unsigned* st) {
    XcdBarrier b; b.bar = bar; b.x = xb_xcc_id(); b.st = st;
    if (threadIdx.x == 0) (void)xb_add(&bar[XB_XCNT(b.x)], 1u);
    return b;
}
__device__ __forceinline__ void xcd_barrier_complete(unsigned* bar, unsigned x, unsigned& nloc, unsigned& nx) {
    const unsigned G = gridDim.x * gridDim.y * gridDim.z;
    unsigned sum, cnt, mine, sp = 0u;
    for (;;) {
        sum = 0u; cnt = 0u; mine = 0u;
#pragma unroll
        for (unsigned j = 0; j < 16; ++j) { const unsigned c = xb_ld(&bar[XB_XCNT(j)]); sum += c; cnt += (c > 0u) ? 1u : 0u; mine = (j == x) ? c : mine; }
        if (sum == G) break;
        __builtin_amdgcn_s_sleep(1);
        if ((++sp & 255u) == 0u) { if (xb_ld(&bar[XB_TMO])) break; if (sp > XB_SPIN_CAP) { atomicAdd(&bar[XB_TMO], 1u); break; } }
    }
    nloc = mine > 0u ? mine : 1u; nx = cnt > 0u ? cnt : 1u;
}

__device__ __forceinline__ void xcd_barrier(const XcdBarrier& b) {
    asm volatile("s_waitcnt vmcnt(0)" ::: "memory");
    __syncthreads();
    if (threadIdx.x == 0) {
        unsigned* bar = b.bar;
        __builtin_amdgcn_s_waitcnt(0);
        unsigned nloc = b.st[0], nx = b.st[1];
        if (nloc == 0u) { xcd_barrier_complete(bar, b.x, nloc, nx); b.st[0] = nloc; b.st[1] = nx; }
        const unsigned old = xb_add(&bar[XB_XSUB(b.x)], 1u);
        const unsigned gen = old / nloc;
        if (old + 1u == (gen + 1u) * nloc) {
            __builtin_amdgcn_fence(__ATOMIC_RELEASE, "agent");
            asm volatile("s_waitcnt vmcnt(0)" ::: "memory");
            const unsigned og = xb_add(&bar[XB_TOP], 1u);
            const unsigned tg = og / nx;
            if (og + 1u == (tg + 1u) * nx) xb_add(&bar[XB_TOPGEN], 1u);
            else XB_SPIN(xb_ld(&bar[XB_TOPGEN]) == tg, bar);
            __builtin_amdgcn_fence(__ATOMIC_ACQUIRE, "agent");
            xb_add(&bar[XB_XGEN(b.x)], 1u);
            asm volatile("s_waitcnt vmcnt(0)" ::: "memory");
        } else {
            XB_SPIN(xb_ld(&bar[XB_XGEN(b.x)]) == gen, bar);
            __builtin_amdgcn_fence(__ATOMIC_ACQUIRE, "agent");
            asm volatile("s_waitcnt vmcnt(0)" ::: "memory");
        }
    }
    __syncthreads();
}

__device__ __forceinline__ void passa_arrive(LAS unsigned char* lds, int l) {
    asm volatile("s_waitcnt vmcnt(0)" ::: "memory");
    __syncthreads();
    if (threadIdx.x == 0) {
        unsigned* ctl = (unsigned*)(PWS + WS_CTL); volatile LAS unsigned* st = (volatile LAS unsigned*)(lds + LDS_CTL_OFF);
        const unsigned nloc = st[0], x = xb_xcc_id();
        const unsigned old = xb_add(&ctl[CW_PASSA + 64 * (16 * l + (int)x)], 1u);
        if (old + 1u == nloc) { __builtin_amdgcn_fence(__ATOMIC_RELEASE, "agent"); asm volatile("s_waitcnt vmcnt(0)" ::: "memory"); xb_add(&ctl[CW_PASSA_TOP + 64 * l], 1u); }
    }
}
__device__ __forceinline__ void passa_wait(LAS unsigned char* lds, int l) {
    if (threadIdx.x == 0) {
        unsigned* ctl = (unsigned*)(PWS + WS_CTL); volatile LAS unsigned* st = (volatile LAS unsigned*)(lds + LDS_CTL_OFF);
        const unsigned nx = st[1];
        XB_SPIN(xb_ld(&ctl[CW_PASSA_TOP + 64 * l]) < nx, ctl + CW_BAR);
        __builtin_amdgcn_fence(__ATOMIC_ACQUIRE, "agent"); asm volatile("s_waitcnt vmcnt(0)" ::: "memory");
    }
    __syncthreads();
}

#define PHASE_FN __device__ __forceinline__
PHASE_FN void ph_prologue(LAS unsigned char* lds, int vcu, int G) { prologue_phase(lds, vcu, G); }
PHASE_FN void ph_x0(int vcu, int G) { x0_phase(vcu, G); }
PHASE_FN void ph_ffn_in(LAS unsigned char* lds, int l, int second, int G, int bx) {
    unsigned char* wl = PWS + WS_W + (size_t)l * WL_STRIDE;
    pg8::Gemm g{(const bf16_t*)(PWS + WS_H), (const bf16_t*)(wl + (second ? WO_W1B : WO_W1A)), MT, 2 * FF, D};
    pg8::StaticOrder S; S.init(MT, 2 * FF, G, bx);
    pg8::EpiFfnIn E{l, second};
    pg8::gemm_phase<pg8::EpiFfnIn, pg8::StaticOrder, true, true>(lds, g, S, E);
}
PHASE_FN void ph_res(LAS unsigned char* lds, int l, int kind, int G, int bx) {
    unsigned char* wl = PWS + WS_W + (size_t)l * WL_STRIDE;
    const bool wo = kind == 1;
    pg8::Gemm g{(const bf16_t*)(PWS + (wo ? WS_MIX : WS_ACT)), (const bf16_t*)(wl + (kind == 0 ? WO_W2A : wo ? WO_WOUT : WO_W2B)), MT, D, wo ? D : FF};
    pg8::StaticOrder S; S.init(MT, D, G, bx);
    pg8::EpiRes E{l, kind};
    pg8::gemm_phase<pg8::EpiRes, pg8::StaticOrder, true, true>(lds, g, S, E);
}
PHASE_FN void ph_win(LAS unsigned char* lds, int l, int G, int bx) {
    unsigned char* wl = PWS + WS_W + (size_t)l * WL_STRIDE;
    pg8::Gemm g{(const bf16_t*)(PWS + WS_H), (const bf16_t*)(wl + WO_WIN), MT, INC, D};
    pg8::StaticOrder S; S.init(MT, INC, G, bx);
    pg8::EpiWin E{l};
    pg8::gemm_phase<pg8::EpiWin, pg8::StaticOrder, true, true>(lds, g, S, E);
}
PHASE_FN void ph_mix1(LAS unsigned char* lds, int l, int vcu, int G, int sub) {
    for (int i = 0; i <= ((sub >> 0) & 1); ++i) ssm_pass_a(lds, l, vcu, G);
    passa_arrive(lds, l);
    for (int i = 0; i <= ((sub >> 1) & 1); ++i) attn_ctx_phase(lds, vcu, G);
    for (int i = 0; i <= ((sub >> 2) & 1); ++i) attn_na_phase(lds, l, vcu, G);
    (void)sub;
    passa_wait(lds, l); ssm_carry(l, vcu, G);
}
PHASE_FN void ph_mix2(LAS unsigned char* lds, int l, int vcu, int G) {
    if (G >= 2 && NCHUNK > G && NCHUNK <= 2 * G) {
        const int h0 = NCHUNK - G, nb = G - h0;
        if (2 * (MT / 128 - nb) == nb) { if (vcu >= h0) gate_phase_split(lds, l, vcu - h0, nb); }
        else gate_phase(lds, l, vcu >= h0 ? vcu - h0 : MT, nb);
    }
    else gate_phase(lds, l, vcu, G);
    ssm_pass_b(lds, l, vcu, G);
}

__global__ void __launch_bounds__(NWAVES * 64, 2) mega(Params p) {
    extern __shared__ __attribute__((aligned(16))) unsigned char lds_raw[];
    LAS unsigned char* lds = (LAS unsigned char*)lds_raw;
    const int G = gridDim.x, bx = blockIdx.x;
    const int vcu = (G % 8 == 0) ? (bx % 8) * (G / 8) + bx / 8 : bx;
    {
        volatile LAS unsigned* st0 = (volatile LAS unsigned*)(lds + LDS_CTL_OFF);
        if (threadIdx.x < 16) st0[threadIdx.x] = 0u;
        __syncthreads();
        (void)xcd_barrier_post((unsigned*)(PWS + WS_CTL) + CW_BAR, st0);
    }
    for (int ph = p.ph_lo, rep = 0; ph < p.ph_hi;) {
        int Gp = G, vp = vcu, bp = bx; asm volatile("" : "+s"(Gp), "+s"(vp), "+s"(bp));
        if (ph == PH_PRO) { ph_prologue(lds, vp, Gp); }
        else if (ph == PH_X0) { ph_x0(vp, Gp); }
        else {
            const int l = (ph - 2) / PH_PER_LAYER, q = (ph - 2) % PH_PER_LAYER + 2;
            if (q == PH_F1IN) ph_ffn_in(lds, l, 0, Gp, bp);
            else if (q == PH_F2IN) ph_ffn_in(lds, l, 1, Gp, bp);
            else if (q == PH_F1OUT) ph_res(lds, l, 0, Gp, bp);
            else if (q == PH_WOUT) ph_res(lds, l, 1, Gp, bp);
            else if (q == PH_F2OUT) ph_res(lds, l, 2, Gp, bp);
            else if (q == PH_WIN) ph_win(lds, l, Gp, bp);
            else if (q == PH_MIX1) ph_mix1(lds, l, vp, Gp, p.rep_mask >> 16);
            else if (q == PH_MIX2) ph_mix2(lds, l, vp, Gp);
        }
        const int kind = ph < 2 ? ph : (ph - 2) % PH_PER_LAYER + 2;
        const bool again = rep == 0 && ((p.rep_mask >> kind) & 1);
        if (again || ph + 1 < p.ph_hi) {
            if (ph == PH_PRO) cooperative_groups::this_grid().sync();
            else { XcdBarrier bar; bar.bar = (unsigned*)(PWS + WS_CTL) + CW_BAR; bar.x = xb_xcc_id(); bar.st = (volatile LAS unsigned*)(lds + LDS_CTL_OFF); xcd_barrier(bar); }
        }
        if (again) rep = 1; else { rep = 0; ++ph; }
    }
}
}

extern "C" void kernel_launch(void* const* d_in, const int* in_sizes, int n_in, void* d_out, int out_size, void* d_ws, size_t ws_size, hipStream_t stream) {
    static int grid = 0;
    if (grid == 0) {
        if (n_in != 33 || ws_size < WS_END) { fprintf(stderr, "kernel_launch: unexpected n_in %d / ws_size %zu\n", n_in, ws_size); grid = -1; return; }
        int dev = 0, cus = 0;
        if (hipGetDevice(&dev) != hipSuccess || hipDeviceGetAttribute(&cus, hipDeviceAttributeMultiprocessorCount, dev) != hipSuccess) { grid = -1; return; }
        if (hipFuncSetAttribute((const void*)mega, hipFuncAttributeMaxDynamicSharedMemorySize, LDS_BYTES) != hipSuccess) { fprintf(stderr, "hipFuncSetAttribute failed\n"); grid = -1; return; }
        grid = cus;
    }
    if (grid < 0) return;
    Params p{};
    for (int i = 0; i < 33; ++i) p.in[i] = (const float*)d_in[i];
    p.out = (float*)d_out; p.ws = (unsigned char*)d_ws;
    p.ph_lo = 0; p.ph_hi = NPHASES; p.rep_mask = PROBE_REP_MASK;
    if (hipMemsetAsync((char*)d_ws + WS_CTL, 0, WS_MOD + (size_t)DEPTH * 5 * NMOD * D * 4, stream) != hipSuccess) { fprintf(stderr, "memset of control words failed\n"); return; }
    void* args[] = {&p};
    const hipError_t e = hipLaunchCooperativeKernel((const void*)mega, dim3(grid), dim3(NWAVES * 64), args, LDS_BYTES, stream);
    if (e != hipSuccess) fprintf(stderr, "cooperative launch failed: %s (grid %d)\n", hipGetErrorString(e), grid);
}
```

```cpp
#include <hip/hip_runtime.h>
#include <hip/hip_cooperative_groups.h>
#include <cstdio>
#include <cstdint>

typedef unsigned short bf16_t;
namespace {
constexpr int D = 1024, BATCH = 32, SEQ = 256, DEPTH = 2, DB = 4, DSEQ = 4096, PAST = 256;
constexpr int GW = 64, SSMW = 256, NAW = 512, NH = 8, HD = 64, GMW = 256, FF = 2816, NMOD = 9, INC = 2304;
constexpr int SG = 16, SC = 16, SP = 64;
constexpr int MC = BATCH * SEQ, ML = DB * DSEQ, MT = MC + ML;
constexpr size_t MiB = 1u << 20;
constexpr size_t WS_CTL = 0, WS_MOD = 1 * MiB, WS_SSMP = 2 * MiB, WS_CK = 3 * MiB, WS_CVT = 5 * MiB, WS_E = 7 * MiB;
constexpr size_t WS_WSB = 13 * MiB, WS_GLT = 13 * MiB + MiB / 2;
constexpr size_t WS_BMF = 14 * MiB, WS_CFF = 14 * MiB + MiB / 2;
constexpr size_t WS_SHW = MiB + 384 * 1024, WS_ROWSS = 15 * MiB, WS_WN = 15 * MiB + 768 * 1024;
constexpr int SHW_LAYER = 5 * (2 * 2 * FF + INC), SHW_J1 = 5 * 2 * FF, SHW_J2 = 5 * (2 * FF + INC);
constexpr size_t WS_W = 16 * MiB, WS_H = 96 * MiB, WS_ACT = 144 * MiB;
constexpr size_t WS_XSSM = 144 * MiB, WS_Q = 168 * MiB, WS_K = 192 * MiB, WS_VT = 216 * MiB, WS_U = 240 * MiB, WS_VG = 252 * MiB;
constexpr size_t WS_SIN = 264 * MiB, WS_MIX = 276 * MiB, WS_XH2B = 324 * MiB, WS_END = 332 * MiB;
constexpr size_t XH_OUT_OFF = 48 * MiB; constexpr int XH2_SPLIT_PM = 80;
constexpr size_t O_YP = 0, O_YS = (size_t)MC * D, O_CK = (size_t)MT * D, O_CV = O_CK + (size_t)BATCH * DEPTH * SEQ * NAW,
                 O_ST = O_CV + (size_t)BATCH * DEPTH * SEQ * NAW;

__device__ __forceinline__ float bf2f(bf16_t v) { return __uint_as_float(((unsigned)v) << 16); }
__device__ __forceinline__ bf16_t f2bf(float f) { unsigned u = __float_as_uint(f); return (bf16_t)((u + 0x7fffu + ((u >> 16) & 1u)) >> 16); }
__device__ __forceinline__ float silu_f(float x) { return x / (1.f + __expf(-x)); }
__device__ __forceinline__ float gelu_tanh(float x) { const float u = 0.7978845608028654f * (x + 0.044715f * x * x * x); return 0.5f * x * (1.f + tanhf(u)); }
__device__ __forceinline__ int modrow(int m) { return m < MC ? 0 : 1 + (m - MC) / DSEQ; }
__device__ __forceinline__ float wave_sum(float v) {
#pragma unroll
    for (int o = 1; o < 64; o <<= 1) v += __shfl_xor(v, o);
    return v;
}

struct Params {
    const float* in[33];
    float* out;
    unsigned char* ws;
    int ph_lo, ph_hi, rep_mask, pad;
};


template <int OFF> __device__ __forceinline__ unsigned long long karg64() {
    unsigned long long v;
    asm volatile("s_load_dwordx2 %0, %1, %2\n\ts_waitcnt lgkmcnt(0)" : "=s"(v) : "s"(__builtin_amdgcn_kernarg_segment_ptr()), "i"(OFF) : "memory");
    return v;
}
__device__ __forceinline__ int tid_opaque() { int t = threadIdx.x; asm volatile("" : "+v"(t)); return t; }
#define GASP __attribute__((address_space(1)))
#define PIN(i) ((const float*)(const GASP float*)karg64<8 * (i)>())
#define POUT ((float*)(GASP float*)karg64<8 * 33>())
#define PWS ((unsigned char*)(GASP unsigned char*)karg64<8 * 34>())
constexpr int NWAVES = 8, LDS_BYTES = 147456, LDS_CTL_OFF = LDS_BYTES - 64, CW_BAR = 4096, CW_SP = 8192, CW_SP_TOP = 65536;
constexpr size_t WL_STRIDE = 40 * MiB, WO_W1A = 0, WO_W2A = 11 * MiB, WO_WIN = 16 * MiB + MiB / 2, WO_WOUT = 21 * MiB, WO_W1B = 23 * MiB, WO_W2B = 34 * MiB;
enum { PH_PRO = 0, PH_X0 = 1, PH_F1IN = 2, PH_F1OUT, PH_WIN, PH_MIX1, PH_MIX2, PH_WOUT, PH_F2IN, PH_F2OUT, PH_PER_LAYER = 8 };
constexpr int NPHASES = 2 + DEPTH * PH_PER_LAYER;
constexpr int PROBE_REP_MASK = 0;


__device__ __forceinline__ void sp_arrive(__attribute__((address_space(3))) unsigned char* lds, int slot);
__device__ __forceinline__ void sp_wait(__attribute__((address_space(3))) unsigned char* lds, int slot);
namespace pg8 {
#define PG8_LAS __attribute__((address_space(3)))
typedef unsigned short bf16_t;
typedef short bf16x8 __attribute__((ext_vector_type(8)));
typedef float f32x4 __attribute__((ext_vector_type(4)));
typedef unsigned u32x4 __attribute__((ext_vector_type(4)));
constexpr int BM = 256, BK = 64, HALF = 128, HTB = HALF * BK * 2  , STAGE_BYTES = 8 * HTB, NXCD = 8, WGM = 8;

__host__ __device__ __forceinline__ int lds_byte(int r, int c) { const int st = (r >> 4) * 2 + (c >> 5), rr = r & 15, cc = c & 31, ob = rr * 64 + cc * 2; return st * 1024 + (ob ^ (((ob >> 9) & 1) << 5)); }
__host__ __device__ __forceinline__ void stage_rc(int b, int& R, int& C) { const int st = b / 1024, sb = b % 1024, swz = sb ^ (((sb >> 9) & 1) << 5); R = (st >> 1) * 16 + swz / 64; C = (st & 1) * 32 + (swz % 64) / 2; }
__host__ __device__ __forceinline__ int perm32(int rho) { const int n = rho >> 4, i = rho & 15; return 8 * (i >> 2) + 4 * n + (i & 3); }

struct Unit { int pm, pn, mask; };
struct Gemm { const bf16_t* A; const bf16_t* Bt; int M, N, K, hooks; };

struct StaticOrder {
    int nM, nN, nwg, G, c, mode;
    __host__ __device__ void init(int M, int N, int G_, int c_, int mode_ = 0) { nM = M / BM; nN = N / BM; nwg = nM * nN; G = G_; c = c_; mode = mode_; }
    __host__ __device__ bool next(int i, Unit& u) const {
        int pm = 0, pn = 0, mask = 3; bool ok = true;
        if (mode == 1) {
            const int x = c & 7, j = c >> 3, t = j >> 1;
            if (i == 0) { pm = 12 * x + (j & 7); pn = j >> 3; }
            else if (i == 1) { pm = 12 * x + 8 + (t & 3); pn = t >> 2; mask = 1 << (j & 1); }
            else ok = false;
        } else if (mode >= 2) {
            const int x = c & 7, j = c >> 3, per = 12 * nN, rf = per / 32, lf = per - rf * 32, jt = mode == 3 ? j - 16 : j;
            int w = 32 * i + j;
            if (i >= rf) { if (i == rf && lf > 0 && 2 * lf <= (mode == 3 ? 16 : 32) && jt >= 0 && jt < 2 * lf) { w = 32 * rf + (jt >> 1); mask = 1 << (jt & 1); } else { ok = false; w = 0; } }
            const int w2 = w - 8 * nN;
            pm = w < 8 * nN ? 12 * x + (w & 7) : 12 * x + 8 + (w2 & 3); pn = w < 8 * nN ? w >> 3 : w2 >> 2;
        } else {
            const int rfull = nwg / G, left = nwg - rfull * G;
            long L = (long)i * G + c;
            if (i == rfull && left > 0 && 2 * left <= G) { if (c >= 2 * left) ok = false; L = (long)i * G + (c >> 1); mask = 1 << (c & 1); }
            if (L >= nwg) { ok = false; L = 0; }
            int wgid = (int)L; { const int q = nwg / NXCD, r = nwg % NXCD, xcd = wgid % NXCD, off = wgid / NXCD; wgid = (xcd < r ? xcd * (q + 1) : r * (q + 1) + (xcd - r) * q) + off; }
            const int nig = WGM * nN, gid = wgid / nig, fm = gid * WGM, gsz = (nM - fm) < WGM ? (nM - fm) : WGM;
            pm = fm + ((wgid % nig) % gsz); pn = (wgid % nig) / gsz;
        }
        u.pm = pm; u.pn = pn; u.mask = mask; return ok;
    }
    __device__ __forceinline__ void a_ready(const Unit&) const {}
    __device__ __forceinline__ void done(const Unit&) const {}
};
__device__ __forceinline__ unsigned cvt_pk_bf16(float lo, float hi) { unsigned r; asm volatile("v_cvt_pk_bf16_f32 %0, %1, %2" : "=v"(r) : "v"(lo), "v"(hi)); return r; }

__device__ __forceinline__ float silu_fast(float x) { return x * __builtin_amdgcn_rcpf(1.f + __builtin_amdgcn_exp2f(-1.4426950408889634f * x)); }
__device__ __forceinline__ float gelu_fast(float x) {
    const float u2 = 1.5957691216057308f * (x + 0.044715f * x * x * x);
    return x * __builtin_amdgcn_rcpf(1.f + __builtin_amdgcn_exp2f(-1.4426950408889634f * u2));
}
struct EpiFfnIn {
    static constexpr bool PERM = true, AFTER_DRAIN = false;
    int l, second;
    __device__ __forceinline__ void operator()(const f32x4 (&acc)[2][2][4][2], const Unit& u, int wr, int wc, int fr, int fq) const {
        asm volatile("" : "+v"(fr), "+v"(fq));
        unsigned char* ws = PWS; bf16_t* ACT = (bf16_t*)(ws + WS_ACT);
        const float* rowss = (const float*)(ws + WS_ROWSS) + (size_t)(l * 3 + (second ? 2 : 0)) * MT; const float* shw = (const float*)(ws + WS_SHW) + (size_t)l * SHW_LAYER + (second ? SHW_J2 : 0);
        const int row0 = u.pm * 256 + wr * 64 + fr, col0 = u.pn * 128 + wc * 32 + 8 * fq;
        const float* sp = shw + (size_t)modrow(u.pm * 256) * (2 * FF) + u.pn * 256 + wc * 32 + 8 * fq;
        const f32x4 sg0 = *(const f32x4*)sp, sg1 = *(const f32x4*)(sp + 4), su0 = *(const f32x4*)(sp + 128), su1 = *(const f32x4*)(sp + 132);
#pragma unroll
        for (int ai = 0; ai < 2; ++ai) if ((u.mask >> ai) & 1)
#pragma unroll
            for (int m = 0; m < 4; ++m) {
                const int row = row0 + ai * 128 + m * 16;
                const float ri = rsqrtf(rowss[row] * (1.f / D) + 1e-6f);
                const f32x4 g0 = acc[ai][0][m][0] * ri + sg0, g1 = acc[ai][0][m][1] * ri + sg1, u0 = acc[ai][1][m][0] * ri + su0, u1 = acc[ai][1][m][1] * ri + su1;
                u32x4 w;
                w.x = cvt_pk_bf16(silu_fast(g0[0]) * u0[0], silu_fast(g0[1]) * u0[1]); w.y = cvt_pk_bf16(silu_fast(g0[2]) * u0[2], silu_fast(g0[3]) * u0[3]);
                w.z = cvt_pk_bf16(silu_fast(g1[0]) * u1[0], silu_fast(g1[1]) * u1[1]); w.w = cvt_pk_bf16(silu_fast(g1[2]) * u1[2], silu_fast(g1[3]) * u1[3]);
                *(u32x4*)(ACT + (size_t)row * FF + col0) = w;
            }
    }
};
typedef _Float16 f16x8 __attribute__((ext_vector_type(8)));
typedef _Float16 f16x4 __attribute__((ext_vector_type(4)));
typedef float f32x8 __attribute__((ext_vector_type(8)));
struct EpiRes {
    static constexpr bool PERM = true, AFTER_DRAIN = false;
    int l, kind;
    __device__ __forceinline__ void operator()(const f32x4 (&acc)[2][2][4][2], const Unit& u, int wr, int wc, int fr, int fq) const {
        asm volatile("" : "+v"(fr), "+v"(fq));
        unsigned char* ws = PWS; float* X = POUT;
        const int step = l * 3 + kind;
        const bool out_f32 = step == DEPTH * 3 - 1;
        const GASP unsigned char* rp; GASP unsigned char* wp;
        if (out_f32) rp = (const GASP unsigned char*)(u.pm < XH2_SPLIT_PM ? ws + WS_W : ws + WS_XH2B - (size_t)XH2_SPLIT_PM * 256 * D * 2);
        else rp = (const GASP unsigned char*)X + XH_OUT_OFF;
        if (out_f32) wp = (GASP unsigned char*)X;
        else if (step == DEPTH * 3 - 2) wp = (GASP unsigned char*)(u.pm < XH2_SPLIT_PM ? ws + WS_W : ws + WS_XH2B - (size_t)XH2_SPLIT_PM * 256 * D * 2);
        else wp = (GASP unsigned char*)X + XH_OUT_OFF;
        const int row0 = u.pm * 256 + wr * 64 + fr, mr = modrow(u.pm * 256);
        const float fac = kind == 1 ? 1.f : 0.5f;
        const float* gate = (const float*)(ws + WS_MOD) + ((size_t)l * 5 + mr) * NMOD * D + (kind == 0 ? 2 : kind == 1 ? 5 : 8) * D;
        const int nl = kind == 2 ? l + 1 : l, nn = nl * 3 + (kind == 0 ? 1 : kind == 1 ? 2 : 0);
        const bool wn = nl < DEPTH;
        bf16_t* H = (bf16_t*)(ws + WS_H); const float* wnp = (const float*)(ws + WS_WN) + ((size_t)nn * 5 + mr) * D; float* rowss_next = (float*)(ws + WS_ROWSS) + (size_t)nn * MT;
        f32x4 ga[2], gb[2], wa[2], wb[2];
#pragma unroll
        for (int bj = 0; bj < 2; ++bj) {
            const int col = u.pn * 256 + wc * 64 + bj * 32 + 8 * fq;
            ga[bj] = *(const f32x4*)(gate + col) * fac; gb[bj] = *(const f32x4*)(gate + col + 4) * fac;
            wa[bj] = (f32x4){0.f, 0.f, 0.f, 0.f}; wb[bj] = wa[bj];
            if (wn) { wa[bj] = *(const f32x4*)(wnp + col); wb[bj] = *(const f32x4*)(wnp + col + 4); }
        }
#pragma unroll
        for (int ai = 0; ai < 2; ++ai) if ((u.mask >> ai) & 1)
#pragma unroll
            for (int m = 0; m < 4; ++m) {
                const int row = row0 + ai * 128 + m * 16;
                float ssq = 0.f;
#pragma unroll
                for (int bj = 0; bj < 2; ++bj) {
                    const size_t ro = (size_t)row * D + u.pn * 256 + wc * 64 + bj * 32 + 8 * fq;
                    f32x4 x0, x1;
                    { const f32x8 fv = __builtin_convertvector(*(const GASP f16x8*)((const GASP _Float16*)rp + ro), f32x8); x0 = fv.lo; x1 = fv.hi; }
                    x0 += ga[bj] * acc[ai][bj][m][0]; x1 += gb[bj] * acc[ai][bj][m][1];
                    if (out_f32) { GASP float* x = (GASP float*)wp + ro; *(GASP f32x4*)x = x0; *(GASP f32x4*)(x + 4) = x1; }
                    else { f32x8 fv; fv.lo = x0; fv.hi = x1; *(GASP f16x8*)((GASP _Float16*)wp + ro) = __builtin_convertvector(fv, f16x8); }
                    if (wn) {
                        ssq += ((x0[0] * x0[0] + x0[1] * x0[1]) + (x0[2] * x0[2] + x0[3] * x0[3])) + ((x1[0] * x1[0] + x1[1] * x1[1]) + (x1[2] * x1[2] + x1[3] * x1[3]));
                        const f32x4 h0 = x0 * wa[bj], h1 = x1 * wb[bj];
                        u32x4 w; w.x = cvt_pk_bf16(h0[0], h0[1]); w.y = cvt_pk_bf16(h0[2], h0[3]); w.z = cvt_pk_bf16(h1[0], h1[1]); w.w = cvt_pk_bf16(h1[2], h1[3]);
                        *(u32x4*)(H + ro) = w;
                    }
                }
                if (wn) { ssq += __shfl_xor(ssq, 16); ssq += __shfl_xor(ssq, 32); if (fq == 0) (void)__hip_atomic_fetch_add(rowss_next + row, ssq, __ATOMIC_RELAXED, __HIP_MEMORY_SCOPE_AGENT); }
            }
    }
};
struct EpiWin {
    static constexpr bool PERM = true, AFTER_DRAIN = false;
    int l;
    __device__ __forceinline__ void operator()(f32x4 (&acc)[2][2][4][2], const Unit& u, int wr, int wc, int fr, int fq) const {
        asm volatile("" : "+v"(fr), "+v"(fq));
        unsigned char* ws = PWS; float* out = POUT; const float* qn = PIN(25) + l * HD; const float* kn = PIN(26) + l * HD;
        const float* rowss = (const float*)(ws + WS_ROWSS) + (size_t)(l * 3 + 1) * MT; const float* shw = (const float*)(ws + WS_SHW) + (size_t)l * SHW_LAYER + SHW_J1;
        const int row0 = u.pm * 256 + wr * 64 + fr, pn = u.pn;
        {
            const float* sp = shw + (size_t)modrow(u.pm * 256) * INC + pn * 256 + wc * 32 + 8 * fq;
            f32x4 sv[2][2];
#pragma unroll
            for (int bj = 0; bj < 2; ++bj) { sv[bj][0] = *(const f32x4*)(sp + bj * 128); sv[bj][1] = *(const f32x4*)(sp + bj * 128 + 4); }
#pragma unroll
            for (int ai = 0; ai < 2; ++ai) if ((u.mask >> ai) & 1)
#pragma unroll
                for (int m = 0; m < 4; ++m) {
                    const float ri = rsqrtf(rowss[row0 + ai * 128 + m * 16] * (1.f / D) + 1e-6f);
#pragma unroll
                    for (int bj = 0; bj < 2; ++bj) { acc[ai][bj][m][0] = acc[ai][bj][m][0] * ri + sv[bj][0]; acc[ai][bj][m][1] = acc[ai][bj][m][1] * ri + sv[bj][1]; }
                }
        }
        float* XS = (float*)(ws + WS_XSSM); bf16_t* Q = (bf16_t*)(ws + WS_Q); bf16_t* K = (bf16_t*)(ws + WS_K); bf16_t* VT = (bf16_t*)(ws + WS_VT); bf16_t* U = (bf16_t*)(ws + WS_U); bf16_t* VG = (bf16_t*)(ws + WS_VG);
        float* ock = out + O_CK; float* ocv = out + O_CV;
        if (pn == 0) {
#pragma unroll
            for (int ai = 0; ai < 2; ++ai) if ((u.mask >> ai) & 1)
#pragma unroll
                for (int m = 0; m < 4; ++m)
#pragma unroll
                    for (int bj = 0; bj < 2; ++bj) { float* o = XS + (size_t)(row0 + ai * 128 + m * 16) * SSMW + bj * 128 + wc * 32 + 8 * fq;
                        *(f32x4*)o = acc[ai][bj][m][0]; *(f32x4*)(o + 4) = acc[ai][bj][m][1]; }
        } else if (pn <= 4) {
            const bool isk = pn >= 3; const int h = 4 * ((pn - 1) & 1) + wc;
            const float* gn = isk ? kn : qn; bf16_t* O = isk ? K : Q;
            f32x4 gv[2][2];
#pragma unroll
            for (int bj = 0; bj < 2; ++bj)
#pragma unroll
                for (int n = 0; n < 2; ++n) gv[bj][n] = *(const f32x4*)(gn + 32 * bj + 8 * fq + 4 * n);
#pragma unroll
            for (int ai = 0; ai < 2; ++ai) if ((u.mask >> ai) & 1)
#pragma unroll
                for (int m = 0; m < 4; ++m) {
                    float ss = 0.f;
#pragma unroll
                    for (int bj = 0; bj < 2; ++bj)
#pragma unroll
                        for (int n = 0; n < 2; ++n) { const f32x4 v = acc[ai][bj][m][n]; ss += (v[0] * v[0] + v[1] * v[1]) + (v[2] * v[2] + v[3] * v[3]); }
                    ss += __shfl_xor(ss, 16); ss += __shfl_xor(ss, 32);
                    const float rinv = rsqrtf(ss * (1.f / HD) + 1e-6f);
                    const int row = row0 + ai * 128 + m * 16;
#pragma unroll
                    for (int bj = 0; bj < 2; ++bj) {
                        const f32x4 v0 = acc[ai][bj][m][0] * rinv * gv[bj][0], v1 = acc[ai][bj][m][1] * rinv * gv[bj][1];
                        u32x4 w; w.x = cvt_pk_bf16(v0[0], v0[1]); w.y = cvt_pk_bf16(v0[2], v0[3]); w.z = cvt_pk_bf16(v1[0], v1[1]); w.w = cvt_pk_bf16(v1[2], v1[3]);
                        const int d = 32 * bj + 8 * fq;
                        *(u32x4*)(O + (size_t)row * NAW + h * HD + d) = w;
                        if (isk && u.pm < MC / 256) { const int b = row / SEQ, t = row % SEQ; float* o = ock + ((((size_t)b * DEPTH + l) * SEQ + t) * NH + h) * HD + d;
                            *(f32x4*)o = v0; *(f32x4*)(o + 4) = v1; }
                    }
                }
        } else if (pn <= 6) {
            const bool ctx = u.pm < MC / 256;
#pragma unroll
            for (int ai = 0; ai < 2; ++ai) if ((u.mask >> ai) & 1)
#pragma unroll
                for (int m = 0; m < 4; ++m) {
                    const int row = row0 + ai * 128 + m * 16;
                    size_t vb; int Lq; float* oc = nullptr;
                    if (ctx) { const int b = row / SEQ, t = row % SEQ; vb = (size_t)b * NH * HD * SEQ + t; Lq = SEQ; oc = ocv + (((size_t)b * DEPTH + l) * SEQ + t) * NAW; }
                    else { const int r2 = row - MC, b = r2 / DSEQ, t = r2 % DSEQ; vb = (size_t)MC * NAW + (size_t)b * NH * HD * DSEQ + t; Lq = DSEQ; }
#pragma unroll
                    for (int bj = 0; bj < 2; ++bj) {
                        const int cl = (pn - 5) * 256 + bj * 128 + wc * 32 + 8 * fq;
                        const f32x4 v0 = acc[ai][bj][m][0], v1 = acc[ai][bj][m][1];
                        bf16_t* o = VT + vb + (size_t)cl * Lq;
                        o[0] = f2bf(v0[0]); o[(size_t)Lq] = f2bf(v0[1]); o[(size_t)2 * Lq] = f2bf(v0[2]); o[(size_t)3 * Lq] = f2bf(v0[3]);
                        o[(size_t)4 * Lq] = f2bf(v1[0]); o[(size_t)5 * Lq] = f2bf(v1[1]); o[(size_t)6 * Lq] = f2bf(v1[2]); o[(size_t)7 * Lq] = f2bf(v1[3]);
                        if (ctx) { *(f32x4*)(oc + cl) = v0; *(f32x4*)(oc + cl + 4) = v1; }
                    }
                }
        } else {
            bf16_t* O = pn == 7 ? U : VG;
#pragma unroll
            for (int ai = 0; ai < 2; ++ai) if ((u.mask >> ai) & 1)
#pragma unroll
                for (int m = 0; m < 4; ++m)
#pragma unroll
                    for (int bj = 0; bj < 2; ++bj) {
                        const f32x4 v0 = acc[ai][bj][m][0], v1 = acc[ai][bj][m][1];
                        u32x4 w; w.x = cvt_pk_bf16(gelu_fast(v0[0]), gelu_fast(v0[1])); w.y = cvt_pk_bf16(gelu_fast(v0[2]), gelu_fast(v0[3]));
                        w.z = cvt_pk_bf16(gelu_fast(v1[0]), gelu_fast(v1[1])); w.w = cvt_pk_bf16(gelu_fast(v1[2]), gelu_fast(v1[3]));
                        *(u32x4*)(O + (size_t)(row0 + ai * 128 + m * 16) * GMW + wc * 64 + bj * 32 + 8 * fq) = w;
                    }
        }
    }
};

template <class Epi, class Sched, bool ALIGN_EPI = false, bool SP2 = false>
__device__ __forceinline__ void gemm_phase(PG8_LAS unsigned char* lds, const Gemm g, const Sched& S, const Epi& E) {
    const int tid = tid_opaque(), wid = __builtin_amdgcn_readfirstlane(tid >> 6), lane = tid & 63, wr = wid >> 2, wc = wid & 3, fr = lane & 15, fq = lane >> 4;
    const int K = g.K, nt = K / BK;
    unsigned voffA[2], voffB[2];
#pragma unroll
    for (int i = 0; i < 2; ++i) { int R, C; stage_rc(tid * 16 + i * 8192, R, C); const int Rb = Epi::PERM ? ((R & ~31) + perm32(R & 31)) : R;
        voffA[i] = (unsigned)(R * K + C) * 2u; voffB[i] = (unsigned)(Rb * K + C) * 2u; }
    const size_t kstep = (size_t)(BK * 2);
    const size_t hstep = (size_t)HALF * K * 2;
    const size_t tstep = 2 * hstep;
    const unsigned ldsw = (unsigned)wid * 1024u;
    const int aoff = lds_byte(wr * 64 + fr, fq * 8), boff = lds_byte(wc * 32 + fr, fq * 8);
#define PG8_SA(b, h) (((b) * 2 + (h)) * HTB)
#define PG8_SB(b, h) ((4 + (b) * 2 + (h)) * HTB)
#define PG8_STAGE(bufoff, gbase, voff) do { _Pragma("unroll") for (int _i = 0; _i < 2; ++_i) \
        __builtin_amdgcn_global_load_lds((const unsigned*)((const char*)(gbase) + (voff)[_i]), (PG8_LAS unsigned*)(lds + (bufoff) + ldsw + _i * 8192), 16, 0, 0); } while (0)
#define PG8_LDA(dst, b, h) do { _Pragma("unroll") for (int m = 0; m < 4; ++m) _Pragma("unroll") for (int k = 0; k < 2; ++k) dst[m][k] = *(const PG8_LAS bf16x8*)(lds + PG8_SA(b, h) + aoff + m * 2048 + k * 1024); } while (0)
#define PG8_LDB(dst, b, h) do { _Pragma("unroll") for (int n = 0; n < 2; ++n) _Pragma("unroll") for (int k = 0; k < 2; ++k) dst[n][k] = *(const PG8_LAS bf16x8*)(lds + PG8_SB(b, h) + boff + n * 2048 + k * 1024); } while (0)
#define PG8_MMA(ai, bj, At, Bt) do { __builtin_amdgcn_s_setprio(1); _Pragma("unroll") for (int m = 0; m < 4; ++m) _Pragma("unroll") for (int n = 0; n < 2; ++n) _Pragma("unroll") for (int k = 0; k < 2; ++k) \
        acc[ai][bj][m][n] = __builtin_amdgcn_mfma_f32_16x16x32_bf16(Bt[n][k], At[m][k], acc[ai][bj][m][n], 0, 0, 0); __builtin_amdgcn_s_setprio(0); } while (0)
#define PG8_WAIT_V(n) asm volatile("s_waitcnt vmcnt(" #n ")" ::: "memory")
#define PG8_WAIT_L(n) asm volatile("s_waitcnt lgkmcnt(" #n ")" ::: "memory")
#define PG8_BAR __builtin_amdgcn_s_barrier()
#define PG8_SCHED __builtin_amdgcn_sched_barrier(0)
    Unit cur, nxt; int ui = 0;
    if (!S.next(0, cur)) return;
    f32x4 acc[2][2][4][2];
#pragma unroll
    for (int a = 0; a < 2; ++a)
#pragma unroll
        for (int b = 0; b < 2; ++b)
#pragma unroll
            for (int m = 0; m < 4; ++m)
#pragma unroll
                for (int n = 0; n < 2; ++n) acc[a][b][m][n] = (f32x4){0.f, 0.f, 0.f, 0.f};
    bf16x8 At[4][2], B0[2][2], B1[2][2];
    const char* cA = (const char*)g.A + (size_t)cur.pm * tstep; const char* cB = (const char*)g.Bt + (size_t)cur.pn * tstep;
    S.a_ready(cur);
    if constexpr (SP2) {
        PG8_STAGE(PG8_SB(0, 0), cB, voffB); PG8_STAGE(PG8_SB(0, 1), cB + hstep, voffB); PG8_STAGE(PG8_SA(0, 0), cA, voffA); PG8_STAGE(PG8_SA(0, 1), cA + hstep, voffA);
        if (wr == 1) PG8_BAR;
        PG8_WAIT_V(2); PG8_BAR;
        PG8_STAGE(PG8_SB(1, 0), cB + kstep, voffB); PG8_STAGE(PG8_SA(1, 0), cA + kstep, voffA); PG8_STAGE(PG8_SB(1, 1), cB + hstep + kstep, voffB);
        PG8_WAIT_V(6); PG8_BAR;
    } else {
        PG8_STAGE(PG8_SB(0, 0), cB, voffB); PG8_STAGE(PG8_SA(0, 0), cA, voffA); PG8_STAGE(PG8_SB(0, 1), cB + hstep, voffB); PG8_STAGE(PG8_SA(0, 1), cA + hstep, voffA);
        if (wr == 1) PG8_BAR;
        PG8_WAIT_V(4); PG8_BAR;
        PG8_STAGE(PG8_SB(1, 0), cB + kstep, voffB); PG8_STAGE(PG8_SA(1, 0), cA + kstep, voffA); PG8_STAGE(PG8_SB(1, 1), cB + hstep + kstep, voffB);
        PG8_WAIT_V(6); PG8_BAR;
    }
    for (;;) {
        const bool has_next = S.next(ui + 1, nxt);
        const char* nA = has_next ? (const char*)g.A + (size_t)nxt.pm * tstep : cA; const char* nB = has_next ? (const char*)g.Bt + (size_t)nxt.pn * tstep : cB;
        for (int t = 0; t < nt; t += 2) {
            const bool last = (t == nt - 2);
            const char* a1 = cA + (size_t)(t + 1) * kstep;
            const char* a2 = last ? nA : cA + (size_t)(t + 2) * kstep; const char* b2 = last ? nB : cB + (size_t)(t + 2) * kstep;
            const char* a3 = a2 + kstep; const char* b3 = b2 + kstep;
            if (last && has_next) S.a_ready(nxt);
            if constexpr (SP2) {
            PG8_LDB(B0, 0, 0); PG8_LDB(B1, 0, 1); PG8_SCHED; if (cur.mask & 1) PG8_LDA(At, 0, 0); PG8_STAGE(PG8_SA(1, 1), a1 + hstep, voffA);
            PG8_WAIT_V(8); PG8_WAIT_L(0); PG8_BAR; if (cur.mask & 1) { PG8_MMA(0, 0, At, B0); PG8_MMA(0, 1, At, B1); } PG8_BAR; PG8_SCHED;
            if (cur.mask & 2) PG8_LDA(At, 0, 1); PG8_STAGE(PG8_SB(0, 0), b2, voffB); PG8_STAGE(PG8_SB(0, 1), b2 + hstep, voffB); PG8_STAGE(PG8_SA(0, 0), a2, voffA);
            PG8_WAIT_V(8); PG8_WAIT_L(0); PG8_BAR; if (cur.mask & 2) { PG8_MMA(1, 0, At, B0); PG8_MMA(1, 1, At, B1); } PG8_BAR; PG8_SCHED;
            PG8_LDB(B0, 1, 0); PG8_LDB(B1, 1, 1); PG8_SCHED; if (cur.mask & 1) PG8_LDA(At, 1, 0); PG8_STAGE(PG8_SA(0, 1), a2 + hstep, voffA);
            PG8_WAIT_V(8); PG8_WAIT_L(0); PG8_BAR; if (cur.mask & 1) { PG8_MMA(0, 0, At, B0); PG8_MMA(0, 1, At, B1); } PG8_BAR; PG8_SCHED;
            if (cur.mask & 2) PG8_LDA(At, 1, 1); PG8_STAGE(PG8_SB(1, 0), b3, voffB); PG8_STAGE(PG8_SB(1, 1), b3 + hstep, voffB); PG8_STAGE(PG8_SA(1, 0), a3, voffA);
            PG8_WAIT_V(8); PG8_WAIT_L(0); PG8_BAR; if (cur.mask & 2) { PG8_MMA(1, 0, At, B0); PG8_MMA(1, 1, At, B1); } PG8_BAR; PG8_SCHED;
            } else {
            PG8_LDB(B0, 0, 0); PG8_SCHED; PG8_LDA(At, 0, 0); PG8_STAGE(PG8_SA(1, 1), a1 + hstep, voffA);
            PG8_WAIT_L(8); PG8_BAR; PG8_WAIT_L(0); PG8_MMA(0, 0, At, B0); PG8_BAR; PG8_SCHED;
            PG8_LDB(B1, 0, 1); PG8_STAGE(PG8_SB(0, 0), b2, voffB);
            PG8_BAR; PG8_WAIT_L(0); PG8_MMA(0, 1, At, B1); PG8_BAR;
            PG8_LDA(At, 0, 1); PG8_STAGE(PG8_SA(0, 0), a2, voffA);
            PG8_BAR; PG8_WAIT_L(0); PG8_MMA(1, 0, At, B0); PG8_BAR; PG8_SCHED;
            PG8_STAGE(PG8_SB(0, 1), b2 + hstep, voffB);
            PG8_WAIT_V(6); PG8_BAR; PG8_MMA(1, 1, At, B1); PG8_BAR;
            PG8_LDB(B0, 1, 0); PG8_SCHED; PG8_LDA(At, 1, 0); PG8_STAGE(PG8_SA(0, 1), a2 + hstep, voffA);
            PG8_WAIT_L(8); PG8_BAR; PG8_WAIT_L(0); PG8_MMA(0, 0, At, B0); PG8_BAR; PG8_SCHED;
            PG8_LDB(B1, 1, 1); PG8_STAGE(PG8_SB(1, 0), b3, voffB);
            PG8_BAR; PG8_WAIT_L(0); PG8_MMA(0, 1, At, B1); PG8_BAR;
            PG8_LDA(At, 1, 1); PG8_STAGE(PG8_SA(1, 0), a3, voffA);
            PG8_BAR; PG8_WAIT_L(0); PG8_MMA(1, 0, At, B0); PG8_BAR; PG8_SCHED;
            PG8_STAGE(PG8_SB(1, 1), b3 + hstep, voffB);
            PG8_WAIT_V(6); PG8_BAR; PG8_MMA(1, 1, At, B1); PG8_BAR;
            }
        }
        if constexpr (ALIGN_EPI) { if (wr == 0) PG8_BAR; }
        if ((g.hooks >> 31) && ui == ((g.hooks >> 24) & 127)) sp_wait(lds, ((g.hooks >> 16) & 255) - 1);
        if constexpr (!Epi::AFTER_DRAIN) { E(acc, cur, wr, wc, fr, fq); S.done(cur); if (g.hooks) { if ((g.hooks & 255) && ui == ((g.hooks >> 8) & 255)) sp_arrive(lds, (g.hooks & 255) - 1); if (!(g.hooks >> 31) && ((g.hooks >> 16) & 255) && ui == ((g.hooks >> 24) & 255)) sp_wait(lds, ((g.hooks >> 16) & 255) - 1); } }
        if (!has_next) break;
#pragma unroll
        for (int a = 0; a < 2; ++a)
#pragma unroll
            for (int b = 0; b < 2; ++b)
#pragma unroll
                for (int m = 0; m < 4; ++m)
#pragma unroll
                    for (int n = 0; n < 2; ++n) acc[a][b][m][n] = (f32x4){0.f, 0.f, 0.f, 0.f};
        cur = nxt; cA = nA; cB = nB; ++ui;
        if constexpr (ALIGN_EPI) { if (wr == 1) PG8_BAR; }
    }
    PG8_WAIT_V(0);
    if constexpr (!ALIGN_EPI) { if (wr == 0) PG8_BAR; }
    PG8_BAR;
    if constexpr (Epi::AFTER_DRAIN) { E.fused(acc, cur, wr, wc, fr, fq, lds, wid, lane); S.done(cur); }
#undef PG8_SA
#undef PG8_SB
#undef PG8_STAGE
#undef PG8_LDA
#undef PG8_LDB
#undef PG8_MMA
#undef PG8_WAIT_V
#undef PG8_WAIT_L
#undef PG8_BAR
#undef PG8_SCHED
}

}

#define LAS __attribute__((address_space(3)))

__device__ __forceinline__ void transpose_item(const float* W, int K, int N, bf16_t* WT, int k0, int ns0, int nd0, LAS float* scr, int lane) {
    float v[32];
    const float* wp = W + (size_t)(k0 + (lane >> 5)) * N + ns0 + (lane & 31);
#pragma unroll
    for (int i = 0; i < 32; ++i) v[i] = wp[(size_t)(2 * i) * N];
#pragma unroll
    for (int i = 0; i < 32; ++i) scr[(2 * i + (lane >> 5)) * 33 + (lane & 31)] = v[i];
    asm volatile("s_waitcnt lgkmcnt(0)" ::: "memory");
    const int c = lane & 7;
#pragma unroll
    for (int j = 0; j < 4; ++j) { const int n = (lane >> 3) + 8 * j; const LAS float* s = scr + (8 * c) * 33 + n;
        pg8::u32x4 o; o.x = pg8::cvt_pk_bf16(s[0 * 33], s[1 * 33]); o.y = pg8::cvt_pk_bf16(s[2 * 33], s[3 * 33]); o.z = pg8::cvt_pk_bf16(s[4 * 33], s[5 * 33]); o.w = pg8::cvt_pk_bf16(s[6 * 33], s[7 * 33]);
        *(pg8::u32x4*)(WT + (size_t)(nd0 + n) * K + k0 + 8 * c) = o; }
    asm volatile("s_waitcnt lgkmcnt(0)" ::: "memory");
}
__device__ __forceinline__ void prologue_adaln(LAS unsigned char* lds, int vcu, int G) {
    const int tid = tid_opaque(), lane = tid & 63, wave = __builtin_amdgcn_readfirstlane(tid >> 6);
    {
        LAS float* sc = (LAS float*)lds;
        LAS float* red = (LAS float*)(lds + 20480);
        const float* cctx = PIN(6); const float* cc = PIN(2);
        for (int i = tid; i < 5 * D; i += NWAVES * 64) { const int r = i / D, k = i % D; const float v = r == 0 ? cctx[k] : cc[(r - 1) * D + k]; sc[i] = v / (1.f + __expf(-v)); }
        __syncthreads();
        constexpr int KQ = 16, NBLK = NMOD * D / 128, NIT = DEPTH * NBLK * KQ;
        int it0 = (int)((long)vcu * NIT / G); const int it1 = (int)((long)(vcu + 1) * NIT / G);
        while (it0 < it1) {
            const int blk = it0 / KQ, ke = it1 < (blk + 1) * KQ ? it1 : (blk + 1) * KQ, nk = ke - it0;
            const int l = blk / NBLK, n0 = (blk % NBLK) * 128, kbeg = (it0 % KQ) * (D / KQ);
            const float* w = PIN(7) + (size_t)l * D * NMOD * D + n0 + (lane & 31) * 4;
            const int kb = kbeg + wave * (nk * 8) + (lane >> 5), nl = nk * 4;
            pg8::f32x4 a[5];
#pragma unroll
            for (int r = 0; r < 5; ++r) a[r] = (pg8::f32x4){0.f, 0.f, 0.f, 0.f};
#pragma unroll 1
            for (int i0 = 0; i0 < nl; i0 += 12) {
                pg8::f32x4 wv[12];
#pragma unroll
                for (int i = 0; i < 12; ++i) { const int ii = i0 + i < nl ? i0 + i : nl - 1; wv[i] = *(const pg8::f32x4*)(w + (size_t)(kb + 2 * ii) * NMOD * D); }
#pragma unroll
                for (int i = 0; i < 12; ++i) { const bool ok = i0 + i < nl; const int k = kb + 2 * (ok ? i0 + i : nl - 1);
#pragma unroll
                    for (int r = 0; r < 5; ++r) a[r] += wv[i] * (ok ? sc[r * D + k] : 0.f); }
            }
#pragma unroll
            for (int r = 0; r < 5; ++r) {
#pragma unroll
                for (int e = 0; e < 4; ++e) a[r][e] += __shfl_xor(a[r][e], 32);
                if (lane < 32) *(LAS pg8::f32x4*)(red + (wave * 5 + r) * 128 + lane * 4) = a[r]; }
            __syncthreads();
            const float* bada = PIN(8); float* modo = (float*)(PWS + WS_MOD);
            for (int o = tid; o < 5 * 128; o += NWAVES * 64) { const int r = o / 128, c = o % 128; float s = kbeg == 0 ? bada[l * NMOD * D + n0 + c] : 0.f;
#pragma unroll
                for (int w8 = 0; w8 < 8; ++w8) s += red[(w8 * 5 + r) * 128 + c];
                (void)__hip_atomic_fetch_add(modo + ((size_t)l * 5 + r) * NMOD * D + n0 + c, s, __ATOMIC_RELAXED, __HIP_MEMORY_SCOPE_AGENT); }
            __syncthreads();
            it0 = ke;
        }
        __syncthreads();
    }
}
__device__ __forceinline__ void prologue_rest(LAS unsigned char* lds, int vcu, int G) {
    const int tid = tid_opaque(), lane = tid & 63, wave = __builtin_amdgcn_readfirstlane(tid >> 6);
    {
        LAS float* scr = (LAS float*)(lds + wave * 16384);
        const int gw = vcu * NWAVES + wave, NGW = G * NWAVES;
        constexpr int I_FIN = (D / 64) * (2 * FF / 32), I_FOUT = (FF / 64) * (D / 32), I_WIN = (D / 64) * (INC / 32), I_WOUT = (D / 64) * (D / 32);
        constexpr int I_LAYER = 2 * I_FIN + 2 * I_FOUT + I_WIN + I_WOUT;
        for (int it = gw; it < DEPTH * I_LAYER; it += NGW) {
            const int l = it / I_LAYER; int r = it % I_LAYER;
            unsigned char* wl = PWS + WS_W + (size_t)l * WL_STRIDE;
            int which = 0;
            if (r >= I_FIN) { r -= I_FIN; which = 1; if (r >= I_FOUT) { r -= I_FOUT; which = 2; if (r >= I_WIN) { r -= I_WIN; which = 3; if (r >= I_WOUT) { r -= I_WOUT; which = 4; if (r >= I_FIN) { r -= I_FIN; which = 5; } } } } }
            if (which == 0 || which == 4) {
                const float* W = (which == 0 ? PIN(10) : PIN(31)) + (size_t)l * D * 2 * FF; bf16_t* WT = (bf16_t*)(wl + (which == 0 ? WO_W1A : WO_W1B));
                const int nblk = 2 * FF / 32, kb = r / nblk, nd0 = (r % nblk) * 32; const int pn = nd0 / 256, c = nd0 % 256, bj = c / 128, x = c % 128;
                transpose_item(W, D, 2 * FF, WT, kb * 64, bj * FF + 128 * pn + x, nd0, scr, lane);
            } else if (which == 1 || which == 5) {
                const float* W = (which == 1 ? PIN(11) : PIN(32)) + (size_t)l * FF * D; bf16_t* WT = (bf16_t*)(wl + (which == 1 ? WO_W2A : WO_W2B));
                const int nblk = D / 32, kb = r / nblk, nd0 = (r % nblk) * 32; const int c = nd0 % 256, bj = c / 128, wc = (c % 128) / 32;
                transpose_item(W, FF, D, WT, kb * 64, (nd0 - c) + 64 * wc + 32 * bj, nd0, scr, lane);
            } else if (which == 2) {
                const float* W = PIN(13) + (size_t)l * D * INC; bf16_t* WT = (bf16_t*)(wl + WO_WIN);
                const int nblk = INC / 32, kb = r / nblk, nd0 = (r % nblk) * 32; const int pn = nd0 / 256, c = nd0 % 256;
                int ns0 = nd0; if ((pn >= 1 && pn <= 4) || pn >= 7) { const int bj = c / 128, wc = (c % 128) / 32; ns0 = 256 * pn + 64 * wc + 32 * bj; }
                transpose_item(W, D, INC, WT, kb * 64, ns0, nd0, scr, lane);
            } else {
                const float* W = PIN(14) + (size_t)l * D * D; bf16_t* WT = (bf16_t*)(wl + WO_WOUT);
                const int nblk = D / 32, kb = r / nblk, nd0 = (r % nblk) * 32; const int c = nd0 % 256, bj = c / 128, wc = (c % 128) / 32;
                transpose_item(W, D, D, WT, kb * 64, (nd0 - c) + 64 * wc + 32 * bj, nd0, scr, lane);
            }
        }
    }
    const int gt = vcu * (NWAVES * 64) + tid, NGT = G * NWAVES * 64;
    const int gtr = (G - 1 - vcu) * (NWAVES * 64) + tid;
    {
        constexpr int NSLOT = DEPTH * 4 * 128 * 128, CTOT = DB * DEPTH * PAST * NH * HD;
        static_assert(DEPTH * SSMW * SSMW == NSLOT && CTOT == 8 * NSLOT && DEPTH * 3 * MT <= 2 * NSLOT, "slot loop layout");
        const float* gws = PIN(28); bf16_t* wsb = (bf16_t*)(PWS + WS_WSB); const float* glw = PIN(23); bf16_t* glt = (bf16_t*)(PWS + WS_GLT); float* rs = (float*)(PWS + WS_ROWSS);
        const float* cki = PIN(3); const float* cvi = PIN(4); bf16_t* cko = (bf16_t*)(PWS + WS_CK); bf16_t* cvo = (bf16_t*)(PWS + WS_CVT);
        for (int sl = gt; sl < NSLOT; sl += NGT) {
            const float w0 = gws[sl];
            const int gk = sl % SSMW, gn = (sl / SSMW) % SSMW, gl = sl / (SSMW * SSMW);
            const float g0 = glw[((size_t)gl * SSMW + gk) * SSMW + gn];
            float kv[8], vv[8];
#pragma unroll
            for (int j = 0; j < 8; ++j) { kv[j] = cki[sl + j * NSLOT]; vv[j] = cvi[sl + j * NSLOT]; }
            wsb[sl] = f2bf(w0); glt[sl] = f2bf(g0);
            if (sl >= MT) rs[sl] = 0.f; if (sl + NSLOT < DEPTH * 3 * MT) rs[sl + NSLOT] = 0.f;
#pragma unroll
            for (int j = 0; j < 8; ++j) { const int idx = sl + j * NSLOT;
                const int d = idx % HD, h = (idx / HD) % NH, t = (idx / (HD * NH)) % PAST, l = (idx / (HD * NH * PAST)) % DEPTH, b = idx / (HD * NH * PAST * DEPTH);
                cko[((((size_t)l * DB + b) * NH + h) * PAST + t) * HD + d] = f2bf(kv[j]);
                cvo[((((size_t)l * DB + b) * NH + h) * HD + d) * PAST + t] = f2bf(vv[j]); }
        }
    }
    for (int idx = gtr; idx < DEPTH * 2 * SG * SP; idx += NGT) {
        const int g = (idx / SP) % SG, ld = idx / (SP * SG);
        const float lre = PIN(15)[idx], lim = PIN(16)[idx];
        const float dt = expf(PIN(17)[ld * SG + g]);
        const float er = expf(lre * dt); float sn, cs; sincosf(lim * dt, &sn, &cs);
        const float br = er * cs, bi = er * sn;
        const float nr = br - 1.f, ni = bi, den = lre * lre + lim * lim;
        const float cr = (nr * lre + ni * lim) / den, ci = (ni * lre - nr * lim) / den;
        float2* lb = (float2*)(PWS + WS_SSMP); float2* bb = (float2*)(PWS + WS_SSMP + 64 * 1024);
        lb[idx] = make_float2(br, bi);
        const float* bre = PIN(18); const float* bim = PIN(19);
        float bxr[SC], bxi[SC];
#pragma unroll
        for (int c = 0; c < SC; ++c) { const float xr = bre[(size_t)idx * SC + c], xi = bim[(size_t)idx * SC + c];
            bxr[c] = cr * xr - ci * xi; bxi[c] = cr * xi + ci * xr; bb[(size_t)idx * SC + c] = make_float2(bxr[c], bxi[c]); }
        const int pp = idx % SP; pg8::u32x4* bmf = (pg8::u32x4*)(PWS + WS_BMF) + ((size_t)(idx / SP) * 8 + pp / 8) * 64;
#pragma unroll
        for (int part = 0; part < 2; ++part)
#pragma unroll
            for (int q4 = 0; q4 < 4; ++q4) { const int c0 = 8 * (q4 & 1); pg8::u32x4 w;
                w.x = pg8::cvt_pk_bf16(part ? bxi[c0 + 0] : bxr[c0 + 0], part ? bxi[c0 + 1] : bxr[c0 + 1]); w.y = pg8::cvt_pk_bf16(part ? bxi[c0 + 2] : bxr[c0 + 2], part ? bxi[c0 + 3] : bxr[c0 + 3]);
                w.z = pg8::cvt_pk_bf16(part ? bxi[c0 + 4] : bxr[c0 + 4], part ? bxi[c0 + 5] : bxr[c0 + 5]); w.w = pg8::cvt_pk_bf16(part ? bxi[c0 + 6] : bxr[c0 + 6], part ? bxi[c0 + 7] : bxr[c0 + 7]);
                bmf[16 * q4 + 2 * (pp % 8) + part] = w; }
    }
    {
        const float* cre0 = PIN(20); const float* cim0 = PIN(21); pg8::u32x4* cff = (pg8::u32x4*)(PWS + WS_CFF);
        for (int idx = gtr; idx < DEPTH * 2 * SG * 4 * 64; idx += NGT) {
            const int ln = idx & 63, ks = (idx >> 6) & 3, ldg = idx >> 8, rr = ln & 15, qq = ln >> 4;
            const float* a = cre0 + ((size_t)ldg * SC + rr) * SP + 16 * ks + 4 * qq; const float* b = cim0 + ((size_t)ldg * SC + rr) * SP + 16 * ks + 4 * qq;
            pg8::u32x4 w; w.x = pg8::cvt_pk_bf16(a[0], -b[0]); w.y = pg8::cvt_pk_bf16(a[1], -b[1]); w.z = pg8::cvt_pk_bf16(a[2], -b[2]); w.w = pg8::cvt_pk_bf16(a[3], -b[3]);
            cff[idx] = w;
        }
    }
}
__device__ __forceinline__ void x0_ab(LAS unsigned char* lds, int vcu, int G, int es) {
    const int tid = tid_opaque(), lane = tid & 63, wave = __builtin_amdgcn_readfirstlane(tid >> 6);
    const int gw = vcu * NWAVES + wave, NGW = G * NWAVES;
    const float* modb = (const float*)(PWS + WS_MOD);
    {
        const float* gain = PIN(9); const float* xp = PIN(0); const float* xs = PIN(1); bf16_t* Hb = (bf16_t*)(PWS + WS_H); float* rs = (float*)(PWS + WS_ROWSS);
        for (int ri = 0, row_lin = gw; row_lin < MT; ++ri, row_lin += NGW) {
            int row = row_lin;
            if (es >= 0) { if (ri < 8) { const int k = gw + ri * NGW; row = 12 * (k >> 11) * 256 + (k & 2047); } else { const int k = gw + (ri - 8) * NGW; row = (12 * (k >> 10) + 8) * 256 + (k & 1023); }
                if (ri == 8) sp_arrive(lds, es); }
            const float* src = row < MC ? xp + (size_t)row * D : xs + (size_t)(row - MC) * D;
            const float* sc = modb + (size_t)modrow(row) * NMOD * D + 1 * D;
            float4 v[4]; float ss = 0.f;
#pragma unroll
            for (int j = 0; j < 4; ++j) { v[j] = ((const float4*)src)[lane + 64 * j]; ss += v[j].x * v[j].x + v[j].y * v[j].y + v[j].z * v[j].z + v[j].w * v[j].w; }
            ss = wave_sum(ss);
            if (lane == 0) rs[row] = ss;
            bf16_t* Hr = Hb + (size_t)row * D; _Float16* Xr = (_Float16*)((unsigned char*)POUT + XH_OUT_OFF) + (size_t)row * D;
#pragma unroll
            for (int j = 0; j < 4; ++j) {
                const int c0 = (lane + 64 * j) * 4;
                { pg8::f32x4 xv; xv[0] = v[j].x; xv[1] = v[j].y; xv[2] = v[j].z; xv[3] = v[j].w; *(pg8::f16x4*)(Xr + c0) = __builtin_convertvector(xv, pg8::f16x4); }
                const float4 g4 = *(const float4*)(gain + c0), s4 = *(const float4*)(sc + c0);
                uint2 o;
                o.x = pg8::cvt_pk_bf16(v[j].x * g4.x * (1.f + s4.x), v[j].y * g4.y * (1.f + s4.y));
                o.y = pg8::cvt_pk_bf16(v[j].z * g4.z * (1.f + s4.z), v[j].w * g4.w * (1.f + s4.w));
                *(uint2*)(Hr + c0) = o;
            }
        }
    }
    {
        float* wn = (float*)(PWS + WS_WN);
        const int gt = vcu * (NWAVES * 64) + tid, NGT = G * NWAVES * 64;
        for (int idx = gt; idx < DEPTH * 3 * 5 * D; idx += NGT) {
            const int c = idx % D, mr = (idx / D) % 5, j = (idx / (5 * D)) % 3, l = idx / (15 * D);
            const float g = (j == 0 ? PIN(9) : j == 1 ? PIN(12) : PIN(30))[l * D + c];
            wn[idx] = g * (1.f + modb[((size_t)l * 5 + mr) * NMOD * D + (3 * j + 1) * D + c]);
        }
    }
}
__device__ __forceinline__ void x0_c(int vcu, int G) {
    const int tid = tid_opaque(), lane = tid & 63, wave = __builtin_amdgcn_readfirstlane(tid >> 6);
    const int gw = vcu * NWAVES + wave, NGW = G * NWAVES;
    const float* modb = (const float*)(PWS + WS_MOD);
    {
        float* shw = (float*)(PWS + WS_SHW);
        constexpr int TPL = (2 * 2 * FF + INC) / 16;
        const int r = lane & 15, q4 = lane >> 4;
        for (int it = gw; it < DEPTH * TPL; it += NGW) {
            const int l = it / TPL, t = it % TPL;
            int j, n0, N; size_t wo;
            if (t < 2 * FF / 16) { j = 0; n0 = t * 16; wo = WO_W1A; N = 2 * FF; } else if (t < (2 * FF + INC) / 16) { j = 1; n0 = (t - 2 * FF / 16) * 16; wo = WO_WIN; N = INC; } else { j = 2; n0 = (t - (2 * FF + INC) / 16) * 16; wo = WO_W1B; N = 2 * FF; }
            const bf16_t* wt = (const bf16_t*)(PWS + WS_W + (size_t)l * WL_STRIDE + wo) + (size_t)(n0 + r) * D + 8 * q4;
            const float* sh = modb + ((size_t)l * 5 + (r < 5 ? r : 4)) * NMOD * D + (3 * j) * D + 8 * q4;
            const bool valid = r < 5;
            pg8::f32x4 ah = (pg8::f32x4){0.f, 0.f, 0.f, 0.f}, al = ah;
#pragma unroll 4
            for (int ks = 0; ks < 32; ++ks) {
                const pg8::bf16x8 b = *(const pg8::bf16x8*)(wt + 32 * ks);
                const pg8::f32x4 s0 = *(const pg8::f32x4*)(sh + 32 * ks), s1 = *(const pg8::f32x4*)(sh + 32 * ks + 4);
                const float sv[8] = {s0[0], s0[1], s0[2], s0[3], s1[0], s1[1], s1[2], s1[3]};
                unsigned hw[4], lw[4];
#pragma unroll
                for (int i = 0; i < 4; ++i) { const unsigned hp = pg8::cvt_pk_bf16(sv[2 * i], sv[2 * i + 1]);
                    const unsigned lp = pg8::cvt_pk_bf16(sv[2 * i] - __uint_as_float(hp << 16), sv[2 * i + 1] - __uint_as_float(hp & 0xffff0000u));
                    hw[i] = valid ? hp : 0u; lw[i] = valid ? lp : 0u; }
                pg8::u32x4 hv, lv; hv.x = hw[0]; hv.y = hw[1]; hv.z = hw[2]; hv.w = hw[3]; lv.x = lw[0]; lv.y = lw[1]; lv.z = lw[2]; lv.w = lw[3];
                ah = __builtin_amdgcn_mfma_f32_16x16x32_bf16(__builtin_bit_cast(pg8::bf16x8, hv), b, ah, 0, 0, 0);
                al = __builtin_amdgcn_mfma_f32_16x16x32_bf16(__builtin_bit_cast(pg8::bf16x8, lv), b, al, 0, 0, 0);
            }
            const pg8::f32x4 sum = ah + al;
            float* o = shw + (size_t)l * SHW_LAYER + (j == 0 ? 0 : j == 1 ? SHW_J1 : SHW_J2) + n0 + r;
            if (q4 == 0) { o[0] = sum[0]; o[(size_t)N] = sum[1]; o[(size_t)2 * N] = sum[2]; o[(size_t)3 * N] = sum[3]; }
            else if (q4 == 1) o[(size_t)4 * N] = sum[0];
        }
    }
}
typedef short bf16x8 __attribute__((ext_vector_type(8)));
typedef float f32x4 __attribute__((ext_vector_type(4)));
typedef unsigned u32x4 __attribute__((ext_vector_type(4)));
typedef float f32x2 __attribute__((ext_vector_type(2)));
typedef unsigned u32x2 __attribute__((ext_vector_type(2)));
constexpr float QK_SCALE_LOG2E = 0.125f * 1.4426950408889634f;
constexpr int AK_STRIDE = 72, AV_STRIDE = 264, ATT_V_OFF = 256 * AK_STRIDE * 2, ATT_B_OFF = ATT_V_OFF + 64 * AV_STRIDE * 2;
__device__ __forceinline__ bf16x8 ldg8(const bf16_t* p) { return *(const bf16x8*)p; }
__device__ __forceinline__ void softmax_pv_step(const f32x4 sa, const f32x4 sb, float& m, float& lsum, f32x4 (&o)[4], const bf16x8 (&vf)[4]) {
    const float mx8 = fmaxf(fmaxf(fmaxf(sa[0], sa[1]), fmaxf(sa[2], sa[3])), fmaxf(fmaxf(sb[0], sb[1]), fmaxf(sb[2], sb[3])));
    if (__builtin_amdgcn_ballot_w64(mx8 > m + 8.f) != 0ull) {
        float mx = fmaxf(mx8, __shfl_xor(mx8, 16)); mx = fmaxf(mx, __shfl_xor(mx, 32));
        const float mn = fmaxf(m, mx), alpha = __builtin_amdgcn_exp2f(m - mn); m = mn; lsum *= alpha;
#pragma unroll
        for (int dt = 0; dt < 4; ++dt) o[dt] = o[dt] * alpha;
    }
    float p[8];
#pragma unroll
    for (int i = 0; i < 4; ++i) { p[i] = __builtin_amdgcn_exp2f(sa[i] - m); p[4 + i] = __builtin_amdgcn_exp2f(sb[i] - m); }
    lsum += ((p[0] + p[1]) + (p[2] + p[3])) + ((p[4] + p[5]) + (p[6] + p[7]));
    u32x4 pw; pw.x = pg8::cvt_pk_bf16(p[0], p[1]); pw.y = pg8::cvt_pk_bf16(p[2], p[3]); pw.z = pg8::cvt_pk_bf16(p[4], p[5]); pw.w = pg8::cvt_pk_bf16(p[6], p[7]);
    const bf16x8 pf = __builtin_bit_cast(bf16x8, pw);
#pragma unroll
    for (int dt = 0; dt < 4; ++dt) o[dt] = __builtin_amdgcn_mfma_f32_16x16x32_bf16(vf[dt], pf, o[dt], 0, 0, 0);
}
__device__ __forceinline__ void softmax_pv_step2(const f32x4 sa, const f32x4 sb, float& m, float& lsum, f32x4 (&o)[4], const bf16x8 (&vf)[4],
                                                 const f32x4 ta, const f32x4 tb, float& m2, float& l2, f32x4 (&o2)[4], const bf16x8 (&vf2)[4]) {
    const float mx8 = fmaxf(fmaxf(fmaxf(sa[0], sa[1]), fmaxf(sa[2], sa[3])), fmaxf(fmaxf(sb[0], sb[1]), fmaxf(sb[2], sb[3])));
    const float nx8 = fmaxf(fmaxf(fmaxf(ta[0], ta[1]), fmaxf(ta[2], ta[3])), fmaxf(fmaxf(tb[0], tb[1]), fmaxf(tb[2], tb[3])));
    if (__builtin_amdgcn_ballot_w64(mx8 > m + 8.f || nx8 > m2 + 8.f) != 0ull) {
        float mx = fmaxf(mx8, __shfl_xor(mx8, 16)); mx = fmaxf(mx, __shfl_xor(mx, 32));
        float nx = fmaxf(nx8, __shfl_xor(nx8, 16)); nx = fmaxf(nx, __shfl_xor(nx, 32));
        const float mn = fmaxf(m, mx), alpha = __builtin_amdgcn_exp2f(m - mn); m = mn; lsum *= alpha;
        const float nn = fmaxf(m2, nx), beta = __builtin_amdgcn_exp2f(m2 - nn); m2 = nn; l2 *= beta;
#pragma unroll
        for (int dt = 0; dt < 4; ++dt) { o[dt] = o[dt] * alpha; o2[dt] = o2[dt] * beta; }
    }
    float p[8], q[8];
#pragma unroll
    for (int i = 0; i < 4; ++i) { p[i] = __builtin_amdgcn_exp2f(sa[i] - m); p[4 + i] = __builtin_amdgcn_exp2f(sb[i] - m); q[i] = __builtin_amdgcn_exp2f(ta[i] - m2); q[4 + i] = __builtin_amdgcn_exp2f(tb[i] - m2); }
    lsum += ((p[0] + p[1]) + (p[2] + p[3])) + ((p[4] + p[5]) + (p[6] + p[7]));
    l2 += ((q[0] + q[1]) + (q[2] + q[3])) + ((q[4] + q[5]) + (q[6] + q[7]));
    u32x4 pw; pw.x = pg8::cvt_pk_bf16(p[0], p[1]); pw.y = pg8::cvt_pk_bf16(p[2], p[3]); pw.z = pg8::cvt_pk_bf16(p[4], p[5]); pw.w = pg8::cvt_pk_bf16(p[6], p[7]);
    u32x4 qw; qw.x = pg8::cvt_pk_bf16(q[0], q[1]); qw.y = pg8::cvt_pk_bf16(q[2], q[3]); qw.z = pg8::cvt_pk_bf16(q[4], q[5]); qw.w = pg8::cvt_pk_bf16(q[6], q[7]);
    const bf16x8 pf = __builtin_bit_cast(bf16x8, pw), qf = __builtin_bit_cast(bf16x8, qw);
#pragma unroll
    for (int dt = 0; dt < 4; ++dt) { o[dt] = __builtin_amdgcn_mfma_f32_16x16x32_bf16(vf[dt], pf, o[dt], 0, 0, 0); o2[dt] = __builtin_amdgcn_mfma_f32_16x16x32_bf16(vf2[dt], qf, o2[dt], 0, 0, 0); }
}
__device__ __forceinline__ void qk_tiles(const bf16x8 a0, const bf16x8 a1, const bf16x8 b0, const bf16x8 b1, const bf16x8 (&qf)[2], f32x4& sa, f32x4& sb) {
    sa = (f32x4){0.f, 0.f, 0.f, 0.f}; sb = (f32x4){0.f, 0.f, 0.f, 0.f};
    sa = __builtin_amdgcn_mfma_f32_16x16x32_bf16(a0, qf[0], sa, 0, 0, 0); sa = __builtin_amdgcn_mfma_f32_16x16x32_bf16(a1, qf[1], sa, 0, 0, 0);
    sb = __builtin_amdgcn_mfma_f32_16x16x32_bf16(b0, qf[0], sb, 0, 0, 0); sb = __builtin_amdgcn_mfma_f32_16x16x32_bf16(b1, qf[1], sb, 0, 0, 0);
}
__device__ __forceinline__ void attn_stage_kv(LAS unsigned char* lds, const bf16_t* ksrc, int krs, const bf16_t* vsrc, int tid) {
    LAS bf16_t* kl = (LAS bf16_t*)lds; LAS bf16_t* vl = (LAS bf16_t*)(lds + ATT_V_OFF);
    bf16x8 kr[4], vr[4];
#pragma unroll
    for (int i = 0; i < 4; ++i) { const int c = tid + NWAVES * 64 * i, row = c >> 3, part = c & 7; kr[i] = ldg8(ksrc + (size_t)row * krs + part * 8); }
#pragma unroll
    for (int i = 0; i < 4; ++i) { const int c = tid + NWAVES * 64 * i, d = c >> 5, part = c & 31; vr[i] = ldg8(vsrc + (size_t)d * 256 + part * 8); }
#pragma unroll
    for (int i = 0; i < 4; ++i) { const int c = tid + NWAVES * 64 * i, row = c >> 3, part = c & 7; *(LAS bf16x8*)(kl + row * AK_STRIDE + part * 8) = kr[i]; }
#pragma unroll
    for (int i = 0; i < 4; ++i) { const int c = tid + NWAVES * 64 * i, d = c >> 5, part = c & 31; *(LAS bf16x8*)(vl + d * AV_STRIDE + part * 8) = vr[i]; }
}
__device__ __forceinline__ void attn_lds_logits(const LAS unsigned char* lds, int k0, const bf16x8 (&qf)[2], f32x4& sa, f32x4& sb, bf16x8 (&vf)[4], int r, int q4) {
    const LAS bf16_t* ka = (const LAS bf16_t*)lds + (k0 + 8 * (r >> 2) + (r & 3)) * AK_STRIDE + 8 * q4;
    const LAS bf16_t* vl = (const LAS bf16_t*)(lds + ATT_V_OFF) + r * AV_STRIDE + 8 * q4 + k0;
    const bf16x8 a0 = *(const LAS bf16x8*)ka, a1 = *(const LAS bf16x8*)(ka + 32), b0 = *(const LAS bf16x8*)(ka + 4 * AK_STRIDE), b1 = *(const LAS bf16x8*)(ka + 4 * AK_STRIDE + 32);
#pragma unroll
    for (int dt = 0; dt < 4; ++dt) vf[dt] = *(const LAS bf16x8*)(vl + dt * 16 * AV_STRIDE);
    qk_tiles(a0, a1, b0, b1, qf, sa, sb);
    sa = sa * QK_SCALE_LOG2E; sb = sb * QK_SCALE_LOG2E;
}
__device__ __forceinline__ void attn_lds_block(const LAS unsigned char* lds, int k0, const bf16x8 (&qf)[2], float& m, float& lsum, f32x4 (&o)[4], int r, int q4) {
    const LAS bf16_t* ka = (const LAS bf16_t*)lds + (k0 + 8 * (r >> 2) + (r & 3)) * AK_STRIDE + 8 * q4;
    const LAS bf16_t* vl = (const LAS bf16_t*)(lds + ATT_V_OFF) + r * AV_STRIDE + 8 * q4 + k0;
    const bf16x8 a0 = *(const LAS bf16x8*)ka, a1 = *(const LAS bf16x8*)(ka + 32), b0 = *(const LAS bf16x8*)(ka + 4 * AK_STRIDE), b1 = *(const LAS bf16x8*)(ka + 4 * AK_STRIDE + 32);
    bf16x8 vf[4];
#pragma unroll
    for (int dt = 0; dt < 4; ++dt) vf[dt] = *(const LAS bf16x8*)(vl + dt * 16 * AV_STRIDE);
    f32x4 sa, sb; qk_tiles(a0, a1, b0, b1, qf, sa, sb);
    sa = sa * QK_SCALE_LOG2E; sb = sb * QK_SCALE_LOG2E;
    softmax_pv_step(sa, sb, m, lsum, o, vf);
}
__device__ __forceinline__ void attn_merge(float& m, float& lsum, f32x4 (&o)[4], const float m2, const float l2, const f32x4 (&o2)[4]) {
    const float mn = fmaxf(m, m2), fa = __builtin_amdgcn_exp2f(m - mn), fb = __builtin_amdgcn_exp2f(m2 - mn);
    m = mn; lsum = lsum * fa + l2 * fb;
#pragma unroll
    for (int dt = 0; dt < 4; ++dt) o[dt] = o[dt] * fa + o2[dt] * fb;
}
__device__ __forceinline__ void attn_store(bf16_t* orow, float lsum, const f32x4 (&o)[4]) {
    lsum += __shfl_xor(lsum, 16); lsum += __shfl_xor(lsum, 32);
    const float inv = 1.f / lsum;
#pragma unroll
    for (int dt = 0; dt < 4; ++dt) { uint2 w; w.x = pg8::cvt_pk_bf16(o[dt][0] * inv, o[dt][1] * inv); w.y = pg8::cvt_pk_bf16(o[dt][2] * inv, o[dt][3] * inv); *(uint2*)(orow + 16 * dt) = w; }
}
__device__ __forceinline__ void attn_ctx_phase(LAS unsigned char* lds, int vcu, int G) {
    const int tid = tid_opaque(), lane = tid & 63, wave = __builtin_amdgcn_readfirstlane(tid >> 6), r = lane & 15, q4 = lane >> 4;
    const bf16_t* Q = (const bf16_t*)(PWS + WS_Q); const bf16_t* K = (const bf16_t*)(PWS + WS_K); const bf16_t* VT = (const bf16_t*)(PWS + WS_VT);
    bf16_t* MIX = (bf16_t*)(PWS + WS_MIX);
    for (int it = vcu; it < BATCH * NH; it += G) {
        const int h = it % NH, b = it / NH;
        static_assert(SEQ / 16 == 2 * NWAVES, "two tasks per wave");
        bf16x8 qa[2][2];
#pragma unroll
        for (int ti = 0; ti < 2; ++ti) { const size_t rq = (size_t)b * SEQ + (wave + ti * NWAVES) * 16 + r; qa[ti][0] = ldg8(Q + rq * NAW + h * HD + 8 * q4); qa[ti][1] = ldg8(Q + rq * NAW + h * HD + 32 + 8 * q4); }
        __syncthreads();
        attn_stage_kv(lds, K + (size_t)b * SEQ * NAW + h * HD, NAW, VT + (size_t)(b * NH + h) * HD * SEQ, tid);
        __syncthreads();
#pragma unroll
        for (int ti = 0; ti < 2; ++ti) {
            const int task = wave + ti * NWAVES;
            const size_t rowq = (size_t)b * SEQ + task * 16 + r;
            bf16x8 qf[2];
            qf[0] = qa[ti][0]; qf[1] = qa[ti][1];
            f32x4 o[4]; float m = -1e30f, lsum = 0.f;
#pragma unroll
            for (int dt = 0; dt < 4; ++dt) o[dt] = (f32x4){0.f, 0.f, 0.f, 0.f};
            f32x4 o2[4]; float m2 = -1e30f, l2 = 0.f;
#pragma unroll
            for (int dt = 0; dt < 4; ++dt) o2[dt] = (f32x4){0.f, 0.f, 0.f, 0.f};
#pragma unroll
            for (int i = 0; i < 4; ++i) { f32x4 sa, sb, ta, tb; bf16x8 v1[4], v2[4];
                attn_lds_logits(lds, 32 * i, qf, sa, sb, v1, r, q4); attn_lds_logits(lds, 128 + 32 * i, qf, ta, tb, v2, r, q4);
                softmax_pv_step2(sa, sb, m, lsum, o, v1, ta, tb, m2, l2, o2, v2); }
            attn_merge(m, lsum, o, m2, l2, o2);
            attn_store(MIX + rowq * D + SSMW + h * HD + 4 * q4, lsum, o);
        }
    }
    __syncthreads();
}
constexpr int NAV_STRIDE = 520, NA_WV_OFF = 512 * AK_STRIDE * 2, NA_WB_OFF = NA_WV_OFF + 64 * NAV_STRIDE * 2;
static_assert(NA_WB_OFF + 15 * 32 * 4 <= LDS_CTL_OFF && ATT_V_OFF + 64 * AV_STRIDE * 2 <= NA_WB_OFF, "NA lds map");
struct NaK { bf16x8 k[8]; };
__device__ __forceinline__ void na_k_load(NaK& w, const bf16_t* kg, int row0, int nrows, int tid) {
    const int ntok = nrows * 64;
#pragma unroll
    for (int i = 0; i < 8; ++i) { const int c = tid + NWAVES * 64 * i, part = c & 7; int tok = c >> 3; tok = tok < ntok ? tok : ntok - 1; w.k[i] = ldg8(kg + (size_t)(row0 * GW + tok) * NAW + part * 8); }
}
__device__ __forceinline__ void na_k_store(LAS unsigned char* lds, const NaK& w, int nrows, int tid) {
    LAS bf16_t* kl = (LAS bf16_t*)lds; const int ntok = nrows * 64;
#pragma unroll
    for (int i = 0; i < 8; ++i) { const int c = tid + NWAVES * 64 * i, tok = c >> 3, part = c & 7; if (tok < ntok) *(LAS bf16x8*)(kl + tok * AK_STRIDE + part * 8) = w.k[i]; }
}
__device__ __forceinline__ void na_stage_v(LAS unsigned char* lds, const bf16_t* vg, int row0, int nrows, int tid) {
    LAS bf16_t* vl = (LAS bf16_t*)(lds + NA_WV_OFF); const int ntok = nrows * 64;
    bf16x8 vr[8];
#pragma unroll
    for (int i = 0; i < 8; ++i) { const int c = tid + NWAVES * 64 * i, d = c >> 6; int part = c & 63; part = part * 8 < ntok ? part : (ntok >> 3) - 1; vr[i] = ldg8(vg + (size_t)d * DSEQ + row0 * GW + part * 8); }
#pragma unroll
    for (int i = 0; i < 8; ++i) { const int c = tid + NWAVES * 64 * i, d = c >> 6, part = c & 63; if (part * 8 < ntok) *(LAS bf16x8*)(vl + d * NAV_STRIDE + part * 8) = vr[i]; }
}
struct NaC { bf16x8 k[4], v[4]; };
__device__ __forceinline__ void na_c_load(NaC& w, const bf16_t* ksrc, const bf16_t* vsrc, int tid) {
#pragma unroll
    for (int i = 0; i < 4; ++i) { const int c = tid + NWAVES * 64 * i, row = c >> 3, part = c & 7; w.k[i] = ldg8(ksrc + (size_t)row * HD + part * 8); }
#pragma unroll
    for (int i = 0; i < 4; ++i) { const int c = tid + NWAVES * 64 * i, d = c >> 5, part = c & 31; w.v[i] = ldg8(vsrc + (size_t)d * 256 + part * 8); }
}
__device__ __forceinline__ void na_c_store(LAS unsigned char* lds, const NaC& w, int tid) {
    LAS bf16_t* kl = (LAS bf16_t*)lds; LAS bf16_t* vl = (LAS bf16_t*)(lds + ATT_V_OFF);
#pragma unroll
    for (int i = 0; i < 4; ++i) { const int c = tid + NWAVES * 64 * i, row = c >> 3, part = c & 7; *(LAS bf16x8*)(kl + row * AK_STRIDE + part * 8) = w.k[i]; }
#pragma unroll
    for (int i = 0; i < 4; ++i) { const int c = tid + NWAVES * 64 * i, d = c >> 5, part = c & 31; *(LAS bf16x8*)(vl + d * AV_STRIDE + part * 8) = w.v[i]; }
}
__device__ __forceinline__ void attn_na_phase(LAS unsigned char* lds, int l, int vcu, int G) {
    const int tid = tid_opaque(), lane = tid & 63, wave = __builtin_amdgcn_readfirstlane(tid >> 6), r = lane & 15, q4 = lane >> 4;
    const bf16_t* Q = (const bf16_t*)(PWS + WS_Q); const bf16_t* K = (const bf16_t*)(PWS + WS_K); const bf16_t* VT = (const bf16_t*)(PWS + WS_VT);
    bf16_t* MIX = (bf16_t*)(PWS + WS_MIX);
    const float* rpb_l = PIN(27) + (size_t)l * NH * 15 * 31;
    const int koff = 8 * (r >> 2) + (r & 3);
    constexpr int NT = 2, IR = 2 * NT;
    const int nb = wave & 3, rl0 = wave >> 2;
    const int qcol = nb * 16 + r;
    int kc0 = nb * 16 - 8; kc0 = kc0 < 0 ? 0 : (kc0 > GW - 32 ? GW - 32 : kc0);
    int cs = qcol - 8; cs = cs < 0 ? 0 : (cs > GW - 16 ? GW - 16 : cs);
    int bidx[8];
#pragma unroll
    for (int i = 0; i < 8; ++i) { const int kcol = kc0 + 8 * q4 + i; const bool valid = kcol >= cs && kcol < cs + 16;
        int dc = kcol - qcol + 15; dc = dc < 0 ? 0 : (dc > 30 ? 30 : dc); bidx[i] = valid ? dc : 31; }
    NaC ck;
    if (vcu < DB * NH * (GW / IR)) { const int h0 = (vcu / (GW / IR)) % NH, b0 = vcu / ((GW / IR) * NH);
        na_c_load(ck, (const bf16_t*)(PWS + WS_CK) + (((size_t)l * DB + b0) * NH + h0) * PAST * HD, (const bf16_t*)(PWS + WS_CVT) + (((size_t)l * DB + b0) * NH + h0) * HD * PAST, tid); }
    for (int it = vcu; it < DB * NH * (GW / IR); it += G) {
        const int rg = it % (GW / IR), h = (it / (GW / IR)) % NH, b = it / ((GW / IR) * NH);
        const int R0 = rg * IR;
        int lo = R0 - 4; lo = lo < 0 ? 0 : (lo > GW - 8 ? GW - 8 : lo);
        int hi = R0 + IR - 1 - 4; hi = (hi < 0 ? 0 : (hi > GW - 8 ? GW - 8 : hi)) + 7;
        const bf16_t* kg = K + ((size_t)MC + (size_t)b * DSEQ) * NAW + h * HD;
        const bf16_t* vg = VT + (size_t)MC * NAW + (size_t)(b * NH + h) * HD * DSEQ;
        const bf16_t* qbase = Q + ((size_t)MC + (size_t)b * DSEQ + (R0 + rl0) * GW + qcol) * NAW + h * HD + 8 * q4;
        bf16x8 qa[NT][2];
#pragma unroll
        for (int t = 0; t < NT; ++t) { qa[t][0] = ldg8(qbase + (size_t)t * 2 * GW * NAW); qa[t][1] = ldg8(qbase + (size_t)t * 2 * GW * NAW + 32); }
        NaK wk; na_k_load(wk, kg, lo, 8, tid);
        __syncthreads();
        na_c_store(lds, ck, tid);
        if (tid < 15 * 32) { const int dr = tid >> 5, dc = tid & 31; ((LAS float*)(lds + NA_WB_OFF))[tid] = dc < 31 ? rpb_l[(size_t)h * 15 * 31 + dr * 31 + dc] * 1.4426950408889634f : -1e30f; }
        __syncthreads();
        f32x4 o[NT][4]; float m[NT], ls[NT];
#pragma unroll
        for (int t = 0; t < NT; ++t) {
            bf16x8 qf[2]; qf[0] = qa[t][0]; qf[1] = qa[t][1];
            m[t] = -1e30f; ls[t] = 0.f;
#pragma unroll
            for (int dt = 0; dt < 4; ++dt) o[t][dt] = (f32x4){0.f, 0.f, 0.f, 0.f};
#pragma unroll 2
            for (int k0 = 0; k0 < PAST; k0 += 32) { f32x4 sa, sb; bf16x8 v1[4];
                attn_lds_logits(lds, k0, qf, sa, sb, v1, r, q4);
                softmax_pv_step(sa, sb, m[t], ls[t], o[t], v1); }
            __builtin_amdgcn_sched_barrier(0);
        }
        const LAS float* btab = (const LAS float*)(lds + NA_WB_OFF);
#pragma unroll
        for (int pass = 0; pass < 2; ++pass) {
            const int base = lo + 8 * pass, nrows = pass == 0 ? 8 : hi - (lo + 8) + 1;
            __syncthreads();
            na_k_store(lds, wk, nrows, tid); na_stage_v(lds, vg, base, nrows, tid);
            __syncthreads();
            if (pass == 0) na_k_load(wk, kg, lo + 8, hi - (lo + 8) + 1, tid);
            else { const int itn = it + G < DB * NH * (GW / IR) ? it + G : it, hn = (itn / (GW / IR)) % NH, bn = itn / ((GW / IR) * NH);
                na_c_load(ck, (const bf16_t*)(PWS + WS_CK) + (((size_t)l * DB + bn) * NH + hn) * PAST * HD, (const bf16_t*)(PWS + WS_CVT) + (((size_t)l * DB + bn) * NH + hn) * HD * PAST, tid); }
#pragma unroll
            for (int t = 0; t < NT; ++t) {
                const int row = R0 + rl0 + 2 * t;
                bf16x8 qf[2]; qf[0] = qa[t][0]; qf[1] = qa[t][1];
                int rs = row - 4; rs = rs < 0 ? 0 : (rs > GW - 8 ? GW - 8 : rs);
                const int sl0 = rs > base ? rs - base : 0, sl1 = rs + 8 - base < nrows ? rs + 8 - base : nrows;
#pragma unroll 2
                for (int sl = sl0; sl < sl1; ++sl) {
                    const int wr = base + sl;
                    const LAS bf16_t* ka = (const LAS bf16_t*)lds + (sl * GW + kc0 + koff) * AK_STRIDE + 8 * q4;
                    const LAS bf16_t* vl = (const LAS bf16_t*)(lds + NA_WV_OFF) + r * NAV_STRIDE + sl * GW + kc0 + 8 * q4;
                    const bf16x8 a0 = *(const LAS bf16x8*)ka, a1 = *(const LAS bf16x8*)(ka + 32), b0 = *(const LAS bf16x8*)(ka + 4 * AK_STRIDE), b1 = *(const LAS bf16x8*)(ka + 4 * AK_STRIDE + 32);
                    bf16x8 vf[4];
#pragma unroll
                    for (int dt = 0; dt < 4; ++dt) vf[dt] = *(const LAS bf16x8*)(vl + dt * 16 * NAV_STRIDE);
                    f32x4 sa, sb; qk_tiles(a0, a1, b0, b1, qf, sa, sb);
                    const LAS float* brow = btab + (wr - row + 7) * 32;
#pragma unroll
                    for (int i = 0; i < 4; ++i) { sa[i] = fmaf(sa[i], QK_SCALE_LOG2E, brow[bidx[i]]); sb[i] = fmaf(sb[i], QK_SCALE_LOG2E, brow[bidx[4 + i]]); }
                    softmax_pv_step(sa, sb, m[t], ls[t], o[t], vf);
                }
                __builtin_amdgcn_sched_barrier(0);
            }
        }
#pragma unroll
        for (int t = 0; t < NT; ++t) {
            const size_t rowq = (size_t)MC + (size_t)b * DSEQ + (R0 + rl0 + 2 * t) * GW + qcol;
            attn_store(MIX + rowq * D + SSMW + h * HD + 4 * q4, ls[t], o[t]);
        }
    }
    __syncthreads();
}
constexpr int GT_STRIDE = 136;
template <int GLO, int GHI>
__device__ __forceinline__ void gate_item(LAS unsigned char* lds, int l, int it, int tid, int wave, int r, int q4) {
    LAS bf16_t* vt = (LAS bf16_t*)lds;
    const bf16_t* VG = (const bf16_t*)(PWS + WS_VG); const bf16_t* U = (const bf16_t*)(PWS + WS_U);
    const bf16_t* wsb = (const bf16_t*)(PWS + WS_WSB) + (size_t)l * 4 * 128 * 128;
    const float* bs = PIN(29) + (size_t)l * 4 * 128;
    bf16_t* MIX = (bf16_t*)(PWS + WS_MIX);
    {
        const size_t base = (size_t)it * 128;
        const int i = wave * 16 + r;
        bf16x8 bfrag[4][4];
#pragma unroll
        for (int g = GLO; g < GHI; ++g)
#pragma unroll
            for (int ks = 0; ks < 4; ++ks) bfrag[g][ks] = ldg8(wsb + ((size_t)g * 128 + i) * 128 + 8 * q4 + 32 * ks);
        uint2 uu[4][4]; float bsv[4];
#pragma unroll
        for (int g = GLO; g < GHI; ++g) { bsv[g] = bs[g * 128 + i];
#pragma unroll
            for (int ct = 0; ct < 4; ++ct) uu[g][ct] = *(const uint2*)(U + (base + i) * GMW + g * 64 + ct * 16 + 4 * q4); }
        __syncthreads();
        {
            const int t = tid >> 2, qc = tid & 3;
            const u32x4* vr = (const u32x4*)(VG + (base + t) * GMW + 64 * qc);
            u32x4 raw[8];
#pragma unroll
            for (int j = 0; j < 8; ++j) raw[j] = vr[j];
            float x[64]; float sm = 0.f;
#pragma unroll
            for (int j = 0; j < 8; ++j)
#pragma unroll
                for (int e = 0; e < 4; ++e) { x[8 * j + 2 * e] = __uint_as_float(raw[j][e] << 16); x[8 * j + 2 * e + 1] = __uint_as_float(raw[j][e] & 0xffff0000u); sm += x[8 * j + 2 * e] + x[8 * j + 2 * e + 1]; }
            sm += __shfl_xor(sm, 1); sm += __shfl_xor(sm, 2);
            const float mean = sm * (1.f / GMW);
            float sq = 0.f;
#pragma unroll
            for (int c = 0; c < 64; ++c) { x[c] -= mean; sq += x[c] * x[c]; }
            sq += __shfl_xor(sq, 1); sq += __shfl_xor(sq, 2);
            const float rstd = rsqrtf(sq * (1.f / GMW) + 1e-5f);
            if (qc >= GLO && qc < GHI) {
#pragma unroll
                for (int c = 0; c < 64; ++c) vt[(64 * qc + c) * GT_STRIDE + t] = f2bf(x[c] * rstd);
            }
        }
        __syncthreads();
#pragma unroll
        for (int g = GLO; g < GHI; ++g) {
            f32x4 acc[4];
#pragma unroll
            for (int ct = 0; ct < 4; ++ct) acc[ct] = (f32x4){0.f, 0.f, 0.f, 0.f};
#pragma unroll
            for (int ks = 0; ks < 4; ++ks)
#pragma unroll
                for (int ct = 0; ct < 4; ++ct) {
                    const bf16x8 afrag = *(const LAS bf16x8*)(vt + (g * 64 + ct * 16 + r) * GT_STRIDE + 32 * ks + 8 * q4);
                    acc[ct] = __builtin_amdgcn_mfma_f32_16x16x32_bf16(afrag, bfrag[g][ks], acc[ct], 0, 0, 0);
                }
#pragma unroll
            for (int ct = 0; ct < 4; ++ct) {
                const int ch = g * 64 + ct * 16 + 4 * q4;
                const float u0 = __uint_as_float(uu[g][ct].x << 16), u1 = __uint_as_float(uu[g][ct].x & 0xffff0000u), u2 = __uint_as_float(uu[g][ct].y << 16), u3 = __uint_as_float(uu[g][ct].y & 0xffff0000u);
                uint2 w; w.x = pg8::cvt_pk_bf16(u0 * (acc[ct][0] + bsv[g]), u1 * (acc[ct][1] + bsv[g])); w.y = pg8::cvt_pk_bf16(u2 * (acc[ct][2] + bsv[g]), u3 * (acc[ct][3] + bsv[g]));
                *(uint2*)(MIX + (base + i) * D + SSMW + NAW + ch) = w;
            }
        }
    }
}
__device__ __forceinline__ void gate_phase(LAS unsigned char* lds, int l, int first, int stride) {
    const int tid = tid_opaque(), lane = tid & 63, wave = __builtin_amdgcn_readfirstlane(tid >> 6), r = lane & 15, q4 = lane >> 4;
    for (int it = first; it < MT / 128; it += stride) gate_item<0, 4>(lds, l, it, tid, wave, r, q4);
    __syncthreads();
}
__device__ __forceinline__ void gate_phase_split(LAS unsigned char* lds, int l, int rb, int nb) {
    const int tid = tid_opaque(), lane = tid & 63, wave = __builtin_amdgcn_readfirstlane(tid >> 6), r = lane & 15, q4 = lane >> 4;
    gate_item<0, 4>(lds, l, rb, tid, wave, r, q4);
    if (rb & 1) gate_item<2, 4>(lds, l, nb + (rb >> 1), tid, wave, r, q4); else gate_item<0, 2>(lds, l, nb + (rb >> 1), tid, wave, r, q4);
    __syncthreads();
}
constexpr int CH = 64, NCHUNK = MT / CH;
constexpr int BU_STRIDE = 132, SB_STRIDE = 136, YB_STRIDE = 264;
constexpr int SSM_WAVE_BYTES = 16 * BU_STRIDE * 4 + 16 * SB_STRIDE * 2, SSM_YB_OFF = NWAVES * SSM_WAVE_BYTES;
static_assert(SSM_WAVE_BYTES % 16 == 0 && SSM_YB_OFF + CH * YB_STRIDE * 2 <= LDS_CTL_OFF, "ssm lds map");
__device__ __forceinline__ float2 cmul(float2 a, float2 b) { return make_float2(a.x * b.x - a.y * b.y, a.x * b.y + a.y * b.x); }
__device__ __forceinline__ float2 cfma(float2 a, float2 b, float2 c) { return make_float2(fmaf(a.x, b.x, fmaf(-a.y, b.y, c.x)), fmaf(a.x, b.y, fmaf(a.y, b.x, c.y))); }
__device__ __forceinline__ void ssm_load_bm(bf16x8 (&bm)[8], const bf16x8* BMFg, int lane) {
#pragma unroll
    for (int tau = 0; tau < 8; ++tau) bm[tau] = BMFg[tau * 64 + lane];
}
__device__ __forceinline__ bf16x8 ssm_cvt_u(const f32x4 a, const f32x4 b, int q4) {
    const float u[8] = {a[0], a[1], a[2], a[3], b[0], b[1], b[2], b[3]};
    u32x4 w; unsigned ww[4];
#pragma unroll
    for (int i = 0; i < 4; ++i) {
        const unsigned hp = pg8::cvt_pk_bf16(u[2 * i], u[2 * i + 1]);
        const unsigned lp = pg8::cvt_pk_bf16(u[2 * i] - __uint_as_float(hp << 16), u[2 * i + 1] - __uint_as_float(hp & 0xffff0000u));
        ww[i] = (q4 & 2) ? lp : hp;
    }
    w.x = ww[0]; w.y = ww[1]; w.z = ww[2]; w.w = ww[3];
    return __builtin_bit_cast(bf16x8, w);
}
__device__ __forceinline__ bf16x8 ssm_load_u(const float* XS, size_t trow0, int g, int r, int q4) {
    const f32x4* src = (const f32x4*)(XS + (trow0 + r) * SSMW + g * SC + 8 * (q4 & 1));
    return ssm_cvt_u(src[0], src[1], q4);
}
__device__ __forceinline__ void ssm_bu_to_lds(LAS float* bul, const bf16x8 (&bm)[8], const bf16x8 uf, int r, int q4) {
#pragma unroll
    for (int tau = 0; tau < 8; ++tau) {
        const f32x4 d = __builtin_amdgcn_mfma_f32_16x16x32_bf16(bm[tau], uf, (f32x4){0.f, 0.f, 0.f, 0.f}, 0, 0, 0);
        *(LAS f32x4*)(bul + r * BU_STRIDE + 16 * tau + 4 * q4) = d;
    }
}
template <int DIR> __device__ __forceinline__ float2 ssm_dir_a(const bf16x8 (&uf)[4], LAS float* bul, const float2* LB, int l, int g, int lane, int r, int q4) {
    constexpr int d = DIR;
    const int pbase = ((l * 2 + d) * SG + g) * SP;
    const float2 lb = LB[pbase + lane];
    bf16x8 bm[8]; ssm_load_bm(bm, (const bf16x8*)(PWS + WS_BMF) + (size_t)((l * 2 + d) * SG + g) * 8 * 64, lane);
    float2 s = make_float2(0.f, 0.f);
    const LAS float* brd = bul + 2 * lane;
#pragma unroll
    for (int si = 0; si < 4; ++si) {
        ssm_bu_to_lds(bul, bm, uf[d ? 3 - si : si], r, q4);
#pragma unroll
        for (int step = 0; step < 16; ++step) { const f32x2 bv2 = *(const LAS f32x2*)(brd + (d ? 15 - step : step) * BU_STRIDE); s = cfma(lb, s, make_float2(bv2[0], bv2[1])); }
    }
    return s;
}
__device__ __forceinline__ void ssm_pass_a(LAS unsigned char* lds, int l, int vcu, int G, bool wsp) {
    const int tid = tid_opaque(), lane = tid & 63, wave = __builtin_amdgcn_readfirstlane(tid >> 6), r = lane & 15, q4 = lane >> 4;
    LAS float* bul = (LAS float*)(lds + wave * SSM_WAVE_BYTES);
    const float* XS = (const float*)(PWS + WS_XSSM);
    const float2* LB = (const float2*)(PWS + WS_SSMP);
    float2* E = (float2*)(PWS + WS_E);
    int first = vcu, step = G, cnt = (2 * NCHUNK - vcu + G - 1) / G;
    if (wsp) { const int bxx = blockIdx.x, x = bxx & 7, q = bxx >> 3; const bool head = q >= 24, two = x < 4;
        step = 1;
        if (!head && two) { cnt = 2; first = (x * 24 + q) * 2; }
        else if (!head) { cnt = 3; first = 192 + ((x - 4) * 24 + q) * 3; }
        else if (two) { cnt = 4; first = 480 + (x * 8 + (q - 24)) * 4; }
        else { cnt = 5; first = 608 + ((x - 4) * 8 + (q - 24)) * 5; } }
    for (int k = 0; k < cnt; ++k) {
        const int it = first + k * step; if (it >= 2 * NCHUNK) break;
        const int ci = it >> 1, g = (it & 1) * 8 + wave;
        bf16x8 uf[4];
        {
            f32x4 ur[4][2];
#pragma unroll
            for (int sub = 0; sub < 4; ++sub) { const f32x4* src = (const f32x4*)(XS + ((size_t)ci * CH + sub * 16 + r) * SSMW + g * SC + 8 * (q4 & 1)); ur[sub][0] = src[0]; ur[sub][1] = src[1]; }
#pragma unroll
            for (int sub = 0; sub < 4; ++sub) uf[sub] = ssm_cvt_u(ur[sub][0], ur[sub][1], q4);
        }
        float2 se[2];
        se[0] = ssm_dir_a<0>(uf, bul, LB, l, g, lane, r, q4);
        se[1] = ssm_dir_a<1>(uf, bul, LB, l, g, lane, r, q4);
#pragma unroll
        for (int d = 0; d < 2; ++d) E[((size_t)ci * 2 + d) * SG * SP + g * SP + lane] = se[d];
    }
}
__device__ __forceinline__ void ssm_carry(int l, int vcu, int G) {
    const int tid = tid_opaque(), lane = tid & 63, wave = __builtin_amdgcn_readfirstlane(tid >> 6);
    const float2* LB = (const float2*)(PWS + WS_SSMP);
    const float2* E = (const float2*)(PWS + WS_E); float2* SIN = (float2*)(PWS + WS_SIN);
    const float* st0 = PIN(5);
    for (int wi = wave * G + vcu; wi < (BATCH + DB) * 2 * SG; wi += G * NWAVES) {
        const bool lat = wi < DB * 2 * SG;
        const int w2 = lat ? wi : wi - DB * 2 * SG, g = w2 % SG, d = (w2 / SG) & 1, sq = w2 / (2 * SG);
        const int nC = lat ? DSEQ / CH : SEQ / CH, cbase = lat ? MC / CH + sq * (DSEQ / CH) : sq * (SEQ / CH);
        float2 lt = LB[((l * 2 + d) * SG + g) * SP + lane];
#pragma unroll
        for (int i = 0; i < 6; ++i) lt = cmul(lt, lt);
        float2 s = make_float2(0.f, 0.f);
        if (lat) { const float* st = st0 + (((((size_t)sq * DEPTH + l) * 2 + d) * SG + g) * SP + lane) * 2; s = make_float2(st[0], st[1]); }
        const size_t off = (size_t)d * SG * SP + g * SP + lane, cs = (size_t)2 * SG * SP;
        if (lat) {
#pragma unroll 1
            for (int k0 = 0; k0 < DSEQ / CH; k0 += 32) {
                float2 e[32];
#pragma unroll
                for (int k = 0; k < 32; ++k) e[k] = E[(size_t)(cbase + (d ? DSEQ / CH - 1 - (k0 + k) : k0 + k)) * cs + off];
#pragma unroll
                for (int k = 0; k < 32; ++k) { SIN[(size_t)(cbase + (d ? DSEQ / CH - 1 - (k0 + k) : k0 + k)) * cs + off] = s; s = cfma(lt, s, e[k]); }
            }
        } else {
            float2 e[SEQ / CH];
#pragma unroll
            for (int k = 0; k < SEQ / CH; ++k) e[k] = E[(size_t)(cbase + (d ? SEQ / CH - 1 - k : k)) * cs + off];
#pragma unroll
            for (int k = 0; k < SEQ / CH; ++k) { SIN[(size_t)(cbase + (d ? SEQ / CH - 1 - k : k)) * cs + off] = s; s = cfma(lt, s, e[k]); }
        }
    }
}
template <int DIR> __device__ __forceinline__ float2 ssm_dir_b(f32x4 (&yg)[4], const bf16x8 (&uf)[4], LAS float* bul, LAS bf16_t* sbw, const float2* LB, const float2* SIN,
                                                          int l, int g, int ci, int lane, int r, int q4) {
    constexpr int d = DIR;
    const int pbase = ((l * 2 + d) * SG + g) * SP;
    const float2 lb = LB[pbase + lane];
    float2 s = SIN[((size_t)ci * 2 + d) * SG * SP + g * SP + lane];
    bf16x8 bm[8]; ssm_load_bm(bm, (const bf16x8*)(PWS + WS_BMF) + (size_t)((l * 2 + d) * SG + g) * 8 * 64, lane);
    bf16x8 cf[4];
    { const bf16x8* cff = (const bf16x8*)(PWS + WS_CFF) + (size_t)((l * 2 + d) * SG + g) * 4 * 64 + lane;
#pragma unroll
      for (int ks = 0; ks < 4; ++ks) cf[ks] = cff[ks * 64]; }
    const LAS float* brd = bul + 2 * lane; LAS bf16_t* swr = sbw + 2 * lane; const LAS bf16_t* srd = sbw + r * SB_STRIDE + 8 * q4;
#pragma unroll
    for (int si = 0; si < 4; ++si) {
        constexpr int dummy = 0; (void)dummy;
        const int sub = d ? 3 - si : si;
        ssm_bu_to_lds(bul, bm, uf[sub], r, q4);
        f32x2 buv[16];
#pragma unroll
        for (int step = 0; step < 16; ++step) buv[step] = *(const LAS f32x2*)(brd + (d ? 15 - step : step) * BU_STRIDE);
#pragma unroll
        for (int step = 0; step < 16; ++step) { s = cfma(lb, s, make_float2(buv[step][0], buv[step][1]));
            *(LAS unsigned*)(swr + (d ? 15 - step : step) * SB_STRIDE) = pg8::cvt_pk_bf16(s.x, s.y); }
#pragma unroll
        for (int ks = 0; ks < 4; ++ks) {
            const bf16x8 sf = *(const LAS bf16x8*)(srd + 32 * ks);
            yg[sub] = __builtin_amdgcn_mfma_f32_16x16x32_bf16(cf[ks], sf, yg[sub], 0, 0, 0);
        }
    }
    return s;
}
__device__ __forceinline__ void ssm_group_b(f32x4 (&yg)[4], float2 (&sfin)[2], const bf16x8 (&uf)[4], const f32x4 (&us)[4], LAS float* bul, LAS bf16_t* sbw, LAS bf16_t* yb, const float2* LB, const float2* SIN,
                                            int l, int g, int ci, int lane, int r, int q4) {
#pragma unroll
    for (int s = 0; s < 4; ++s) yg[s] = (f32x4){0.f, 0.f, 0.f, 0.f};
    const f32x4 dv = *(const f32x4*)(PIN(22) + l * SSMW + g * SC + 4 * q4);
    sfin[0] = ssm_dir_b<0>(yg, uf, bul, sbw, LB, SIN, l, g, ci, lane, r, q4);
    sfin[1] = ssm_dir_b<1>(yg, uf, bul, sbw, LB, SIN, l, g, ci, lane, r, q4);
#pragma unroll
    for (int sub = 0; sub < 4; ++sub) {
        const int t = sub * 16 + r;
#pragma unroll
        for (int i = 0; i < 4; ++i) yg[sub][i] = pg8::gelu_fast(fmaf(dv[i], us[sub][i], yg[sub][i]));
        u32x2 w; w[0] = pg8::cvt_pk_bf16(yg[sub][0], yg[sub][1]); w[1] = pg8::cvt_pk_bf16(yg[sub][2], yg[sub][3]);
        *(LAS u32x2*)(yb + t * YB_STRIDE + g * SC + 4 * q4) = w;
    }
}
__device__ __forceinline__ void ssm_pass_b(LAS unsigned char* lds, int l, int vcu, int G, int rs_slot) {
    const int tid = tid_opaque(), lane = tid & 63, wave = __builtin_amdgcn_readfirstlane(tid >> 6), r = lane & 15, q4 = lane >> 4;
    LAS float* bul = (LAS float*)(lds + wave * SSM_WAVE_BYTES);
    LAS bf16_t* sbw = (LAS bf16_t*)(lds + wave * SSM_WAVE_BYTES + 16 * BU_STRIDE * 4);
    LAS bf16_t* yb = (LAS bf16_t*)(lds + SSM_YB_OFF);
    const float* XS = (const float*)(PWS + WS_XSSM);
    const float2* LB = (const float2*)(PWS + WS_SSMP); const float2* BB = (const float2*)(PWS + WS_SSMP + 64 * 1024);
    const float2* SIN = (const float2*)(PWS + WS_SIN);
    const bf16_t* glt = (const bf16_t*)(PWS + WS_GLT) + (size_t)l * SSMW * SSMW;
    bf16_t* MIX = (bf16_t*)(PWS + WS_MIX);
    const int nit = rs_slot >= 0 ? (vcu < NCHUNK - G ? 2 : 1) : (NCHUNK - vcu + G - 1) / G;
    for (int ii = 0; ii < nit; ++ii) {
        int ci = vcu + ii * G;
        if (rs_slot >= 0) ci = ii == 0 ? 4 * (12 * (vcu >> 5) + ((vcu & 31) >> 2)) + (vcu & 3) : 4 * (12 * (vcu >> 4) + 8 + ((vcu & 15) >> 2)) + (vcu & 3);
        if (rs_slot >= 0 && ii == 1) sp_arrive(lds, rs_slot);
        const bool lat = ci >= MC / CH;
        const int sq = lat ? (ci - MC / CH) / (DSEQ / CH) : ci / (SEQ / CH);
        const int nC = lat ? DSEQ / CH : SEQ / CH, cbase = lat ? MC / CH + sq * (DSEQ / CH) : sq * (SEQ / CH), k = ci - cbase;
        __syncthreads();
        bf16x8 uf[2][4]; f32x4 us[2][4];
        {
            f32x4 ur[2][4][2];
#pragma unroll
            for (int gi = 0; gi < 2; ++gi)
#pragma unroll
                for (int sub = 0; sub < 4; ++sub) { const f32x4* src = (const f32x4*)(XS + ((size_t)ci * CH + sub * 16 + r) * SSMW + (wave * 2 + gi) * SC + 8 * (q4 & 1)); ur[gi][sub][0] = src[0]; ur[gi][sub][1] = src[1]; }
#pragma unroll
            for (int gi = 0; gi < 2; ++gi)
#pragma unroll
                for (int sub = 0; sub < 4; ++sub) us[gi][sub] = *(const f32x4*)(XS + ((size_t)ci * CH + sub * 16 + r) * SSMW + (wave * 2 + gi) * SC + 4 * q4);
#pragma unroll
            for (int gi = 0; gi < 2; ++gi)
#pragma unroll
                for (int sub = 0; sub < 4; ++sub) uf[gi][sub] = ssm_cvt_u(ur[gi][sub][0], ur[gi][sub][1], q4);
        }
        f32x4 yg0[4], yg1[4]; float2 sf0[2], sf1[2];
        ssm_group_b(yg0, sf0, uf[0], us[0], bul, sbw, yb, LB, SIN, l, wave * 2 + 0, ci, lane, r, q4);
        ssm_group_b(yg1, sf1, uf[1], us[1], bul, sbw, yb, LB, SIN, l, wave * 2 + 1, ci, lane, r, q4);
        const float* gb = PIN(24) + l * SSMW;
        bf16x8 af[8][2];
#pragma unroll
        for (int ks = 0; ks < 8; ++ks)
#pragma unroll
            for (int a = 0; a < 2; ++a) af[ks][a] = ldg8(glt + (size_t)(wave * 32 + a * 16 + r) * SSMW + 32 * ks + 8 * q4);
        f32x4 gbv[2];
#pragma unroll
        for (int a = 0; a < 2; ++a) gbv[a] = *(const f32x4*)(gb + wave * 32 + a * 16 + 4 * q4);
        __syncthreads();
        f32x4 z[2][4];
#pragma unroll
        for (int a = 0; a < 2; ++a)
#pragma unroll
            for (int b = 0; b < 4; ++b) z[a][b] = (f32x4){0.f, 0.f, 0.f, 0.f};
#pragma unroll
        for (int ks = 0; ks < 8; ++ks) {
            bf16x8 bfv[4];
#pragma unroll
            for (int b = 0; b < 4; ++b) bfv[b] = *(const LAS bf16x8*)(yb + (b * 16 + r) * YB_STRIDE + 32 * ks + 8 * q4);
#pragma unroll
            for (int a = 0; a < 2; ++a)
#pragma unroll
                for (int b = 0; b < 4; ++b) z[a][b] = __builtin_amdgcn_mfma_f32_16x16x32_bf16(af[ks][a], bfv[b], z[a][b], 0, 0, 0);
        }
#pragma unroll
        for (int a = 0; a < 2; ++a) {
            const int n = wave * 32 + a * 16 + 4 * q4;
            const f32x4 bv = gbv[a];
#pragma unroll
            for (int b = 0; b < 4; ++b) {
                const f32x4 yv = a ? yg1[b] : yg0[b];
                float o[4];
#pragma unroll
                for (int i = 0; i < 4; ++i) o[i] = yv[i] * __builtin_amdgcn_rcpf(1.f + __builtin_amdgcn_exp2f(-1.4426950408889634f * (z[a][b][i] + bv[i])));
                uint2 w; w.x = pg8::cvt_pk_bf16(o[0], o[1]); w.y = pg8::cvt_pk_bf16(o[2], o[3]);
                *(uint2*)(MIX + ((size_t)ci * CH + b * 16 + r) * D + n) = w;
            }
        }
        if (!lat) {
#pragma unroll
            for (int gi = 0; gi < 2; ++gi)
#pragma unroll
                for (int d = 0; d < 2; ++d)
                    if (d ? k == 0 : k == nC - 1) { const float2 sv = gi ? sf1[d] : sf0[d];
                        float* o = POUT + O_ST + (((((size_t)sq * DEPTH + l) * 2 + d) * SG + wave * 2 + gi) * SP + lane) * 2; o[0] = sv.x; o[1] = sv.y; }
        }
    }
    if (rs_slot >= 0 && nit < 2) sp_arrive(lds, rs_slot);
    __syncthreads();
}

#define XB_TMO      128
#define XB_XCNT(j)  (256  + 64 * (j))
#define XB_XSUB(j)  (1280 + 64 * (j))
#define XB_XGEN(j)  (2304 + 64 * (j))
#define XB_TOP      3328
#define XB_TOPGEN   3392
#define XCD_BAR_WORDS 3456
#define XB_SPIN_CAP (1u << 18)

__device__ __forceinline__ unsigned xb_ld(unsigned* p)              { return __hip_atomic_load(p, __ATOMIC_RELAXED, __HIP_MEMORY_SCOPE_AGENT); }
__device__ __forceinline__ unsigned xb_add(unsigned* p, unsigned v) { return __hip_atomic_fetch_add(p, v, __ATOMIC_RELAXED, __HIP_MEMORY_SCOPE_AGENT); }
__device__ __forceinline__ unsigned xb_xcc_id() { return (unsigned)__builtin_amdgcn_s_getreg((3 << 11) | 20) & 0xFu; }
#define XB_SPIN(cond, bar) do { unsigned _sp = 0; while (cond) { __builtin_amdgcn_s_sleep(1); \
    if ((++_sp & 255u) == 0u) { if (xb_ld(&(bar)[XB_TMO])) break; if (_sp > XB_SPIN_CAP) { atomicAdd(&(bar)[XB_TMO], 1u); break; } } } } while (0)

struct XcdBarrier {
    unsigned* bar; unsigned x;
    volatile LAS unsigned* st;
};

__device__ __forceinline__ XcdBarrier xcd_barrier_post(unsigned* bar, volatile LAS unsigned* st) {
    XcdBarrier b; b.bar = bar; b.x = xb_xcc_id(); b.st = st;
    if (threadIdx.x == 0) (void)xb_add(&bar[XB_XCNT(b.x)], 1u);
    return b;
}
__device__ __forceinline__ void xcd_barrier_complete(unsigned* bar, unsigned x, unsigned& nloc, unsigned& nx) {
    const unsigned G = gridDim.x * gridDim.y * gridDim.z;
    unsigned sum, cnt, mine, sp = 0u;
    for (;;) {
        sum = 0u; cnt = 0u; mine = 0u;
#pragma unroll
        for (unsigned j = 0; j < 16; ++j) { const unsigned c = xb_ld(&bar[XB_XCNT(j)]); sum += c; cnt += (c > 0u) ? 1u : 0u; mine = (j == x) ? c : mine; }
        if (sum == G) break;
        __builtin_amdgcn_s_sleep(1);
        if ((++sp & 255u) == 0u) { if (xb_ld(&bar[XB_TMO])) break; if (sp > XB_SPIN_CAP) { atomicAdd(&bar[XB_TMO], 1u); break; } }
    }
    nloc = mine > 0u ? mine : 1u; nx = cnt > 0u ? cnt : 1u;
}

__device__ __forceinline__ void xcd_barrier(const XcdBarrier& b) {
    asm volatile("s_waitcnt vmcnt(0)" ::: "memory");
    __syncthreads();
    if (threadIdx.x == 0) {
        unsigned* bar = b.bar;
        __builtin_amdgcn_s_waitcnt(0);
        unsigned nloc = b.st[0], nx = b.st[1];
        if (nloc == 0u) { xcd_barrier_complete(bar, b.x, nloc, nx); b.st[0] = nloc; b.st[1] = nx; }
        const unsigned old = xb_add(&bar[XB_XSUB(b.x)], 1u);
        const unsigned gen = old / nloc;
        if (old + 1u == (gen + 1u) * nloc) {
            __builtin_amdgcn_fence(__ATOMIC_RELEASE, "agent");
            asm volatile("s_waitcnt vmcnt(0)" ::: "memory");
            const unsigned og = xb_add(&bar[XB_TOP], 1u);
            const unsigned tg = og / nx;
            if (og + 1u == (tg + 1u) * nx) xb_add(&bar[XB_TOPGEN], 1u);
            else XB_SPIN(xb_ld(&bar[XB_TOPGEN]) == tg, bar);
            __builtin_amdgcn_fence(__ATOMIC_ACQUIRE, "agent");
            xb_add(&bar[XB_XGEN(b.x)], 1u);
            asm volatile("s_waitcnt vmcnt(0)" ::: "memory");
        } else {
            XB_SPIN(xb_ld(&bar[XB_XGEN(b.x)]) == gen, bar);
            __builtin_amdgcn_fence(__ATOMIC_ACQUIRE, "agent");
            asm volatile("s_waitcnt vmcnt(0)" ::: "memory");
        }
    }
    __syncthreads();
}

__device__ __forceinline__ void sp_arrive(LAS unsigned char* lds, int slot) {
    asm volatile("s_waitcnt vmcnt(0)" ::: "memory");
    __syncthreads();
    if (threadIdx.x == 0) {
        unsigned* ctl = (unsigned*)(PWS + WS_CTL); volatile LAS unsigned* st = (volatile LAS unsigned*)(lds + LDS_CTL_OFF);
        __builtin_amdgcn_s_waitcnt(0);
        const unsigned x = xb_xcc_id();
        unsigned nloc = st[0];
        if (nloc == 0u) { unsigned nx; xcd_barrier_complete(ctl + CW_BAR, x, nloc, nx); st[0] = nloc; st[1] = nx; }
        const unsigned old = xb_add(&ctl[CW_SP + 64 * (16 * slot + (int)x)], 1u);
        if (old + 1u == nloc) { __builtin_amdgcn_fence(__ATOMIC_RELEASE, "agent"); asm volatile("s_waitcnt vmcnt(0)" ::: "memory"); xb_add(&ctl[CW_SP_TOP + 64 * slot], 1u); }
    }
}
__device__ __forceinline__ void sp_wait(LAS unsigned char* lds, int slot) {
    if (threadIdx.x == 0) {
        unsigned* ctl = (unsigned*)(PWS + WS_CTL); volatile LAS unsigned* st = (volatile LAS unsigned*)(lds + LDS_CTL_OFF);
        const unsigned nx = st[1];
        XB_SPIN(xb_ld(&ctl[CW_SP_TOP + 64 * slot]) < nx, ctl + CW_BAR);
        __builtin_amdgcn_fence(__ATOMIC_ACQUIRE, "agent"); asm volatile("s_waitcnt vmcnt(0)" ::: "memory");
    }
    __syncthreads();
}

__device__ __forceinline__ void sp_arrive_wait(LAS unsigned char* lds, int a, int w) {
    asm volatile("s_waitcnt vmcnt(0)" ::: "memory");
    __syncthreads();
    if (threadIdx.x == 0) {
        unsigned* ctl = (unsigned*)(PWS + WS_CTL); volatile LAS unsigned* st = (volatile LAS unsigned*)(lds + LDS_CTL_OFF);
        __builtin_amdgcn_s_waitcnt(0);
        const unsigned x = xb_xcc_id();
        unsigned nloc = st[0], nx = st[1];
        if (nloc == 0u) { xcd_barrier_complete(ctl + CW_BAR, x, nloc, nx); st[0] = nloc; st[1] = nx; }
        const unsigned old = xb_add(&ctl[CW_SP + 64 * (16 * a + (int)x)], 1u);
        const unsigned seen = xb_ld(&ctl[CW_SP_TOP + 64 * w]);
        if (old + 1u == nloc) { __builtin_amdgcn_fence(__ATOMIC_RELEASE, "agent"); asm volatile("s_waitcnt vmcnt(0)" ::: "memory"); xb_add(&ctl[CW_SP_TOP + 64 * a], 1u); }
        if (seen < nx) XB_SPIN(xb_ld(&ctl[CW_SP_TOP + 64 * w]) < nx, ctl + CW_BAR);
        __builtin_amdgcn_fence(__ATOMIC_ACQUIRE, "agent"); asm volatile("s_waitcnt vmcnt(0)" ::: "memory");
    }
    __syncthreads();
}
__device__ __forceinline__ bool chain_on(int G);

#define PHASE_FN __device__ __forceinline__
__device__ __forceinline__ bool win_split_on(int G) { return G == 256 && (MT / 256) * (INC / 256) / 256 == 3; }
__device__ __forceinline__ bool rowsplit_on(int G) { return G == 256 && MT / 256 == 96 && D / 256 == 4; }
__device__ __forceinline__ bool chain_on(int G) { return rowsplit_on(G) && win_split_on(G) && NCHUNK - G == G / 2 && MT == 12 * G * NWAVES; }
PHASE_FN void ph_prologue(LAS unsigned char* lds, int vcu, int G) {
    prologue_adaln(lds, vcu, G); sp_arrive(lds, 2);
    prologue_rest(lds, vcu, G);  sp_arrive_wait(lds, 3, 2);
    const bool rs = rowsplit_on(G) && MT == 12 * G * NWAVES;
    x0_ab(lds, vcu, G, rs ? 32 : -1);
    sp_wait(lds, 3); x0_c(vcu, G);
    if (chain_on(G)) sp_arrive_wait(lds, 33, 32); else if (rs) sp_arrive(lds, 33);
}
PHASE_FN void ph_ffn_in(LAS unsigned char* lds, int l, int second, int G, int bx) {
    unsigned char* wl = PWS + WS_W + (size_t)l * WL_STRIDE;
    const bool rs = rowsplit_on(G), rsw = rs && (second || l > 0), rs0 = rs && !second && l == 0 && MT == 12 * G * NWAVES;
    const int eslot = rs0 ? 32 : second ? 10 + l : 14, wslot = rs0 ? 33 : second ? 12 + l : 15;
    if ((rsw || rs0) && !chain_on(G)) sp_wait(lds, eslot);
    const int pes = (second ? 20 : 16) + l, pas = (second ? 22 : 18) + l;
    pg8::Gemm g{(const bf16_t*)(PWS + WS_H), (const bf16_t*)(wl + (second ? WO_W1B : WO_W1A)), MT, 2 * FF, D, (rs ? (pes + 1) | (5 << 8) : 0) | (rsw ? ((wslot + 1) << 16) | (1 << 24) : 0) | (rs0 ? (int)(((unsigned)(wslot + 1) << 16) | 0x80000000u) : 0)};
    pg8::StaticOrder S; S.init(MT, 2 * FF, G, bx, rs ? ((!second && l > 0) ? 3 : 2) : 0);
    pg8::EpiFfnIn E{l, second};
    pg8::gemm_phase<pg8::EpiFfnIn, pg8::StaticOrder, true, true>(lds, g, S, E);
    if (chain_on(G)) sp_arrive_wait(lds, pas, pes); else if (rs) sp_arrive(lds, pas);
}
PHASE_FN void ph_res(LAS unsigned char* lds, int l, int kind, int G, int bx) {
    unsigned char* wl = PWS + WS_W + (size_t)l * WL_STRIDE;
    const bool wo = kind == 1;
    const bool rs = rowsplit_on(G), rsp = rs && (kind != 2 || l + 1 < DEPTH);
    const int eslot = kind == 0 ? 24 + l : kind == 1 ? 10 + l : 14, aslot = kind == 0 ? 26 + l : kind == 1 ? 12 + l : 15;
    const bool rsc = rs && (kind != 1 || (win_split_on(G) && NCHUNK - G == G / 2));
    const int ces = (kind == 0 ? 16 : kind == 1 ? 28 : 20) + l, cas = (kind == 0 ? 18 : kind == 1 ? 30 : 22) + l;
    if (rsc && !chain_on(G)) sp_wait(lds, ces);
    pg8::Gemm g{(const bf16_t*)(PWS + (wo ? WS_MIX : WS_ACT)), (const bf16_t*)(wl + (kind == 0 ? WO_W2A : wo ? WO_WOUT : WO_W2B)), MT, D, wo ? D : FF, (rsp ? eslot + 1 : 0) | (rsc ? (cas + 1) << 16 : 0)};
    pg8::StaticOrder S; S.init(MT, D, G, bx, (rsp || rsc) ? 1 : 0);
    pg8::EpiRes E{l, kind};
    pg8::gemm_phase<pg8::EpiRes, pg8::StaticOrder, true, true>(lds, g, S, E);
    if (rsp && chain_on(G)) sp_arrive_wait(lds, aslot, eslot); else if (rsp) sp_arrive(lds, aslot);
}
PHASE_FN void ph_win(LAS unsigned char* lds, int l, int G, int bx) {
    unsigned char* wl = PWS + WS_W + (size_t)l * WL_STRIDE;
    const bool sp = win_split_on(G), rs = sp && rowsplit_on(G);
    if (rs && !chain_on(G)) sp_wait(lds, 24 + l);
    pg8::Gemm g{(const bf16_t*)(PWS + WS_H), (const bf16_t*)(wl + WO_WIN), MT, INC, D, (sp ? (6 + l + 1) | (((MT / 256) * (INC / 256) / 256 - 1) << 8) : 0) | (rs ? (int)(((unsigned)(26 + l + 1) << 16) | 0x80000000u) : 0)};
    pg8::StaticOrder S; S.init(MT, INC, G, bx, rs ? 2 : 0);
    pg8::EpiWin E{l};
    pg8::gemm_phase<pg8::EpiWin, pg8::StaticOrder, true, true>(lds, g, S, E);
    if (chain_on(G)) sp_arrive_wait(lds, 8 + l, 6 + l); else if (sp) sp_arrive(lds, 8 + l);
}
PHASE_FN void ph_mix(LAS unsigned char* lds, int l, int vcu, int G, int sub) {
    const bool wsp = win_split_on(G);
    if (wsp && !chain_on(G)) sp_wait(lds, 6 + l);
    for (int i = 0; i <= ((sub >> 0) & 1); ++i) ssm_pass_a(lds, l, vcu, G, wsp);
    if (wsp) sp_arrive_wait(lds, l, 8 + l); else sp_arrive(lds, l);
    for (int i = 0; i <= ((sub >> 1) & 1); ++i) attn_ctx_phase(lds, vcu, G);
    sp_wait(lds, l); ssm_carry(l, vcu, G);
    sp_arrive(lds, 4 + l);
    for (int i = 0; i <= ((sub >> 2) & 1); ++i) attn_na_phase(lds, l, vcu, G);
    (void)sub;
    sp_wait(lds, 4 + l);
    if (G >= 2 && NCHUNK > G && NCHUNK <= 2 * G) {
        const int h0 = NCHUNK - G, nb = G - h0;
        if (2 * (MT / 128 - nb) == nb) { if (vcu >= h0) gate_phase_split(lds, l, vcu - h0, nb); }
        else gate_phase(lds, l, vcu >= h0 ? vcu - h0 : MT, nb);
    }
    else gate_phase(lds, l, vcu, G);
    const bool mrs = wsp && rowsplit_on(G) && NCHUNK - G == G / 2;
    ssm_pass_b(lds, l, vcu, G, mrs ? 28 + l : -1);
    if (mrs && chain_on(G)) sp_arrive_wait(lds, 30 + l, 28 + l); else if (mrs) sp_arrive(lds, 30 + l);
}

__global__ void __launch_bounds__(NWAVES * 64, 2) mega(Params p) {
    extern __shared__ __attribute__((aligned(16))) unsigned char lds_raw[];
    LAS unsigned char* lds = (LAS unsigned char*)lds_raw;
    const int G = gridDim.x, bx = blockIdx.x;
    const int vcu = (G % 8 == 0) ? (bx % 8) * (G / 8) + bx / 8 : bx;
    {
        volatile LAS unsigned* st0 = (volatile LAS unsigned*)(lds + LDS_CTL_OFF);
        if (threadIdx.x < 16) st0[threadIdx.x] = 0u;
        __syncthreads();
        (void)xcd_barrier_post((unsigned*)(PWS + WS_CTL) + CW_BAR, st0);
    }
    for (int ph = p.ph_lo, rep = 0; ph < p.ph_hi;) {
        int Gp = G, vp = vcu, bp = bx; asm volatile("" : "+s"(Gp), "+s"(vp), "+s"(bp));
        if (ph == PH_X0 || (ph >= 2 && (ph - 2) % PH_PER_LAYER + 2 == PH_MIX2)) { ++ph; continue; }
        if (ph == PH_PRO) { ph_prologue(lds, vp, Gp); }
        else {
            const int l = (ph - 2) / PH_PER_LAYER, q = (ph - 2) % PH_PER_LAYER + 2;
            if (q == PH_F1IN) ph_ffn_in(lds, l, 0, Gp, bp);
            else if (q == PH_F2IN) ph_ffn_in(lds, l, 1, Gp, bp);
            else if (q == PH_F1OUT) ph_res(lds, l, 0, Gp, bp);
            else if (q == PH_WOUT) ph_res(lds, l, 1, Gp, bp);
            else if (q == PH_F2OUT) ph_res(lds, l, 2, Gp, bp);
            else if (q == PH_WIN) ph_win(lds, l, Gp, bp);
            else if (q == PH_MIX1) ph_mix(lds, l, vp, Gp, p.rep_mask >> 16);
        }
        const int kind = ph < 2 ? ph : (ph - 2) % PH_PER_LAYER + 2;
        const bool again = rep == 0 && ((p.rep_mask >> kind) & 1);
        const int lyr = ph < 2 ? 0 : (ph - 2) / PH_PER_LAYER;
        if ((again || ph + 1 < p.ph_hi) && !(kind == PH_WIN && win_split_on(Gp)) && !(rowsplit_on(Gp) && ((kind == PH_PRO && MT == 12 * Gp * NWAVES) || kind == PH_WOUT || kind == PH_F1IN || kind == PH_F2IN || kind == PH_F1OUT || (kind == PH_MIX1 && win_split_on(Gp) && NCHUNK - Gp == Gp / 2) || (kind == PH_F2OUT && lyr + 1 < DEPTH)))) {
            if (p.ph_lo < 0) cooperative_groups::this_grid().sync();
            { XcdBarrier bar; bar.bar = (unsigned*)(PWS + WS_CTL) + CW_BAR; bar.x = xb_xcc_id(); bar.st = (volatile LAS unsigned*)(lds + LDS_CTL_OFF); xcd_barrier(bar); }
        }
        if (again) rep = 1; else { rep = 0; ++ph; }
    }
}
}

extern "C" void kernel_launch(void* const* d_in, const int* in_sizes, int n_in, void* d_out, int out_size, void* d_ws, size_t ws_size, hipStream_t stream) {
    static int grid = 0;
    if (grid == 0) {
        if (n_in != 33 || ws_size < WS_END) { fprintf(stderr, "kernel_launch: unexpected n_in %d / ws_size %zu\n", n_in, ws_size); grid = -1; return; }
        int dev = 0, cus = 0;
        if (hipGetDevice(&dev) != hipSuccess || hipDeviceGetAttribute(&cus, hipDeviceAttributeMultiprocessorCount, dev) != hipSuccess) { grid = -1; return; }
        if (hipFuncSetAttribute((const void*)mega, hipFuncAttributeMaxDynamicSharedMemorySize, LDS_BYTES) != hipSuccess) { fprintf(stderr, "hipFuncSetAttribute failed\n"); grid = -1; return; }
        grid = cus;
    }
    if (grid < 0) return;
    Params p{};
    for (int i = 0; i < 33; ++i) p.in[i] = (const float*)d_in[i];
    p.out = (float*)d_out; p.ws = (unsigned char*)d_ws;
    p.ph_lo = 0; p.ph_hi = NPHASES; p.rep_mask = PROBE_REP_MASK;
    if (hipMemsetAsync((char*)d_ws + WS_CTL, 0, WS_MOD + (size_t)DEPTH * 5 * NMOD * D * 4, stream) != hipSuccess) { fprintf(stderr, "memset of control words failed\n"); return; }
    void* args[] = {&p};
    const hipError_t e = hipLaunchCooperativeKernel((const void*)mega, dim3(grid), dim3(NWAVES * 64), args, LDS_BYTES, stream);
    if (e != hipSuccess) fprintf(stderr, "cooperative launch failed: %s (grid %d)\n", hipGetErrorString(e), grid);
}
```
